# Optimizing an MI355X kernel written in HIP

```python
import jax, jax.numpy as jnp
from jax import lax
import numpy as np

D_MODEL = 1024
BATCH = 8
SEQ = 2048
DEPTH = 4
DEC_BATCH = 128
DEC_SEQ = 1
PAST_LEN = 16384
PAGE_SIZE = 128

N_META = 16
N_MIXERS = 3
N_RET_LAYERS = (DEPTH + N_MIXERS - 1) // N_MIXERS
RET_HEADS = 4
RET_DK = D_MODEL // RET_HEADS
RET_DV = 2 * D_MODEL // RET_HEADS
RET_CHUNK = 128
ROPE_BASE = 10000.0
RWKV_HEAD = 64
RWKV_HEADS = D_MODEL // RWKV_HEAD
RWKV_DECAY_LORA = 64
RWKV_A_LORA = 64
RWKV_GATE_LORA = 160
CONV_WIDTH = 3
D_FF = 4 * D_MODEL
EPS = 1e-6
RWKV_GN_EPS = 64e-5

kernel_name = 'hybrid_retention_rwkv7_shortconv_step'


def rmsnorm(x, g):
    xf = x.astype(jnp.float32)
    y = xf * lax.rsqrt(jnp.mean(xf * xf, axis=-1, keepdims=True) + EPS)
    return (y * g.astype(jnp.float32)).astype(x.dtype)


def rotate_pairs(x, pos):
    inv = 1.0 / (ROPE_BASE ** jnp.linspace(0.0, 1.0, RET_DK // 2, dtype=jnp.float32))
    ang = pos.astype(jnp.float32)[:, None] * inv[None, :]
    cos = jnp.cos(ang)[None, :, None, :]
    sin = jnp.sin(ang)[None, :, None, :]
    xf = x.astype(jnp.float32).reshape(x.shape[:-1] + (RET_DK // 2, 2))
    x1, x2 = xf[..., 0], xf[..., 1]
    return jnp.stack([x1 * cos - x2 * sin, x1 * sin + x2 * cos], axis=-1).reshape(x.shape)


def retention_chunk(S, q, k, v, log_gamma):
    L = q.shape[1]
    idx = jnp.arange(L, dtype=jnp.float32)
    diff = idx[:, None] - idx[None, :]
    mask = jnp.where(diff >= 0, jnp.exp(jnp.maximum(diff, 0.0)[None] * log_gamma[:, None, None]), 0.0)
    scores = jnp.einsum('blhd,bmhd->bhlm', q, k) * mask[None]
    inner = jnp.einsum('bhlm,bmhe->blhe', scores, v)
    q_decay = jnp.exp((idx + 1.0)[:, None] * log_gamma[None, :])
    cross = jnp.einsum('blhd,bhde->blhe', q * q_decay[None, :, :, None], S)
    k_decay = jnp.exp((L - 1.0 - idx)[:, None] * log_gamma[None, :])
    S_new = S * jnp.exp(L * log_gamma)[None, :, None, None] + jnp.einsum('blhd,blhe->bhde', k * k_decay[None, :, :, None], v)
    return S_new, inner + cross


def retention_blocks(S, q, k, v, log_gamma):
    B, T = q.shape[0], q.shape[1]
    n_full = T // RET_CHUNK
    outs = []
    if n_full > 0:
        def to_blocks(a):
            return a[:, :n_full * RET_CHUNK].reshape((B, n_full, RET_CHUNK) + a.shape[2:]).swapaxes(0, 1)

        def step(carry, qkv):
            return retention_chunk(carry, qkv[0], qkv[1], qkv[2], log_gamma)

        S, o = lax.scan(step, S, (to_blocks(q), to_blocks(k), to_blocks(v)))
        outs.append(o.swapaxes(0, 1).reshape(B, n_full * RET_CHUNK, RET_HEADS, RET_DV))
    if T % RET_CHUNK:
        t0 = n_full * RET_CHUNK
        S, o = retention_chunk(S, q[:, t0:], k[:, t0:], v[:, t0:], log_gamma)
        outs.append(o)
    return S, jnp.concatenate(outs, axis=1)


def retention_mixer(xn, S0, pos, lead, w_in, w_out):
    B, T, _ = xn.shape
    hk, hv = RET_HEADS * RET_DK, RET_HEADS * RET_DV
    q, k, v, g = jnp.split(xn @ w_in, [hk, 2 * hk, 2 * hk + hv], axis=-1)
    q = rotate_pairs(q.reshape(B, T, RET_HEADS, RET_DK), pos)
    k = rotate_pairs(k.reshape(B, T, RET_HEADS, RET_DK), pos) * (RET_DK ** -0.5)
    v = v.reshape(B, T, RET_HEADS, RET_DV).astype(jnp.float32)
    log_gamma = jnp.log(1.0 - 2.0 ** (-5.0 - jnp.arange(RET_HEADS, dtype=jnp.float32)))
    S = S0.astype(jnp.float32)
    if lead > 0:
        S, o_lead = retention_chunk(S, q[:, :lead], k[:, :lead], v[:, :lead], log_gamma)
        S, o_rest = retention_blocks(S, q[:, lead:], k[:, lead:], v[:, lead:], log_gamma)
        o = jnp.concatenate([o_lead, o_rest], axis=1)
    else:
        S, o = retention_blocks(S, q, k, v, log_gamma)
    o = o * lax.rsqrt(jnp.mean(o * o, axis=-1, keepdims=True) + EPS)
    y = jax.nn.silu(g.astype(jnp.float32)) * o.reshape(B, T, hv)
    return y.astype(xn.dtype) @ w_out, S.astype(xn.dtype)


def wkv7_scan(S0, r, decay, k, v, kk, a):
    def step(S, inp):
        r_t, w_t, k_t, v_t, kk_t, a_t = inp
        sa = jnp.einsum('bhvk,bhk->bhv', S, -kk_t)
        S = S * w_t[:, :, None, :] + sa[..., None] * (kk_t * a_t)[:, :, None, :] + v_t[..., None] * k_t[:, :, None, :]
        return S, jnp.einsum('bhvk,bhk->bhv', S, r_t)

    xs = tuple(t.swapaxes(0, 1) for t in (r, decay, k, v, kk, a))
    S, y = lax.scan(step, S0, xs)
    return S, y.swapaxes(0, 1)


def rwkv7_mixer(xn, shift_prev, S0, mix, w_rkv, w0, w1, w2, a0, a1, a2, g1, g2, k_k, k_a, r_k, ln_g, ln_b, w_o):
    B, T, D = xn.shape
    H, N = RWKV_HEADS, RWKV_HEAD
    x_prev = jnp.concatenate([shift_prev[:, None].astype(xn.dtype), xn[:, :-1]], axis=1)
    xx = x_prev - xn
    xm = xn[:, :, None, :] + xx[:, :, None, :] * mix[None, None]
    r, k, v = jnp.split(jnp.einsum('btjd,jde->btje', xm[:, :, :3], w_rkv), 3, axis=2)
    r, k, v = r[:, :, 0].astype(jnp.float32), k[:, :, 0].astype(jnp.float32), v[:, :, 0].astype(jnp.float32)
    xw, xa, xg = xm[:, :, 3], xm[:, :, 4], xm[:, :, 5]
    w = -jax.nn.softplus(-(w0 + jnp.tanh(xw @ w1) @ w2).astype(jnp.float32)) - 0.5
    decay = jnp.exp(-jnp.exp(w))
    a = jax.nn.sigmoid((a0 + (xa @ a1) @ a2).astype(jnp.float32))
    g = (jax.nn.sigmoid(xg @ g1) @ g2).astype(jnp.float32)
    kk = (k * k_k.astype(jnp.float32)).reshape(B, T, H, N)
    kk = kk / jnp.maximum(jnp.sqrt(jnp.sum(kk * kk, axis=-1, keepdims=True)), 1e-12)
    k = k * (1.0 + (a - 1.0) * k_a.astype(jnp.float32))
    hs = lambda t: t.reshape(B, T, H, N)
    r, decay, k, v, a = hs(r), hs(decay), hs(k), hs(v), hs(a)
    S, y = wkv7_scan(S0.astype(jnp.float32), r, decay, k, v, kk, a)
    mu = jnp.mean(y, axis=-1, keepdims=True)
    var = jnp.mean((y - mu) ** 2, axis=-1, keepdims=True)
    y = ((y - mu) * lax.rsqrt(var + RWKV_GN_EPS)).reshape(B, T, D) * ln_g.astype(jnp.float32) + ln_b.astype(jnp.float32)
    bonus = jnp.sum(r * k * r_k.astype(jnp.float32)[None, None], axis=-1, keepdims=True) * v
    y = (y + bonus.reshape(B, T, D)) * g
    return y.astype(xn.dtype) @ w_o, xn[:, -1], S.astype(xn.dtype)


def short_conv_mixer(xn, buf, w_in, conv_w, w_out):
    T = xn.shape[1]
    b, c, h = jnp.split(xn @ w_in, 3, axis=-1)
    u = c * h
    up = jnp.concatenate([buf.astype(u.dtype), u], axis=1)
    y = conv_w[0] * up[:, :T] + conv_w[1] * up[:, 1:T + 1] + conv_w[2] * up[:, 2:T + 2]
    return (b * y) @ w_out, up[:, -(CONV_WIDTH - 1):]


def sq_relu_mlp(xn, w1, w2):
    return jnp.square(jax.nn.relu(xn @ w1)) @ w2


def trunk(h, pos, lead, ret_states, rwkv_shift, rwkv_state, conv_buf,
          norm_mix, norm_mlp, norm_final, ret_w_in, ret_w_out,
          rwkv_mix, rwkv_w_rkv, rwkv_w0, rwkv_w1, rwkv_w2, rwkv_a0, rwkv_a1, rwkv_a2,
          rwkv_g1, rwkv_g2, rwkv_k_k, rwkv_k_a, rwkv_r_k, rwkv_ln_g, rwkv_ln_b, rwkv_w_o,
          conv_w_in, conv_w, conv_w_out, mlp_w1, mlp_w2):
    new_ret = []
    for i in range(DEPTH):
        xn = rmsnorm(h, norm_mix[i])
        kind = i % N_MIXERS
        if kind == 0:
            j = i // N_MIXERS
            out, s = retention_mixer(xn, ret_states[j], pos, lead, ret_w_in[j], ret_w_out[j])
            new_ret.append(s)
        elif kind == 1:
            out, rwkv_shift, rwkv_state = rwkv7_mixer(xn, rwkv_shift, rwkv_state, rwkv_mix, rwkv_w_rkv, rwkv_w0, rwkv_w1, rwkv_w2,
                                                      rwkv_a0, rwkv_a1, rwkv_a2, rwkv_g1, rwkv_g2, rwkv_k_k, rwkv_k_a, rwkv_r_k,
                                                      rwkv_ln_g, rwkv_ln_b, rwkv_w_o)
        else:
            out, conv_buf = short_conv_mixer(xn, conv_buf, conv_w_in, conv_w, conv_w_out)
        h = h + out
        h = h + sq_relu_mlp(rmsnorm(h, norm_mlp[i]), mlp_w1[i], mlp_w2[i])
    return rmsnorm(h, norm_final), new_ret, rwkv_shift, rwkv_state, conv_buf


def setup_inputs(seed: int = 0) -> dict:
    key = jax.random.key(seed)
    ks = iter(jax.random.split(key, 48))

    def nrm(shape, scale):
        return jax.random.normal(next(ks), shape, jnp.float32) * scale

    D = D_MODEL
    hk, hv = RET_HEADS * RET_DK, RET_HEADS * RET_DV
    return {
        'x_prompt': nrm((BATCH, SEQ, D), 1.0),
        'x_sample': nrm((DEC_BATCH, DEC_SEQ, D), 1.0),
        'state_ret_l0': nrm((DEC_BATCH, RET_HEADS, RET_DK, RET_DV), 0.5),
        'state_rwkv_shift_l1': nrm((DEC_BATCH, D), 1.0),
        'state_rwkv_wkv_l1': nrm((DEC_BATCH, RWKV_HEADS, RWKV_HEAD, RWKV_HEAD), 0.3),
        'state_conv_l2': nrm((DEC_BATCH, CONV_WIDTH - 1, D), 1.0),
        'state_ret_l3': nrm((DEC_BATCH, RET_HEADS, RET_DK, RET_DV), 0.5),
        'meta_tokens': nrm((N_META, D), 1.0),
        'norm_mix': 1.0 + nrm((DEPTH, D), 0.02),
        'norm_mlp': 1.0 + nrm((DEPTH, D), 0.02),
        'norm_final': 1.0 + nrm((D,), 0.02),
        'ret_w_in': nrm((N_RET_LAYERS, D, 2 * hk + 2 * hv), D ** -0.5),
        'ret_w_out': nrm((N_RET_LAYERS, hv, D), hv ** -0.5),
        'rwkv_mix': jax.random.uniform(next(ks), (6, D), jnp.float32, 0.0, 1.0),
        'rwkv_w_rkv': nrm((3, D, D), D ** -0.5),
        'rwkv_w0': jnp.linspace(-6.0, -1.0, D, dtype=jnp.float32) + nrm((D,), 0.1),
        'rwkv_w1': nrm((D, RWKV_DECAY_LORA), D ** -0.5),
        'rwkv_w2': nrm((RWKV_DECAY_LORA, D), 0.1 * RWKV_DECAY_LORA ** -0.5),
        'rwkv_a0': nrm((D,), 0.1),
        'rwkv_a1': nrm((D, RWKV_A_LORA), D ** -0.5),
        'rwkv_a2': nrm((RWKV_A_LORA, D), 0.5 * RWKV_A_LORA ** -0.5),
        'rwkv_g1': nrm((D, RWKV_GATE_LORA), D ** -0.5),
        'rwkv_g2': nrm((RWKV_GATE_LORA, D), RWKV_GATE_LORA ** -0.5),
        'rwkv_k_k': 0.85 + nrm((D,), 0.05),
        'rwkv_k_a': 1.0 + nrm((D,), 0.05),
        'rwkv_r_k': nrm((RWKV_HEADS, RWKV_HEAD), 0.1),
        'rwkv_ln_g': 1.0 + nrm((D,), 0.02),
        'rwkv_ln_b': nrm((D,), 0.02),
        'rwkv_w_o': nrm((D, D), D ** -0.5),
        'conv_w_in': nrm((D, 3 * D), D ** -0.5),
        'conv_w': nrm((CONV_WIDTH, D), CONV_WIDTH ** -0.5),
        'conv_w_out': nrm((D, D), D ** -0.5),
        'mlp_w1': nrm((DEPTH, D, D_FF), D ** -0.5),
        'mlp_w2': nrm((DEPTH, D_FF, D), D_FF ** -0.5),
    }


def reference(x_prompt, x_sample, state_ret_l0, state_rwkv_shift_l1, state_rwkv_wkv_l1, state_conv_l2, state_ret_l3,
              meta_tokens, norm_mix, norm_mlp, norm_final, ret_w_in, ret_w_out,
              rwkv_mix, rwkv_w_rkv, rwkv_w0, rwkv_w1, rwkv_w2, rwkv_a0, rwkv_a1, rwkv_a2,
              rwkv_g1, rwkv_g2, rwkv_k_k, rwkv_k_a, rwkv_r_k, rwkv_ln_g, rwkv_ln_b, rwkv_w_o,
              conv_w_in, conv_w, conv_w_out, mlp_w1, mlp_w2):
    weights = (norm_mix, norm_mlp, norm_final, ret_w_in, ret_w_out,
               rwkv_mix, rwkv_w_rkv, rwkv_w0, rwkv_w1, rwkv_w2, rwkv_a0, rwkv_a1, rwkv_a2,
               rwkv_g1, rwkv_g2, rwkv_k_k, rwkv_k_a, rwkv_r_k, rwkv_ln_g, rwkv_ln_b, rwkv_w_o,
               conv_w_in, conv_w, conv_w_out, mlp_w1, mlp_w2)
    dt = x_prompt.dtype
    B = x_prompt.shape[0]

    h_p = jnp.concatenate([jnp.broadcast_to(meta_tokens[None].astype(dt), (B, N_META, D_MODEL)), x_prompt], axis=1)
    pos_p = jnp.arange(SEQ + N_META)
    zero_ret = [jnp.zeros((B, RET_HEADS, RET_DK, RET_DV), dt) for _ in range(N_RET_LAYERS)]
    out_p, ret_p, shift_p, wkv_p, conv_p = trunk(
        h_p, pos_p, N_META, zero_ret, jnp.zeros((B, D_MODEL), dt),
        jnp.zeros((B, RWKV_HEADS, RWKV_HEAD, RWKV_HEAD), dt), jnp.zeros((B, CONV_WIDTH - 1, D_MODEL), dt), *weights)
    y_prompt = out_p[:, N_META:]

    pos_s = PAST_LEN + jnp.arange(DEC_SEQ)
    y_sample, ret_s, shift_s, wkv_s, conv_s = trunk(
        x_sample, pos_s, 0, [state_ret_l0, state_ret_l3], state_rwkv_shift_l1, state_rwkv_wkv_l1, state_conv_l2, *weights)

    return (y_prompt, y_sample, ret_p[0], ret_s[0], shift_p, shift_s, wkv_p, wkv_s, conv_p, conv_s, ret_p[1], ret_s[1])
```

```cpp
#include <hip/hip_runtime.h>
#include <hip/hip_cooperative_groups.h>
#include <cstdio>
#include <cstdint>
namespace cg = cooperative_groups;
namespace pg8 {
#define PG8_LAS __attribute__((address_space(3)))
typedef unsigned short bf16_t;
typedef short bf16x8 __attribute__((ext_vector_type(8)));
typedef float f32x4 __attribute__((ext_vector_type(4)));
typedef unsigned u32x4 __attribute__((ext_vector_type(4)));
constexpr int BM = 256, BK = 64, HALF = 128, HTB = HALF * BK * 2  , STAGE_BYTES = 8 * HTB, NXCD = 8, WGM = 8;

__host__ __device__ __forceinline__ int lds_byte(int r, int c) { const int st = (r >> 4) * 2 + (c >> 5), rr = r & 15, cc = c & 31, ob = rr * 64 + cc * 2; return st * 1024 + (ob ^ (((ob >> 9) & 1) << 5)); }
__host__ __device__ __forceinline__ void stage_rc(int b, int& R, int& C) { const int st = b / 1024, sb = b % 1024, swz = sb ^ (((sb >> 9) & 1) << 5); R = (st >> 1) * 16 + swz / 64; C = (st & 1) * 32 + (swz % 64) / 2; }
__host__ __device__ __forceinline__ int perm32(int rho) { const int n = rho >> 4, i = rho & 15; return 8 * (i >> 2) + 4 * n + (i & 3); }

struct Unit { int pm, pn, k0, nt; };
struct Gemm { const bf16_t* A; const bf16_t* Bt; int M, N, K; };

struct StaticOrder {
    int nM, nN, nwg, G, c;
    __host__ __device__ void init(int M, int N, int G_, int c_) { nM = M / BM; nN = N / BM; nwg = nM * nN; G = G_; c = c_; }
    __host__ __device__ __forceinline__ bool next(int i, Unit& u) const {
        const long L = (long)i * G + c; if (L >= nwg) return false;
        int wgid = (int)L; { const int q = nwg / NXCD, r = nwg % NXCD, xcd = wgid % NXCD, off = wgid / NXCD; wgid = (xcd < r ? xcd * (q + 1) : r * (q + 1) + (xcd - r) * q) + off; }
        const int nig = WGM * nN, gid = wgid / nig, fm = gid * WGM, gsz = (nM - fm) < WGM ? (nM - fm) : WGM;
        u.pm = fm + ((wgid % nig) % gsz); u.pn = (wgid % nig) / gsz; u.k0 = 0; u.nt = 0; return true;
    }
    __device__ __forceinline__ void a_ready(const Unit&) const {}
    __device__ __forceinline__ void done(const Unit&) const {}
};

__device__ __forceinline__ unsigned cvt_pk_bf16(float lo, float hi) { unsigned r; asm volatile("v_cvt_pk_bf16_f32 %0, %1, %2" : "=v"(r) : "v"(lo), "v"(hi)); return r; }
template <class Epi, class Sched, bool ALIGN_EPI = false, bool SP2 = false>
__device__ __forceinline__ void gemm_phase(PG8_LAS unsigned char* lds, const Gemm g, const Sched& S, const Epi& E) {
    int tid_ = threadIdx.x; asm volatile("" : "+v"(tid_));
    const int tid = tid_, wid = __builtin_amdgcn_readfirstlane(tid >> 6), lane = tid & 63, wr = wid >> 2, wc = wid & 3, fr = lane & 15, fq = lane >> 4;
    const int K = g.K, nt = K / BK;
    unsigned voffA[2], voffB[2];
#pragma unroll
    for (int i = 0; i < 2; ++i) { int R, C; stage_rc(tid * 16 + i * 8192, R, C); const int Rb = Epi::PERM ? ((R & ~31) + perm32(R & 31)) : R;
        voffA[i] = (unsigned)(R * K + C) * 2u; voffB[i] = (unsigned)(Rb * K + C) * 2u; }
    const size_t kstep = (size_t)(BK * 2);
    const size_t hstep = (size_t)HALF * K * 2;
    const size_t tstep = 2 * hstep;
    const unsigned ldsw = (unsigned)wid * 1024u;
    const int aoff = lds_byte(wr * 64 + fr, fq * 8), boff = lds_byte(wc * 32 + fr, fq * 8);
#define PG8_SA(b, h) (((b) * 2 + (h)) * HTB)
#define PG8_SB(b, h) ((4 + (b) * 2 + (h)) * HTB)
#define PG8_STAGE(bufoff, gbase, voff) do { _Pragma("unroll") for (int _i = 0; _i < 2; ++_i) \
        __builtin_amdgcn_global_load_lds((const unsigned*)((const char*)(gbase) + (voff)[_i]), (PG8_LAS unsigned*)(lds + (bufoff) + ldsw + _i * 8192), 16, 0, 0); } while (0)
#define PG8_LDA(dst, b, h) do { _Pragma("unroll") for (int m = 0; m < 4; ++m) _Pragma("unroll") for (int k = 0; k < 2; ++k) dst[m][k] = *(const PG8_LAS bf16x8*)(lds + PG8_SA(b, h) + aoff + m * 2048 + k * 1024); } while (0)
#define PG8_LDB(dst, b, h) do { _Pragma("unroll") for (int n = 0; n < 2; ++n) _Pragma("unroll") for (int k = 0; k < 2; ++k) dst[n][k] = *(const PG8_LAS bf16x8*)(lds + PG8_SB(b, h) + boff + n * 2048 + k * 1024); } while (0)
#define PG8_MMA(ai, bj, At, Bt) do { __builtin_amdgcn_s_setprio(1); _Pragma("unroll") for (int m = 0; m < 4; ++m) _Pragma("unroll") for (int n = 0; n < 2; ++n) _Pragma("unroll") for (int k = 0; k < 2; ++k) \
        acc[ai][bj][m][n] = __builtin_amdgcn_mfma_f32_16x16x32_bf16(Bt[n][k], At[m][k], acc[ai][bj][m][n], 0, 0, 0); __builtin_amdgcn_s_setprio(0); } while (0)
#define PG8_WAIT_V(n) asm volatile("s_waitcnt vmcnt(" #n ")" ::: "memory")
#define PG8_WAIT_L(n) asm volatile("s_waitcnt lgkmcnt(" #n ")" ::: "memory")
#define PG8_BAR __builtin_amdgcn_s_barrier()
#define PG8_SCHED __builtin_amdgcn_sched_barrier(0)
    Unit cur, nxt; int ui = 0;
    if (!S.next(0, cur)) return;
    f32x4 acc[2][2][4][2];
#pragma unroll
    for (int a = 0; a < 2; ++a)
#pragma unroll
        for (int b = 0; b < 2; ++b)
#pragma unroll
            for (int m = 0; m < 4; ++m)
#pragma unroll
                for (int n = 0; n < 2; ++n) acc[a][b][m][n] = (f32x4){0.f, 0.f, 0.f, 0.f};
    bf16x8 At[4][2], B0[2][2], B1[2][2];
    const char* cA = (const char*)g.A + (size_t)cur.pm * tstep + (size_t)cur.k0 * 2; const char* cB = (const char*)g.Bt + (size_t)cur.pn * tstep + (size_t)cur.k0 * 2;
    S.a_ready(cur);
    if constexpr (SP2) {
        PG8_STAGE(PG8_SB(0, 0), cB, voffB); PG8_STAGE(PG8_SB(0, 1), cB + hstep, voffB); PG8_STAGE(PG8_SA(0, 0), cA, voffA); PG8_STAGE(PG8_SA(0, 1), cA + hstep, voffA);
        if (wr == 1) PG8_BAR;
        PG8_WAIT_V(2); PG8_BAR;
        PG8_STAGE(PG8_SB(1, 0), cB + kstep, voffB); PG8_STAGE(PG8_SA(1, 0), cA + kstep, voffA); PG8_STAGE(PG8_SB(1, 1), cB + hstep + kstep, voffB);
        PG8_WAIT_V(6); PG8_BAR;
    } else {
        PG8_STAGE(PG8_SB(0, 0), cB, voffB); PG8_STAGE(PG8_SA(0, 0), cA, voffA); PG8_STAGE(PG8_SB(0, 1), cB + hstep, voffB); PG8_STAGE(PG8_SA(0, 1), cA + hstep, voffA);
        if (wr == 1) PG8_BAR;
        PG8_WAIT_V(4); PG8_BAR;
        PG8_STAGE(PG8_SB(1, 0), cB + kstep, voffB); PG8_STAGE(PG8_SA(1, 0), cA + kstep, voffA); PG8_STAGE(PG8_SB(1, 1), cB + hstep + kstep, voffB);
        PG8_WAIT_V(6); PG8_BAR;
    }
    for (;;) {
        const bool has_next = S.next(ui + 1, nxt);
        const char* nA = has_next ? (const char*)g.A + (size_t)nxt.pm * tstep + (size_t)nxt.k0 * 2 : cA; const char* nB = has_next ? (const char*)g.Bt + (size_t)nxt.pn * tstep + (size_t)nxt.k0 * 2 : cB;
        const int ntc = cur.nt ? cur.nt : nt;
        for (int t = 0; t < ntc; t += 2) {
            const bool last = (t == ntc - 2);
            const char* a1 = cA + (size_t)(t + 1) * kstep;
            const char* a2 = last ? nA : cA + (size_t)(t + 2) * kstep; const char* b2 = last ? nB : cB + (size_t)(t + 2) * kstep;
            const char* a3 = a2 + kstep; const char* b3 = b2 + kstep;
            if (last && has_next) S.a_ready(nxt);
            if constexpr (SP2) {
            PG8_LDB(B0, 0, 0); PG8_LDB(B1, 0, 1); PG8_SCHED; PG8_LDA(At, 0, 0); PG8_STAGE(PG8_SA(1, 1), a1 + hstep, voffA);
            PG8_WAIT_V(8); PG8_WAIT_L(0); PG8_BAR; PG8_MMA(0, 0, At, B0); PG8_MMA(0, 1, At, B1); PG8_BAR; PG8_SCHED;
            PG8_LDA(At, 0, 1); PG8_STAGE(PG8_SB(0, 0), b2, voffB); PG8_STAGE(PG8_SB(0, 1), b2 + hstep, voffB); PG8_STAGE(PG8_SA(0, 0), a2, voffA);
            PG8_WAIT_V(8); PG8_WAIT_L(0); PG8_BAR; PG8_MMA(1, 0, At, B0); PG8_MMA(1, 1, At, B1); PG8_BAR; PG8_SCHED;
            PG8_LDB(B0, 1, 0); PG8_LDB(B1, 1, 1); PG8_SCHED; PG8_LDA(At, 1, 0); PG8_STAGE(PG8_SA(0, 1), a2 + hstep, voffA);
            PG8_WAIT_V(8); PG8_WAIT_L(0); PG8_BAR; PG8_MMA(0, 0, At, B0); PG8_MMA(0, 1, At, B1); PG8_BAR; PG8_SCHED;
            PG8_LDA(At, 1, 1); PG8_STAGE(PG8_SB(1, 0), b3, voffB); PG8_STAGE(PG8_SB(1, 1), b3 + hstep, voffB); PG8_STAGE(PG8_SA(1, 0), a3, voffA);
            PG8_WAIT_V(8); PG8_WAIT_L(0); PG8_BAR; PG8_MMA(1, 0, At, B0); PG8_MMA(1, 1, At, B1); PG8_BAR; PG8_SCHED;
            } else {
            PG8_LDB(B0, 0, 0); PG8_SCHED; PG8_LDA(At, 0, 0); PG8_STAGE(PG8_SA(1, 1), a1 + hstep, voffA);
            PG8_WAIT_L(8); PG8_BAR; PG8_WAIT_L(0); PG8_MMA(0, 0, At, B0); PG8_BAR; PG8_SCHED;
            PG8_LDB(B1, 0, 1); PG8_STAGE(PG8_SB(0, 0), b2, voffB);
            PG8_BAR; PG8_WAIT_L(0); PG8_MMA(0, 1, At, B1); PG8_BAR;
            PG8_LDA(At, 0, 1); PG8_STAGE(PG8_SA(0, 0), a2, voffA);
            PG8_BAR; PG8_WAIT_L(0); PG8_MMA(1, 0, At, B0); PG8_BAR; PG8_SCHED;
            PG8_STAGE(PG8_SB(0, 1), b2 + hstep, voffB);
            PG8_WAIT_V(6); PG8_BAR; PG8_MMA(1, 1, At, B1); PG8_BAR;
            PG8_LDB(B0, 1, 0); PG8_SCHED; PG8_LDA(At, 1, 0); PG8_STAGE(PG8_SA(0, 1), a2 + hstep, voffA);
            PG8_WAIT_L(8); PG8_BAR; PG8_WAIT_L(0); PG8_MMA(0, 0, At, B0); PG8_BAR; PG8_SCHED;
            PG8_LDB(B1, 1, 1); PG8_STAGE(PG8_SB(1, 0), b3, voffB);
            PG8_BAR; PG8_WAIT_L(0); PG8_MMA(0, 1, At, B1); PG8_BAR;
            PG8_LDA(At, 1, 1); PG8_STAGE(PG8_SA(1, 0), a3, voffA);
            PG8_BAR; PG8_WAIT_L(0); PG8_MMA(1, 0, At, B0); PG8_BAR; PG8_SCHED;
            PG8_STAGE(PG8_SB(1, 1), b3 + hstep, voffB);
            PG8_WAIT_V(6); PG8_BAR; PG8_MMA(1, 1, At, B1); PG8_BAR;
            }
        }
        if constexpr (ALIGN_EPI) { if (wr == 0) PG8_BAR; }
        if constexpr (!Epi::AFTER_DRAIN) { E(acc, cur, wr, wc, fr, fq); S.done(cur); }
        if (!has_next) break;
#pragma unroll
        for (int a = 0; a < 2; ++a)
#pragma unroll
            for (int b = 0; b < 2; ++b)
#pragma unroll
                for (int m = 0; m < 4; ++m)
#pragma unroll
                    for (int n = 0; n < 2; ++n) acc[a][b][m][n] = (f32x4){0.f, 0.f, 0.f, 0.f};
        cur = nxt; cA = nA; cB = nB; ++ui;
        if constexpr (ALIGN_EPI) { if (wr == 1) PG8_BAR; }
    }
    PG8_WAIT_V(0);
    if constexpr (!ALIGN_EPI) { if (wr == 0) PG8_BAR; }
    PG8_BAR;
    if constexpr (Epi::AFTER_DRAIN) { E.fused(acc, cur, wr, wc, fr, fq, lds, wid, lane); S.done(cur); }
#undef PG8_SA
#undef PG8_SB
#undef PG8_STAGE
#undef PG8_LDA
#undef PG8_LDB
#undef PG8_MMA
#undef PG8_WAIT_V
#undef PG8_WAIT_L
#undef PG8_BAR
#undef PG8_SCHED
}
}

#define LAS __attribute__((address_space(3)))
typedef unsigned short bf16;
typedef short bf16x8 __attribute__((ext_vector_type(8)));
typedef float f32x4 __attribute__((ext_vector_type(4)));
typedef float f32x2 __attribute__((ext_vector_type(2)));
typedef float f32x16 __attribute__((ext_vector_type(16)));
typedef unsigned u32x4 __attribute__((ext_vector_type(4)));
typedef unsigned u32x2 __attribute__((ext_vector_type(2)));
using pg8::cvt_pk_bf16;
using pg8::Unit;

constexpr int D = 1024, NB = 8, TP = 2064, MP = NB * TP, NS = 128, M = MP + NS, NMT = M / 256;
constexpr int FF = 4096, NRI = 6144, HV = 2048;
constexpr float EPS = 1e-6f;
static_assert(M % 256 == 0, "rows");

constexpr size_t O_YP = 0, O_YS = 16777216, O_R0P = 16908288, O_R0S = 21102592, O_SHP = 88211456, O_SHS = 88219648,
                 O_WKP = 88350720, O_WKS = 88875008, O_CVP = 97263616, O_CVS = 97280000, O_R3P = 97542144, O_R3S = 101736448, O_END = 168845312;

constexpr size_t al(size_t x) { return (x + 4095) & ~(size_t)4095; }
constexpr size_t WS_RI0 = 4096, WS_RI1 = WS_RI0 + al((size_t)NRI * D * 2), WS_RO0 = WS_RI1 + al((size_t)NRI * D * 2), WS_RO1 = WS_RO0 + al((size_t)D * HV * 2),
                 WS_RW1 = WS_RO1 + al((size_t)D * HV * 2), WS_RW2 = WS_RW1 + al((size_t)3840 * D * 2), WS_RWO = WS_RW2 + al((size_t)3072 * 256 * 2),
                 WS_CIN = WS_RWO + al((size_t)D * D * 2), WS_COUT = WS_CIN + al((size_t)3072 * D * 2), WS_M1 = WS_COUT + al((size_t)D * D * 2),
                 WS_M2 = WS_M1 + 4 * al((size_t)FF * D * 2), WS_ROPE = WS_M2 + 4 * al((size_t)FF * D * 2), WS_H = WS_ROPE + al((size_t)2065 * 128 * 8),
                 WS_XN = WS_H + al((size_t)M * D * 4), WS_B = WS_XN + al((size_t)M * D * 2);
constexpr size_t RB_Q = WS_B, RB_K = RB_Q + al((size_t)M * D * 2), RB_KTD = RB_K + al((size_t)M * D * 2), RB_VT = RB_KTD + al((size_t)32 * 256 * TP * 2),
                 RB_VS = RB_VT + al((size_t)32 * 512 * TP * 2), RB_SG = RB_VS + al((size_t)NS * HV * 4), RB_OB = RB_SG + al((size_t)M * HV * 2),
                 RB_Y = RB_OB + al((size_t)M * HV * 2), RB_END = RB_Y + al((size_t)M * HV * 2);
constexpr size_t WB_XM = WS_B, WB_DAG = WS_B  , WB_RKV = WB_XM + al((size_t)6 * M * D * 2), WB_L1 = WB_RKV + al((size_t)3 * M * D * 4),
                 WB_YR = WB_L1 + al((size_t)3 * M * 256 * 2), WB_Y = WB_YR + al((size_t)M * D * 4), WB_END = WB_Y + al((size_t)M * D * 2);
static_assert((size_t)3 * M * D * 4 <= (size_t)6 * M * D * 2, "DAG fits over XM");
constexpr size_t CB_BC = WS_B, CB_U = CB_BC + al((size_t)M * D * 2), CB_A2 = CB_U + al((size_t)M * D * 4), CB_END = CB_A2 + al((size_t)M * D * 2);
constexpr size_t MB_ACT = WS_B, MB_END = MB_ACT + al((size_t)M * FF * 2);
constexpr size_t cmax(size_t a, size_t b) { return a > b ? a : b; }
constexpr size_t WS_END = cmax(cmax(RB_END, WB_END), cmax(CB_END, MB_END));

constexpr size_t WS_BAR = al(WS_END), WS_TOTAL = WS_BAR + 16384;
constexpr int LDS_BYTES = 147456, LDS_MISC = 131072 + 256;

#define LDS_WAIT() asm volatile("s_waitcnt lgkmcnt(0)" ::: "memory")
__device__ __forceinline__ float bf2f(bf16 x) { return __uint_as_float((unsigned)x << 16); }
__device__ __forceinline__ unsigned f2bf(float f) { unsigned u = __builtin_bit_cast(unsigned, f); return (u + 0x7fffu + ((u >> 16) & 1u)) >> 16; }
__device__ __forceinline__ unsigned pk2(float lo, float hi) { return f2bf(lo) | (f2bf(hi) << 16); }
__device__ __forceinline__ float wave_sum(float v) {
#pragma unroll
    for (int o = 1; o < 64; o <<= 1) v += __shfl_xor(v, o);
    return v;
}
template <int CTRL> __device__ __forceinline__ float dpp_add(float x) {
    const int xi = __builtin_bit_cast(int, x);
    const int yi = __builtin_amdgcn_update_dpp(0, xi, CTRL, 0xF, 0xF, false);
    return x + __builtin_bit_cast(float, yi);
}
__device__ __forceinline__ float sum4(float x) { x = dpp_add<0xB1>(x); x = dpp_add<0x4E>(x); return x; }
__device__ __forceinline__ float sum16(float x) { x = sum4(x); x = dpp_add<0x141>(x); x = dpp_add<0x140>(x); return x; }
__device__ __forceinline__ int crow(int r, int hi) { return (r & 3) + 8 * (r >> 2) + 4 * hi; }
#define MFMA32(a, b, c) __builtin_amdgcn_mfma_f32_32x32x16_bf16((a), (b), (c), 0, 0, 0)

struct StackOrder {
    pg8::StaticOrder base; int mode;
    __device__ __forceinline__ bool next(int i, Unit& u) const {
        if (!base.next(i, u)) return false;
        const int j = mode == 1 ? (u.pn < 12 ? (u.pn >> 2) : u.pn - 9) : (u.pn >> 2);
        u.pm += NMT * j; return true;
    }
    __device__ __forceinline__ void a_ready(const Unit&) const {}
    __device__ __forceinline__ void done(const Unit&) const {}
};

struct TailOrder {
    pg8::StaticOrder base; int nN, nsmall, G, c;
    __device__ __forceinline__ void init(int N, int K, int G_, int c_) { base.init(M - 256, N, G_, c_); nN = N / 256; nsmall = nN * (K / 256); G = G_; c = c_; }
    __device__ __forceinline__ bool next(int i, Unit& u) const {
        const long L = (long)i * G + c;
        if (L < base.nwg) return base.next(i, u);
        const int s = (int)(L - base.nwg); if (s >= nsmall) return false;
        u.pm = NMT - 1; u.pn = s % nN; u.k0 = (s / nN) * 256; u.nt = 4; return true;
    }
    __device__ __forceinline__ void a_ready(const Unit&) const {}
    __device__ __forceinline__ void done(const Unit&) const {}
};

#define EPI_LOOP_ROWS for (int ai = 0; ai < 2; ++ai) for (int m = 0; m < 4; ++m)
#define EPI_LOOP_COLS for (int bj = 0; bj < 2; ++bj) for (int n = 0; n < 2; ++n)

struct EpiResid {
    static constexpr bool PERM = false, AFTER_DRAIN = false;
    float* H; float sgn;
    __device__ __forceinline__ void operator()(const f32x4 (&acc)[2][2][4][2], const Unit& u, int wr, int wc, int fr, int fq) const {
        const int row0 = u.pm * 256 + wr * 64 + fr, col0 = u.pn * 256 + wc * 32 + 4 * fq;
        if (u.nt == 0) {
#pragma unroll
            EPI_LOOP_ROWS { float* rp = H + (size_t)(row0 + ai * 128 + m * 16) * D + col0;
#pragma unroll
                EPI_LOOP_COLS { f32x4* p = (f32x4*)(rp + bj * 128 + n * 16); *p = *p + acc[ai][bj][m][n] * sgn; } }
        } else {
#pragma unroll
            EPI_LOOP_ROWS { float* rp = H + (size_t)(row0 + ai * 128 + m * 16) * D + col0;
#pragma unroll
                EPI_LOOP_COLS { float* p = rp + bj * 128 + n * 16;
#pragma unroll
                    for (int i = 0; i < 4; ++i) __hip_atomic_fetch_add(p + i, acc[ai][bj][m][n][i] * sgn, __ATOMIC_RELAXED, __HIP_MEMORY_SCOPE_AGENT); } }
        }
    }
};

struct EpiRelu2 {
    static constexpr bool PERM = true, AFTER_DRAIN = false;
    bf16* O;
    __device__ __forceinline__ void operator()(const f32x4 (&acc)[2][2][4][2], const Unit& u, int wr, int wc, int fr, int fq) const {
#ifdef SKIP_EPIRELU2
        return;
#endif

        const int row0 = u.pm * 256 + wr * 64 + fr, col0 = u.pn * 256 + wc * 32 + 8 * fq;
#pragma unroll
        EPI_LOOP_ROWS { bf16* rp = O + (size_t)(row0 + ai * 128 + m * 16) * FF + col0;
#pragma unroll
            for (int bj = 0; bj < 2; ++bj) { f32x4 a = acc[ai][bj][m][0], b = acc[ai][bj][m][1];
                a = __builtin_elementwise_max(a, (f32x4){0.f, 0.f, 0.f, 0.f}); b = __builtin_elementwise_max(b, (f32x4){0.f, 0.f, 0.f, 0.f}); a = a * a; b = b * b;
                u32x4 w; w.x = cvt_pk_bf16(a[0], a[1]); w.y = cvt_pk_bf16(a[2], a[3]); w.z = cvt_pk_bf16(b[0], b[1]); w.w = cvt_pk_bf16(b[2], b[3]);
                *(u32x4*)(rp + bj * 128) = w; } }
    }
};

struct EpiRetIn {
    static constexpr bool PERM = false, AFTER_DRAIN = false;
    bf16 *Qb, *Kb, *KTD, *VT, *SG; float* VS; const float* rope;
    __device__ __forceinline__ void operator()(const f32x4 (&acc)[2][2][4][2], const Unit& u, int wr, int wc, int fr, int fq) const {
#ifdef SKIP_EPIRETIN
        return;
#endif

        const int row0 = u.pm * 256 + wr * 64 + fr, cin0 = wc * 32 + 4 * fq, pn = u.pn;
#pragma unroll
        for (int ai = 0; ai < 2; ++ai)
#pragma unroll
            for (int m = 0; m < 4; ++m) {
                const int r = row0 + ai * 128 + m * 16;
                const bool prm = r < MP; const int b = prm ? r / TP : 0; const int t = prm ? r - b * TP : 0; const int pidx = prm ? t : TP;
                if (pn < 8) {
                    const int h = pn & 3; const bool isk = pn >= 4;
                    float kdec = 1.f;
                    if (isk && prm) { const int e = t < 16 ? 15 - t : 127 - ((t - 16) & 127); kdec = __builtin_amdgcn_exp2f((float)e * __log2f(1.f - __builtin_amdgcn_exp2f(-(float)(5 + h)))); }
#pragma unroll
                    EPI_LOOP_COLS { const int d = bj * 128 + n * 16 + cin0; const f32x4 x = acc[ai][bj][m][n];
                        const f32x4 cs = *(const f32x4*)(rope + ((size_t)pidx * 128 + (d >> 1)) * 2);
                        f32x4 o; o[0] = x[0] * cs[0] - x[1] * cs[1]; o[1] = x[0] * cs[1] + x[1] * cs[0]; o[2] = x[2] * cs[2] - x[3] * cs[3]; o[3] = x[2] * cs[3] + x[3] * cs[2];
                        if (isk) o = o * 0.0625f;
                        u32x2 w; w.x = cvt_pk_bf16(o[0], o[1]); w.y = cvt_pk_bf16(o[2], o[3]);
                        *(u32x2*)((isk ? Kb : Qb) + (size_t)r * D + h * 256 + d) = w;
                        if (isk && prm) { bf16* kp = KTD + ((size_t)((b * 4 + h) * 256 + d)) * TP + t;
                            kp[0] = (bf16)f2bf(o[0] * kdec); kp[TP] = (bf16)f2bf(o[1] * kdec); kp[2 * TP] = (bf16)f2bf(o[2] * kdec); kp[3 * TP] = (bf16)f2bf(o[3] * kdec); } }
                } else if (pn < 16) {
                    const int h = (pn - 8) >> 1, e0 = ((pn - 8) & 1) * 256;
#pragma unroll
                    EPI_LOOP_COLS { const int e = e0 + bj * 128 + n * 16 + cin0; const f32x4 x = acc[ai][bj][m][n];
                        if (prm) { bf16* vp = VT + ((size_t)((b * 4 + h) * 512 + e)) * TP + t;
                            vp[0] = (bf16)f2bf(x[0]); vp[TP] = (bf16)f2bf(x[1]); vp[2 * TP] = (bf16)f2bf(x[2]); vp[3 * TP] = (bf16)f2bf(x[3]); }
                        else *(f32x4*)(VS + (size_t)(r - MP) * HV + h * 512 + e) = x; }
                } else {
                    const int c0 = (pn - 16) * 256;
#pragma unroll
                    EPI_LOOP_COLS { const int c = c0 + bj * 128 + n * 16 + cin0; const f32x4 x = acc[ai][bj][m][n]; f32x4 o;
#pragma unroll
                        for (int i = 0; i < 4; ++i) o[i] = x[i] / (1.f + __expf(-x[i]));
                        u32x2 w; w.x = cvt_pk_bf16(o[0], o[1]); w.y = cvt_pk_bf16(o[2], o[3]);
                        *(u32x2*)(SG + (size_t)r * HV + c) = w; }
                }
            }
    }
};

struct EpiRw1 {
    static constexpr bool PERM = false, AFTER_DRAIN = false;
    float* RKV; bf16* L1;
    __device__ __forceinline__ void operator()(const f32x4 (&acc)[2][2][4][2], const Unit& u, int wr, int wc, int fr, int fq) const {
#ifdef SKIP_EPIRW1
        return;
#endif

        const int pmr = u.pm % NMT, row0 = pmr * 256 + wr * 64 + fr, cin0 = wc * 32 + 4 * fq, pn = u.pn;
        if (pn < 12) {
            float* base = RKV + (size_t)(pn >> 2) * M * D + (pn & 3) * 256 + cin0;
#pragma unroll
            EPI_LOOP_ROWS { float* rp = base + (size_t)(row0 + ai * 128 + m * 16) * D;
#pragma unroll
                EPI_LOOP_COLS *(f32x4*)(rp + bj * 128 + n * 16) = acc[ai][bj][m][n]; }
        } else {
            const int j = pn - 12; bf16* base = L1 + (size_t)j * M * 256 + cin0;
#pragma unroll
            for (int ai = 0; ai < 2; ++ai)
#pragma unroll
                for (int m = 0; m < 4; ++m) { bf16* rp = base + (size_t)(row0 + ai * 128 + m * 16) * 256;
#pragma unroll
                    EPI_LOOP_COLS { const f32x4 x = acc[ai][bj][m][n]; f32x4 o;
#pragma unroll
                        for (int i = 0; i < 4; ++i) o[i] = j == 0 ? tanhf(x[i]) : (j == 1 ? x[i] : 1.f / (1.f + __expf(-x[i])));
                        u32x2 w; w.x = cvt_pk_bf16(o[0], o[1]); w.y = cvt_pk_bf16(o[2], o[3]);
                        *(u32x2*)(rp + bj * 128 + n * 16) = w; } }
        }
    }
};

struct EpiRw2 {
    static constexpr bool PERM = false, AFTER_DRAIN = false;
    float* DAG; const float *w0, *a0;
    __device__ __forceinline__ void operator()(const f32x4 (&acc)[2][2][4][2], const Unit& u, int wr, int wc, int fr, int fq) const {
#ifdef SKIP_EPIRW2
        return;
#endif
        const int pmr = u.pm % NMT, row0 = pmr * 256 + wr * 64 + fr, pn = u.pn, j = pn >> 2, col0 = (pn & 3) * 256 + wc * 32 + 4 * fq;
        float* base = DAG + (size_t)j * M * D + (size_t)row0 * D + col0;
        const float* bias = j == 0 ? w0 : a0;
#pragma unroll
        EPI_LOOP_COLS { const int cc = bj * 128 + n * 16;
            f32x4 bb = (f32x4){0.f, 0.f, 0.f, 0.f}; if (j < 2) bb = *(const f32x4*)(bias + col0 + cc);
#pragma unroll
            EPI_LOOP_ROWS { const f32x4 x = acc[ai][bj][m][n] + bb; f32x4 o;
                if (j == 0) {
#pragma unroll
                    for (int i = 0; i < 4; ++i) { const float z = -x[i]; const float sp = fmaxf(z, 0.f) + __logf(1.f + __expf(-fabsf(z))); o[i] = __expf(-__expf(-sp - 0.5f)); } }
                else if (j == 1) {
#pragma unroll
                    for (int i = 0; i < 4; ++i) o[i] = 1.f / (1.f + __expf(-x[i])); }
                else o = x;
                if (j == 2) { u32x2 wv; wv.x = cvt_pk_bf16(o[0], o[1]); wv.y = cvt_pk_bf16(o[2], o[3]); *(u32x2*)((bf16*)(DAG + (size_t)2 * M * D) + (size_t)(row0 + ai * 128 + m * 16) * D + col0 + cc) = wv; }
                else *(f32x4*)(base + (size_t)(ai * 128 + m * 16) * D + cc) = o; }
            asm volatile("" ::: "memory"); }
    }
};

struct EpiConvIn {
    static constexpr bool PERM = false, AFTER_DRAIN = false;
    bf16* BC; float* U;
    __device__ __forceinline__ void operator()(const f32x4 (&acc)[2][2][4][2], const Unit& u, int wr, int wc, int fr, int fq) const {
#ifdef SKIP_EPICONVIN
        return;
#endif

        const int row0 = u.pm * 256 + wr * 64 + fr, cin0 = wc * 32 + 4 * fq, pn = u.pn;
        if (pn < 4) {
#pragma unroll
            EPI_LOOP_ROWS { bf16* rp = BC + (size_t)(row0 + ai * 128 + m * 16) * D + pn * 256 + cin0;
#pragma unroll
                EPI_LOOP_COLS { const f32x4 x = acc[ai][bj][m][n]; u32x2 w; w.x = cvt_pk_bf16(x[0], x[1]); w.y = cvt_pk_bf16(x[2], x[3]); *(u32x2*)(rp + bj * 128 + n * 16) = w; } }
        } else {
#pragma unroll
            EPI_LOOP_ROWS { float* rp = U + (size_t)(row0 + ai * 128 + m * 16) * D + (pn - 4) * 128 + cin0;
#pragma unroll
                for (int n = 0; n < 2; ++n) *(f32x4*)(rp + n * 16) = acc[ai][0][m][n] * acc[ai][1][m][n]; }
        }
    }
};

__device__ __forceinline__ void tr_item(const float* W, int K, int N, bf16* WT, int ldk, int drow0, int k0, int n0, LAS bf16* scr, int lane) {
    f32x4 v[16];
    const int nl = (lane & 15) * 4, kq = lane >> 4, n = n0 + nl;
#pragma unroll
    for (int i = 0; i < 16; ++i) { const int k = k0 + 4 * i + kq; v[i] = (k < K && n < N) ? *(const f32x4*)(W + (size_t)k * N + n) : (f32x4){0.f, 0.f, 0.f, 0.f}; }
#pragma unroll
    for (int i = 0; i < 16; ++i) { const int kl = 4 * i + kq;
#pragma unroll
        for (int j = 0; j < 4; ++j) scr[(nl + j) * 72 + kl] = (bf16)f2bf(v[i][j]); }
    LDS_WAIT(); asm volatile("" ::: "memory");
    const int c = lane & 7;
#pragma unroll
    for (int q = 0; q < 8; ++q) { const int nr = q * 8 + (lane >> 3);
        const u32x4 o = *(const LAS u32x4*)(scr + nr * 72 + 8 * c);
        *(u32x4*)(WT + (size_t)(drow0 + nr) * ldk + k0 + 8 * c) = o; }
    LDS_WAIT(); asm volatile("" ::: "memory");
}
__device__ __forceinline__ int cin_row(int n0) { if (n0 < 1024) return n0; if (n0 < 2048) { const int j = n0 - 1024; return 1024 + (j >> 7) * 256 + (j & 127); } const int j = n0 - 2048; return 1024 + (j >> 7) * 256 + 128 + (j & 127); }

__device__ __forceinline__ void rms_row(const float* xrow, const float* gain, int lane, f32x4 (&v)[4]) {
    const f32x4* xr = (const f32x4*)xrow + lane; const f32x4* gr = (const f32x4*)gain + lane; float s = 0.f;
#pragma unroll
    for (int j = 0; j < 4; ++j) { v[j] = xr[64 * j]; s += (v[j].x * v[j].x + v[j].y * v[j].y) + (v[j].z * v[j].z + v[j].w * v[j].w); }
    const float rstd = 1.0f / sqrtf(wave_sum(s) * (1.f / D) + EPS);
#pragma unroll
    for (int j = 0; j < 4; ++j) v[j] = v[j] * rstd * gr[64 * j];
}
__device__ __forceinline__ void rms_row2(const float* x0, const float* x1, const float* gain, int lane, f32x4 (&v0)[4], f32x4 (&v1)[4]) {
    const f32x4* p0 = (const f32x4*)x0 + lane; const f32x4* p1 = (const f32x4*)x1 + lane; const f32x4* gr = (const f32x4*)gain + lane; float s0 = 0.f, s1 = 0.f;
#pragma unroll
    for (int j = 0; j < 4; ++j) { v0[j] = p0[64 * j]; v1[j] = p1[64 * j]; }
#pragma unroll
    for (int j = 0; j < 4; ++j) { s0 += (v0[j].x * v0[j].x + v0[j].y * v0[j].y) + (v0[j].z * v0[j].z + v0[j].w * v0[j].w); s1 += (v1[j].x * v1[j].x + v1[j].y * v1[j].y) + (v1[j].z * v1[j].z + v1[j].w * v1[j].w); }
#pragma unroll
    for (int o = 1; o < 64; o <<= 1) { s0 += __shfl_xor(s0, o); s1 += __shfl_xor(s1, o); }
    const float r0 = 1.0f / sqrtf(s0 * (1.f / D) + EPS), r1 = 1.0f / sqrtf(s1 * (1.f / D) + EPS);
#pragma unroll
    for (int j = 0; j < 4; ++j) { const f32x4 g = gr[64 * j]; v0[j] = v0[j] * r0 * g; v1[j] = v1[j] * r1 * g; }
}
__device__ __forceinline__ void store_row_bf16(bf16* orow, int lane, const f32x4 (&v)[4]) {
    u32x2* o8 = (u32x2*)orow + lane;
#pragma unroll
    for (int j = 0; j < 4; ++j) { u32x2 w; w.x = pk2(v[j].x, v[j].y); w.y = pk2(v[j].z, v[j].w); o8[64 * j] = w; }
}

#define XB_TMO      128
#define XB_XCNT(j)  (256  + 64 * (j))
#define XB_XSUB(j)  (1280 + 64 * (j))
#define XB_XGEN(j)  (2304 + 64 * (j))
#define XB_TOP      3328
#define XB_TOPGEN   3392
#define XCD_BAR_WORDS 3456
#define XB_SPIN_CAP (1u << 18)

__device__ __forceinline__ unsigned xb_ld(unsigned* p)              { return __hip_atomic_load(p, __ATOMIC_RELAXED, __HIP_MEMORY_SCOPE_AGENT); }
__device__ __forceinline__ unsigned xb_add(unsigned* p, unsigned v) { return __hip_atomic_fetch_add(p, v, __ATOMIC_RELAXED, __HIP_MEMORY_SCOPE_AGENT); }
__device__ __forceinline__ unsigned xb_xcc_id() { return (unsigned)__builtin_amdgcn_s_getreg((3 << 11) | 20) & 0xFu; }
#define XB_SPIN(cond, bar) do { unsigned _sp = 0; while (cond) { __builtin_amdgcn_s_sleep(1); \
    if ((++_sp & 255u) == 0u) { if (xb_ld(&(bar)[XB_TMO])) break; if (_sp > XB_SPIN_CAP) { atomicAdd(&(bar)[XB_TMO], 1u); break; } } } } while (0)

struct XcdBarrier {
    unsigned* bar; unsigned x;
    volatile LAS unsigned* st;
};

__device__ __forceinline__ XcdBarrier xcd_barrier_post(unsigned* bar, volatile LAS unsigned* st) {
    XcdBarrier b; b.bar = bar; b.x = xb_xcc_id(); b.st = st;
    if (threadIdx.x == 0) (void)xb_add(&bar[XB_XCNT(b.x)], 1u);
    return b;
}
__device__ __forceinline__ void xcd_barrier_complete(unsigned* bar, unsigned x, unsigned& nloc, unsigned& nx) {
    const unsigned G = gridDim.x * gridDim.y * gridDim.z;
    unsigned sum, cnt, mine, sp = 0u;
    for (;;) {
        sum = 0u; cnt = 0u; mine = 0u;
#pragma unroll
        for (unsigned j = 0; j < 16; ++j) { const unsigned c = xb_ld(&bar[XB_XCNT(j)]); sum += c; cnt += (c > 0u) ? 1u : 0u; mine = (j == x) ? c : mine; }
        if (sum == G) break;
        __builtin_amdgcn_s_sleep(1);
        if ((++sp & 255u) == 0u) { if (xb_ld(&bar[XB_TMO])) break; if (sp > XB_SPIN_CAP) { atomicAdd(&bar[XB_TMO], 1u); break; } }
    }
    nloc = mine > 0u ? mine : 1u; nx = cnt > 0u ? cnt : 1u;
}

__device__ __forceinline__ void xcd_barrier(const XcdBarrier& b) {
    asm volatile("s_waitcnt vmcnt(0)" ::: "memory");
    __syncthreads();
    if (threadIdx.x == 0) {
        unsigned* bar = b.bar;
        __builtin_amdgcn_s_waitcnt(0);
        unsigned nloc = b.st[0], nx = b.st[1];
        if (nloc == 0u) { xcd_barrier_complete(bar, b.x, nloc, nx); b.st[0] = nloc; b.st[1] = nx; }
        const unsigned old = xb_add(&bar[XB_XSUB(b.x)], 1u);
        const unsigned gen = old / nloc;
        if (old + 1u == (gen + 1u) * nloc) {
            __builtin_amdgcn_fence(__ATOMIC_RELEASE, "agent");
            asm volatile("s_waitcnt vmcnt(0)" ::: "memory");
            const unsigned og = xb_add(&bar[XB_TOP], 1u);
            const unsigned tg = og / nx;
            if (og + 1u == (tg + 1u) * nx) xb_add(&bar[XB_TOPGEN], 1u);
            else XB_SPIN(xb_ld(&bar[XB_TOPGEN]) == tg, bar);
            __builtin_amdgcn_fence(__ATOMIC_ACQUIRE, "agent");
            xb_add(&bar[XB_XGEN(b.x)], 1u);
            asm volatile("s_waitcnt vmcnt(0)" ::: "memory");
        } else {
            XB_SPIN(xb_ld(&bar[XB_XGEN(b.x)]) == gen, bar);
            __builtin_amdgcn_fence(__ATOMIC_ACQUIRE, "agent");
            asm volatile("s_waitcnt vmcnt(0)" ::: "memory");
        }
    }
    __syncthreads();
}

struct KArgs { const float* in[34]; float* out; unsigned char* ws; int ph_lo, ph_hi, coop, pad; int rep[8]; };

__global__ void __launch_bounds__(512, 2) fwd_kernel(KArgs a) {
    extern __shared__ __attribute__((aligned(16))) unsigned char lds_raw[];
    LAS unsigned char* lds = (LAS unsigned char*)lds_raw;
    cg::grid_group grid = cg::this_grid();
    const int tid0 = threadIdx.x, wave = __builtin_amdgcn_readfirstlane(tid0 >> 6);
    const int G = gridDim.x, bid = blockIdx.x, gw = bid * 8 + wave, NGW = G * 8;
    unsigned char* ws = a.ws; float* out = a.out;
    float* H = (float*)(ws + WS_H); bf16* XN = (bf16*)(ws + WS_XN);
    const float* rope = (const float*)(ws + WS_ROPE);
    const int lo = a.ph_lo, hi = a.ph_hi; const bool coop = a.coop != 0;
    volatile LAS unsigned* MISC = (volatile LAS unsigned*)(lds + LDS_MISC);
    if (tid0 == 0) { MISC[0] = 0u; MISC[1] = 0u; }
    __syncthreads();
    XcdBarrier xbar = xcd_barrier_post((unsigned*)(ws + WS_BAR), MISC);
    int pc = 0;
#define PH_BEGIN(cat) if (pc >= lo && pc < hi) { for (int rep_ = 0; rep_ < a.rep[cat]; ++rep_) { int tid = tid0; asm volatile("" : "+v"(tid)); const int lane = tid & 63; (void)lane;
#define PH_END   __syncthreads(); } if (coop && pc + 1 < hi) { if (a.coop == 2) grid.sync();     \
        xcd_barrier(xbar); if (a.rep[5] > 1) xcd_barrier(xbar); } } ++pc;

    PH_BEGIN(0)
    {
        LAS bf16* scr = (LAS bf16*)(lds + wave * 9216);
        for (int it = gw; ; it += NGW) {
            int r = it; bool did = false; const float* jW = nullptr; bf16* jWT = nullptr; int jK = 0, jN = 0, jld = 0, jrow = 0, jk0 = 0, jn0 = 0;
#define TRJOB(Wp, K_, N_, KP_, NP_, WTp, LDK_, ROWEXPR) if (!did) { const int nnb = (NP_) / 64, cnt = ((KP_) / 64) * nnb; \
                if (r < cnt) { const int kb = r / nnb, nb = r - kb * nnb, n0 = nb * 64; jW = (Wp); jK = (K_); jN = (N_); jWT = (WTp); jld = (LDK_); jrow = (ROWEXPR) + n0; jk0 = kb * 64; jn0 = n0; did = true; } else r -= cnt; }
            TRJOB(a.in[11], D, NRI, D, NRI, (bf16*)(ws + WS_RI0), D, 0)
            TRJOB(a.in[11] + (size_t)D * NRI, D, NRI, D, NRI, (bf16*)(ws + WS_RI1), D, 0)
            TRJOB(a.in[12], HV, D, HV, D, (bf16*)(ws + WS_RO0), HV, 0)
            TRJOB(a.in[12] + (size_t)HV * D, HV, D, HV, D, (bf16*)(ws + WS_RO1), HV, 0)
            TRJOB(a.in[14], D, D, D, D, (bf16*)(ws + WS_RW1), D, 0)
            TRJOB(a.in[14] + (size_t)D * D, D, D, D, D, (bf16*)(ws + WS_RW1), D, 1024)
            TRJOB(a.in[14] + (size_t)2 * D * D, D, D, D, D, (bf16*)(ws + WS_RW1), D, 2048)
            TRJOB(a.in[16], D, 64, D, 256, (bf16*)(ws + WS_RW1), D, 3072)
            TRJOB(a.in[19], D, 64, D, 256, (bf16*)(ws + WS_RW1), D, 3328)
            TRJOB(a.in[21], D, 160, D, 256, (bf16*)(ws + WS_RW1), D, 3584)
            TRJOB(a.in[17], 64, D, 256, D, (bf16*)(ws + WS_RW2), 256, 0)
            TRJOB(a.in[20], 64, D, 256, D, (bf16*)(ws + WS_RW2), 256, 1024)
            TRJOB(a.in[22], 160, D, 256, D, (bf16*)(ws + WS_RW2), 256, 2048)
            TRJOB(a.in[28], D, D, D, D, (bf16*)(ws + WS_RWO), D, 0)
            TRJOB(a.in[29], D, 3072, D, 3072, (bf16*)(ws + WS_CIN), D, cin_row(n0) - n0)
            TRJOB(a.in[31], D, D, D, D, (bf16*)(ws + WS_COUT), D, 0)
#pragma unroll 1
            for (int l = 0; l < 4; ++l) {
                TRJOB(a.in[32] + (size_t)l * D * FF, D, FF, D, FF, (bf16*)(ws + WS_M1 + (size_t)l * al((size_t)FF * D * 2)), D, 0)
                TRJOB(a.in[33] + (size_t)l * D * FF, FF, D, FF, D, (bf16*)(ws + WS_M2 + (size_t)l * al((size_t)FF * D * 2)), FF, 0)
            }
#undef TRJOB
            if (!did) break;
            tr_item(jW, jK, jN, jWT, jld, jrow, jk0, jn0, scr, lane);
        }
        for (int e = bid * 512 + tid; e < 2065 * 128; e += G * 512) {
            const int p = e >> 7, i = e & 127;
            const float x = (float)i / 127.0f;
            const float inv = 1.0f / (float)exp((double)x * 9.210340371976184);
            const float ang = (float)(p == TP ? 16384 : p) * inv;
            double rev = (double)ang * 0.15915494309189535; rev -= rint(rev);
            const float fr = (float)rev;
            ((f32x2*)(ws + WS_ROPE))[e] = (f32x2){__builtin_amdgcn_cosf(fr), __builtin_amdgcn_sinf(fr)};
        }
        for (int m = gw; m < M; m += NGW) {
            const float* src;
            if (m < MP) { const int b = m / TP, t = m - b * TP; src = t < 16 ? a.in[7] + (size_t)t * D : a.in[0] + ((size_t)b * 2048 + (t - 16)) * D; }
            else src = a.in[1] + (size_t)(m - MP) * D;
            const f32x4* xr = (const f32x4*)src + lane; f32x4* hr = (f32x4*)(H + (size_t)m * D) + lane;
#pragma unroll
            for (int j = 0; j < 4; ++j) hr[64 * j] = xr[64 * j];
            f32x4 v[4]; rms_row(src, a.in[8], lane, v); store_row_bf16(XN + (size_t)m * D, lane, v);
        }
    }
    PH_END

#pragma unroll 1
    for (int layer = 0; layer < 4; ++layer) {
        const int kind = layer % 3;
        const bf16* outA; const bf16* outB; int outK;
        if (kind == 0) {
            const int jr = layer / 3;
            bf16 *Qb = (bf16*)(ws + RB_Q), *Kb = (bf16*)(ws + RB_K), *KTD = (bf16*)(ws + RB_KTD), *VT = (bf16*)(ws + RB_VT), *SG = (bf16*)(ws + RB_SG), *OB = (bf16*)(ws + RB_OB), *Y = (bf16*)(ws + RB_Y);
            float* VS = (float*)(ws + RB_VS);
            outA = Y; outB = (const bf16*)(ws + (jr ? WS_RO1 : WS_RO0)); outK = HV;
            PH_BEGIN(4)
            {
                pg8::Gemm g{XN, (const bf16*)(ws + (jr ? WS_RI1 : WS_RI0)), M, NRI, D}; pg8::StaticOrder S; S.init(M, NRI, G, bid);
                EpiRetIn E{Qb, Kb, KTD, VT, SG, VS, rope};
                pg8::gemm_phase<EpiRetIn, pg8::StaticOrder, true, true>(lds, g, S, E);
            }
            PH_END
            PH_BEGIN(1)
            {
                const float* S0in = a.in[jr ? 6 : 2];
                float* Sp_out = out + (jr ? O_R3P : O_R0P); float* Ss_out = out + (jr ? O_R3S : O_R0S);
                const int l32 = lane & 31, hi = lane >> 5, w = wave;
                LAS bf16* P = (LAS bf16*)lds;
                LAS bf16* ST = (LAS bf16*)(lds + 34816);
                for (int item = bid; item < 256; item += G) {
                    const int b = item >> 5, h = (item >> 3) & 3, es = item & 7;
                    const float lg2 = __log2f(1.f - __builtin_amdgcn_exp2f(-(float)(5 + h)));
                    const unsigned char* qbytes = (const unsigned char*)(Qb + (size_t)(b * TP) * D + h * 256);
                    const unsigned char* kbytes = (const unsigned char*)(Kb + (size_t)(b * TP) * D + h * 256);
                    const bf16* ktd = KTD + (size_t)((b * 4 + h) * 256) * TP;
                    const bf16* vt = VT + (size_t)((b * 4 + h) * 512 + es * 64) * TP;
                    LAS unsigned char* QH = lds;
                    LAS unsigned char* KH = lds + 34816;
                    LAS unsigned char* STb = lds + 69632;
                    LAS unsigned char* VTs = lds + 103424;
                    f32x16 S2[2];
#pragma unroll
                    for (int i = 0; i < 16; ++i) { S2[0][i] = 0.f; S2[1][i] = 0.f; }
                    for (int i = tid; i < 33792 / 16; i += 512) *(LAS u32x4*)(STb + i * 16) = (u32x4){0u, 0u, 0u, 0u};
                    const u32x4 z4 = {0u, 0u, 0u, 0u};
                    u32x4 rq[4], rk[4], rv[2];
#define RET_T0(cc) ((cc) == 0 ? 0 : 16 + 128 * ((cc) - 1))
#define RET_L(cc)  ((cc) == 0 ? 16 : 128)
#define LOADQK(cc, dh) do { const int t0c_ = RET_T0(cc), Lc_ = RET_L(cc); _Pragma("unroll") for (int i_ = 0; i_ < 4; ++i_) { const int id_ = tidc + 512 * i_, row_ = id_ >> 4, c16_ = id_ & 15; const bool ok_ = row_ < Lc_; \
        const size_t off_ = (size_t)(t0c_ + (ok_ ? row_ : 0)) * 2048 + (dh) * 256 + c16_ * 16; rq[i_] = *(const u32x4*)(qbytes + off_); rk[i_] = *(const u32x4*)(kbytes + off_); if (!ok_) { rq[i_] = z4; rk[i_] = z4; } } } while (0)
#define STOREQK() do { _Pragma("unroll") for (int i_ = 0; i_ < 4; ++i_) { const int id_ = tidc + 512 * i_, row_ = id_ >> 4, c16_ = id_ & 15; *(LAS u32x4*)(QH + row_ * 272 + c16_ * 16) = rq[i_]; *(LAS u32x4*)(KH + row_ * 272 + c16_ * 16) = rk[i_]; } } while (0)
#define LOADV(cc) do { const int t0c_ = RET_T0(cc), Lc_ = RET_L(cc); _Pragma("unroll") for (int i_ = 0; i_ < 2; ++i_) { const int id_ = tidc + 512 * i_, row_ = id_ >> 4, c16_ = id_ & 15; const bool ok_ = c16_ * 8 < Lc_; \
        rv[i_] = *(const u32x4*)(vt + (size_t)row_ * TP + t0c_ + (ok_ ? c16_ * 8 : 0)); if (!ok_) rv[i_] = z4; } } while (0)
#define STOREV() do { _Pragma("unroll") for (int i_ = 0; i_ < 2; ++i_) { const int id_ = tidc + 512 * i_, row_ = id_ >> 4, c16_ = id_ & 15; *(LAS u32x4*)(VTs + row_ * 272 + c16_ * 16) = rv[i_]; } } while (0)
                    { const int tidc = tid; LOADQK(0, 0); LOADV(0); }
                    const int lt = w >> 1, ei = w & 1;
                    __syncthreads();
#pragma unroll 1
                    for (int c = 0; c < 17; ++c) {
                        const int t0 = RET_T0(c), L = RET_L(c);
                        int tl_ = tid; asm volatile("" : "+v"(tl_));
                        const int tidc = tl_, l32 = tidc & 31, hi = (tidc >> 5) & 1, lrow = 32 * lt + l32, erow = 32 * ei + l32;
                        const bool act = 32 * lt < L;
                        f32x16 accP[2], aX;
#pragma unroll
                        for (int i = 0; i < 16; ++i) { accP[0][i] = 0.f; accP[1][i] = 0.f; aX[i] = 0.f; }
#pragma unroll
                        for (int dh = 0; dh < 2; ++dh) {
                            STOREQK(); if (dh == 0) STOREV();
                            if (dh == 0) LOADQK(c, 1); else if (c < 16) { LOADQK(c + 1, 0); LOADV(c + 1); }
                            __syncthreads();
                            if (act) {
                                const LAS unsigned char* qrow = QH + lrow * 272 + 16 * hi;
#pragma unroll
                                for (int j = 0; j < 2; ++j) { const int mt = 2 * (w & 1) + j;
                                    if (mt <= lt && 32 * mt < L) { const LAS unsigned char* krow = KH + (32 * mt + l32) * 272 + 16 * hi;
#pragma unroll 4
                                        for (int s = 0; s < 8; ++s) { const bf16x8 kf = *(const LAS bf16x8*)(krow + 32 * s), qf = *(const LAS bf16x8*)(qrow + 32 * s); accP[j] = MFMA32(kf, qf, accP[j]); } } }
                                const LAS unsigned char* srow = STb + erow * 528 + 256 * dh + 16 * hi;
#pragma unroll 4
                                for (int s = 0; s < 8; ++s) { const bf16x8 sf = *(const LAS bf16x8*)(srow + 32 * s), qf = *(const LAS bf16x8*)(qrow + 32 * s); aX = MFMA32(sf, qf, aX); }
                            }
                            __syncthreads();
                        }
                        bf16x8 kc[8];
                        { const bf16* kp = ktd + (size_t)(32 * w + l32) * TP + t0 + 8 * hi; const int nkc = L >> 4;
#pragma unroll
                          for (int s = 0; s < 8; ++s) kc[s] = *(const bf16x8*)(kp + (s < nkc ? 16 * s : 0)); }
                        if (act) {
#pragma unroll
                            for (int j = 0; j < 2; ++j) { const int mt = 2 * (w & 1) + j;
                                if (mt <= lt && 32 * mt < L) {
#pragma unroll
                                    for (int gq = 0; gq < 4; ++gq) { float o[4];
#pragma unroll
                                        for (int i = 0; i < 4; ++i) { const int mm = 32 * mt + 8 * gq + 4 * hi + i; const int df = lrow - mm;
                                            o[i] = df >= 0 ? accP[j][gq * 4 + i] * __builtin_amdgcn_exp2f((float)df * lg2) : 0.f; }
                                        u32x2 wv; wv.x = cvt_pk_bf16(o[0], o[1]); wv.y = cvt_pk_bf16(o[2], o[3]);
                                        *(LAS u32x2*)(KH + lrow * 272 + (32 * mt + 8 * gq + 4 * hi) * 2) = wv; } } }
                        }
                        __syncthreads();
                        if (act) {
                            f32x16 aI;
#pragma unroll
                            for (int i = 0; i < 16; ++i) aI[i] = 0.f;
                            const int nk = (32 * (lt + 1) < L ? 32 * (lt + 1) : L) >> 4;
#pragma unroll 2
                            for (int s = 0; s < nk; ++s) { const bf16x8 fa = *(const LAS bf16x8*)(VTs + erow * 272 + (16 * s + 8 * hi) * 2), fb = *(const LAS bf16x8*)(KH + lrow * 272 + (16 * s + 8 * hi) * 2); aI = MFMA32(fa, fb, aI); }
                            const float qd = __builtin_amdgcn_exp2f((float)(lrow + 1) * lg2);
                            if (lrow < L) {
                                bf16* op = OB + (size_t)(b * TP + t0 + lrow) * HV + h * 512 + es * 64 + 32 * ei + 4 * hi;
#pragma unroll
                                for (int gq = 0; gq < 4; ++gq) {
                                    u32x2 wv; wv.x = cvt_pk_bf16(aI[gq * 4 + 0] + qd * aX[gq * 4 + 0], aI[gq * 4 + 1] + qd * aX[gq * 4 + 1]);
                                    wv.y = cvt_pk_bf16(aI[gq * 4 + 2] + qd * aX[gq * 4 + 2], aI[gq * 4 + 3] + qd * aX[gq * 4 + 3]);
                                    *(u32x2*)(op + 8 * gq) = wv; }
                            }
                        }
                        {
                            const float gl = __builtin_amdgcn_exp2f((float)L * lg2);
                            S2[0] = S2[0] * gl; S2[1] = S2[1] * gl;
                            const int nkc = L >> 4;
#pragma unroll
                            for (int s = 0; s < 8; ++s) if (s < nkc) {
                                const bf16x8 fb0 = *(const LAS bf16x8*)(VTs + l32 * 272 + (16 * s + 8 * hi) * 2), fb1 = *(const LAS bf16x8*)(VTs + (32 + l32) * 272 + (16 * s + 8 * hi) * 2);
                                S2[0] = MFMA32(kc[s], fb0, S2[0]); S2[1] = MFMA32(kc[s], fb1, S2[1]); }
                        }
                        __syncthreads();
                        if (c < 16) {
#pragma unroll
                            for (int e2 = 0; e2 < 2; ++e2)
#pragma unroll
                                for (int gq = 0; gq < 4; ++gq) {
                                    u32x2 wv; wv.x = cvt_pk_bf16(S2[e2][gq * 4 + 0], S2[e2][gq * 4 + 1]); wv.y = cvt_pk_bf16(S2[e2][gq * 4 + 2], S2[e2][gq * 4 + 3]);
                                    *(LAS u32x2*)(STb + (32 * e2 + l32) * 528 + (32 * w + 8 * gq + 4 * hi) * 2) = wv; }
                        }
                    }
#undef LOADQK
#undef STOREQK
#undef LOADV
#undef STOREV
                    {
                        float* sp = Sp_out + (size_t)((b * 4 + h) * 256) * 512 + es * 64 + l32;
#pragma unroll
                        for (int e2 = 0; e2 < 2; ++e2)
#pragma unroll
                            for (int r = 0; r < 16; ++r) sp[(size_t)(32 * w + crow(r, hi)) * 512 + 32 * e2] = S2[e2][r];
                    }
                    __syncthreads();
                }
                {
                    LAS float* qk = (LAS float*)(lds + 69632);
                    LAS float* ored = (LAS float*)(lds + 69632 + 2048);
                    for (int item = bid; item < NS * 4; item += G) {
                        const int s = item >> 2, h = item & 3;
                        const float gamma = 1.f - __builtin_amdgcn_exp2f(-(float)(5 + h));
                        __syncthreads();
                        { const int which = tid >> 8, dd = tid & 255; qk[tid] = bf2f((which ? Kb : Qb)[(size_t)(MP + s) * D + h * 256 + dd]); }
                        __syncthreads();
                        const int e4 = (tid & 127) * 4, dg = tid >> 7;
                        const f32x4 v4 = *(const f32x4*)(VS + (size_t)s * HV + h * 512 + e4);
                        const float* sin_ = S0in + (size_t)(s * 4 + h) * 256 * 512 + e4; float* sout = Ss_out + (size_t)(s * 4 + h) * 256 * 512 + e4;
                        f32x4 o4 = {0.f, 0.f, 0.f, 0.f};
#pragma unroll 16
                        for (int i = 0; i < 64; ++i) { const int d = dg * 64 + i;
                            const f32x4 sv = __builtin_nontemporal_load((const f32x4*)(sin_ + (size_t)d * 512));
                            const f32x4 sn = sv * gamma + v4 * qk[256 + d];
                            __builtin_nontemporal_store(sn, (f32x4*)(sout + (size_t)d * 512));
                            o4 = o4 + sn * qk[d]; }
                        *(LAS f32x4*)(ored + dg * 512 + e4) = o4;
                        __syncthreads();
                        if (tid < 128) { const f32x4 r = *(LAS f32x4*)(ored + e4) + *(LAS f32x4*)(ored + 512 + e4) + *(LAS f32x4*)(ored + 1024 + e4) + *(LAS f32x4*)(ored + 1536 + e4);
                            u32x2 wv; wv.x = cvt_pk_bf16(r[0], r[1]); wv.y = cvt_pk_bf16(r[2], r[3]);
                            *(u32x2*)(OB + (size_t)(MP + s) * HV + h * 512 + e4) = wv; }
                    }
                }
            }
            PH_END
            PH_BEGIN(3)
            {
                for (int m = gw; m < M; m += NGW) {
                    const u32x4* op = (const u32x4*)(OB + (size_t)m * HV) + lane * 4; const u32x4* gp = (const u32x4*)(SG + (size_t)m * HV) + lane * 4;
                    u32x4 ov[4]; float ss = 0.f;
#pragma unroll
                    for (int j = 0; j < 4; ++j) { ov[j] = op[j];
#pragma unroll
                        for (int i = 0; i < 4; ++i) { const float x0 = __uint_as_float(ov[j][i] << 16), x1 = __uint_as_float(ov[j][i] & 0xffff0000u); ss += x0 * x0 + x1 * x1; } }
                    ss = sum16(ss);
                    const float rs = 1.0f / sqrtf(ss * (1.f / 512.f) + EPS);
                    u32x4* yp = (u32x4*)(Y + (size_t)m * HV) + lane * 4;
#pragma unroll
                    for (int j = 0; j < 4; ++j) { const u32x4 gv = gp[j]; u32x4 wv;
#pragma unroll
                        for (int i = 0; i < 4; ++i) { const float x0 = __uint_as_float(ov[j][i] << 16), x1 = __uint_as_float(ov[j][i] & 0xffff0000u);
                            const float g0 = __uint_as_float(gv[i] << 16), g1 = __uint_as_float(gv[i] & 0xffff0000u);
                            wv[i] = cvt_pk_bf16(x0 * rs * g0, x1 * rs * g1); }
                        yp[j] = wv; }
                }
            }
            PH_END
        } else if (kind == 1) {
            bf16* XM = (bf16*)(ws + WB_XM); float* RKV = (float*)(ws + WB_RKV); bf16* L1 = (bf16*)(ws + WB_L1); float* DAG = (float*)(ws + WB_DAG);
            float* YR = (float*)(ws + WB_YR); bf16* Y = (bf16*)(ws + WB_Y);
            outA = Y; outB = (const bf16*)(ws + WS_RWO); outK = D;
            PH_BEGIN(4)
            {
                pg8::Gemm g{XM, (const bf16*)(ws + WS_RW1), 6 * M, 3840, D}; StackOrder S; S.base.init(M, 3840, G, bid); S.mode = 1;
                EpiRw1 E{RKV, L1};
                pg8::gemm_phase<EpiRw1, StackOrder, true, true>(lds, g, S, E);
            }
            PH_END
            PH_BEGIN(4)
            {
                int K2 = 256; asm volatile("" : "+s"(K2));
                pg8::Gemm g{L1, (const bf16*)(ws + WS_RW2), 3 * M, 3072, K2}; StackOrder S; S.base.init(M, 3072, G, bid); S.mode = 2;
                EpiRw2 E{DAG, a.in[15], a.in[18]};
                pg8::gemm_phase<EpiRw2, StackOrder, true, true>(lds, g, S, E);
            }
            PH_END
            PH_BEGIN(2)
            {
                const float *Rr = RKV, *Kr = RKV + (size_t)M * D, *Vr = RKV + (size_t)2 * M * D, *DEC = DAG, *AAp = DAG + (size_t)M * D;
                const float *k_k = a.in[23], *k_a = a.in[24]; float* RKb = (float*)(ws + WB_L1);
                LAS float* ob = (LAS float*)lds;
                const int pair = (tid >> 4) & 15, p = tid & 15; const bool cw = tid < 256;
                const int st_ld = tid >> 5, kq = tid & 31;
                for (int item = bid; item < 2 * NB * 32; item += G) {
                    const int seq = item >> 5, h = (item >> 1) & 15, half = item & 1;
                    const bool indep = seq >= NB; const int s0 = (seq - NB) * 16;
                    const int T = indep ? 16 : TP; const int rowbase = indep ? MP + s0 : seq * TP;
                    const int vrow = half * 32 + 2 * pair, ch = h * 64;
                    f32x4 Sa = (f32x4){0.f, 0.f, 0.f, 0.f}, Sb = Sa;
                    const float* sin_ = a.in[4] + (size_t)(s0 * 16 + h) * 4096 + vrow * 64 + 4 * p; float* sout_ = out + O_WKS + (size_t)(s0 * 16 + h) * 4096 + vrow * 64 + 4 * p;
                    const f32x2 rk2 = *(const f32x2*)(a.in[25] + ch + 2 * kq);
                    const f32x2 kk2 = *(const f32x2*)(k_k + ch + 2 * kq), ka2 = *(const f32x2*)(k_a + ch + 2 * kq);
                    f32x2 lr, lk, lv, ld, la;
                    { const int t = st_ld; const bool ok = t < T; const size_t off = (size_t)(rowbase + (ok ? t : 0)) * D + ch + 2 * kq;
                      lr = *(const f32x2*)(Rr + off); lk = *(const f32x2*)(Kr + off); lv = *(const f32x2*)(Vr + off); ld = *(const f32x2*)(DEC + off); la = *(const f32x2*)(AAp + off); }
                    const int nch = (T + 15) >> 4;
                    __syncthreads();
#pragma unroll 1
                    for (int cidx = 0; cidx < nch; ++cidx) {
                        LAS float* B = ob + (cidx & 1) * 6144;
                        {
                            f32x2 kkv = lk * kk2; float ssq = kkv.x * kkv.x + kkv.y * kkv.y;
                            ssq = sum16(ssq); { const int si = __builtin_bit_cast(int, ssq); ssq += __builtin_bit_cast(float, __builtin_amdgcn_ds_swizzle(si, 0x401F)); }
                            const float nrm = fmaxf(sqrtf(ssq), 1e-12f); kkv = kkv * (1.f / nrm);
                            const f32x2 km = lk * (1.f + (la - 1.f) * ka2), kav = kkv * la;
                            { float rkp = lr.x * km.x * rk2.x + lr.y * km.y * rk2.y; rkp = sum16(rkp); { const int si = __builtin_bit_cast(int, rkp); rkp += __builtin_bit_cast(float, __builtin_amdgcn_ds_swizzle(si, 0x401F)); }
                              const int tt = cidx * 16 + st_ld; if (kq == 0 && half == 0 && tt < T) RKb[(size_t)(rowbase + tt) * 16 + h] = rkp; }
                            const int o = st_ld * 64 + 2 * kq;
                            *(LAS f32x2*)(B + o) = ld; *(LAS f32x2*)(B + 1024 + o) = kkv; *(LAS f32x2*)(B + 2048 + o) = kav; *(LAS f32x2*)(B + 3072 + o) = km; *(LAS f32x2*)(B + 4096 + o) = lr; *(LAS f32x2*)(B + 5120 + o) = lv;
                        }
                        if (cidx + 1 < nch) { const int t = (cidx + 1) * 16 + st_ld; const bool ok = t < T; const size_t off = (size_t)(rowbase + (ok ? t : 0)) * D + ch + 2 * kq;
                            lr = *(const f32x2*)(Rr + off); lk = *(const f32x2*)(Kr + off); lv = *(const f32x2*)(Vr + off); ld = *(const f32x2*)(DEC + off); la = *(const f32x2*)(AAp + off); }
                        __syncthreads();
                        const int t0 = cidx * 16;
                        f32x2 ykeep = {0.f, 0.f};
#define SCAN_STEP(st, IND) { if (IND) { Sa = *(const f32x4*)(sin_ + (size_t)(st) * 65536); Sb = *(const f32x4*)(sin_ + (size_t)(st) * 65536 + 64); } \
                            const LAS float* bs = B + (st) * 64 + 4 * p; \
                            const f32x4 w4 = *(const LAS f32x4*)bs, kk4 = *(const LAS f32x4*)(bs + 1024), ka4 = *(const LAS f32x4*)(bs + 2048), km4 = *(const LAS f32x4*)(bs + 3072), r4 = *(const LAS f32x4*)(bs + 4096); \
                            const f32x2 vv = *(const LAS f32x2*)(B + 5120 + (st) * 64 + vrow); \
                            float sa0 = (Sa.x * kk4.x + Sa.y * kk4.y) + (Sa.z * kk4.z + Sa.w * kk4.w), sa1 = (Sb.x * kk4.x + Sb.y * kk4.y) + (Sb.z * kk4.z + Sb.w * kk4.w); \
                            sa0 = -sum16(sa0); sa1 = -sum16(sa1); \
                            Sa = Sa * w4 + ka4 * sa0 + km4 * vv.x; Sb = Sb * w4 + ka4 * sa1 + km4 * vv.y; \
                            float y0 = (Sa.x * r4.x + Sa.y * r4.y) + (Sa.z * r4.z + Sa.w * r4.w), y1 = (Sb.x * r4.x + Sb.y * r4.y) + (Sb.z * r4.z + Sb.w * r4.w); \
                            y0 = sum16(y0); y1 = sum16(y1); \
                            if (p == (st)) { ykeep.x = y0; ykeep.y = y1; } \
                            if (IND) { *(f32x4*)(sout_ + (size_t)(st) * 65536) = Sa; *(f32x4*)(sout_ + (size_t)(st) * 65536 + 64) = Sb; } }
                        if (cw) {
                            if (!indep) {
#pragma unroll
                                for (int st = 0; st < 16; ++st) SCAN_STEP(st, false)
                            } else {
#pragma unroll 1
                                for (int st = 0; st < 16; ++st) SCAN_STEP(st, true)
                            }
                            *(f32x2*)(YR + (size_t)(rowbase + t0 + p) * D + ch + vrow) = ykeep;
                        }
#undef SCAN_STEP
                    }
                    if (!indep && cw) { float* so = out + O_WKP + (size_t)(seq * 16 + h) * 4096 + vrow * 64 + 4 * p; *(f32x4*)so = Sa; *(f32x4*)(so + 64) = Sb; }
                    __syncthreads();
                }
            }
            PH_END
            PH_BEGIN(3)
            {
                const float *Vr = RKV + (size_t)2 * M * D; const bf16* GB = (const bf16*)(DAG + (size_t)2 * M * D); const float* RKb = (const float*)(ws + WB_L1);
                const float *ln_g = a.in[26], *ln_b = a.in[27];
                for (int m = gw; m < M; m += NGW) {
                    const size_t off = (size_t)m * D + lane * 16; const int c0 = lane * 16;
                    f32x4 y[4]; float s1 = 0.f;
                    const float rk = RKb[(size_t)m * 16 + (lane >> 2)];
                    const u32x4 g0 = *(const u32x4*)(GB + off), g1 = *(const u32x4*)(GB + off + 8);
#pragma unroll
                    for (int j = 0; j < 4; ++j) { y[j] = *(const f32x4*)(YR + off + 4 * j); s1 += (y[j].x + y[j].y) + (y[j].z + y[j].w); }
                    s1 = sum4(s1);
                    const float mu = s1 * (1.f / 64.f); float s2 = 0.f;
#pragma unroll
                    for (int j = 0; j < 4; ++j) { const f32x4 d = y[j] - mu; s2 += (d.x * d.x + d.y * d.y) + (d.z * d.z + d.w * d.w); }
                    s2 = sum4(s2);
                    const float rstd = 1.0f / sqrtf(s2 * (1.f / 64.f) + 64e-5f);
                    u32x4 w0, w1;
#pragma unroll
                    for (int j = 0; j < 4; ++j) { const f32x4 lg = *(const f32x4*)(ln_g + c0 + 4 * j), lb = *(const f32x4*)(ln_b + c0 + 4 * j), v = *(const f32x4*)(Vr + off + 4 * j);
                        const unsigned ga = j == 0 ? g0.x : (j == 1 ? g0.z : (j == 2 ? g1.x : g1.z)), gb = j == 0 ? g0.y : (j == 1 ? g0.w : (j == 2 ? g1.y : g1.w));
                        const f32x4 g = {__uint_as_float(ga << 16), __uint_as_float(ga & 0xffff0000u), __uint_as_float(gb << 16), __uint_as_float(gb & 0xffff0000u)};
                        const f32x4 o = ((y[j] - mu) * rstd * lg + lb + v * rk) * g;
                        const unsigned a0 = cvt_pk_bf16(o[0], o[1]), a1 = cvt_pk_bf16(o[2], o[3]);
                        if (j == 0) { w0.x = a0; w0.y = a1; } else if (j == 1) { w0.z = a0; w0.w = a1; } else if (j == 2) { w1.x = a0; w1.y = a1; } else { w1.z = a0; w1.w = a1; } }
                    u32x4* yp = (u32x4*)(Y + off); yp[0] = w0; yp[1] = w1;
                }
            }
            PH_END
        } else {
            bf16* BC = (bf16*)(ws + CB_BC); float* U = (float*)(ws + CB_U); bf16* A2 = (bf16*)(ws + CB_A2);
            outA = A2; outB = (const bf16*)(ws + WS_COUT); outK = D;
            PH_BEGIN(4)
            {
                pg8::Gemm g{XN, (const bf16*)(ws + WS_CIN), M, 3072, D}; pg8::StaticOrder S; S.init(M, 3072, G, bid);
                EpiConvIn E{BC, U};
                pg8::gemm_phase<EpiConvIn, pg8::StaticOrder, true, true>(lds, g, S, E);
            }
            PH_END
            PH_BEGIN(3)
            {
                const float* cw = a.in[30]; const float* cst = a.in[5];
                for (size_t e = (size_t)bid * 512 + tid; e < (size_t)M * 256; e += (size_t)G * 512) {
                    const int m = (int)(e >> 8), c = (int)(e & 255) * 4;
                    const f32x4 w0 = *(const f32x4*)(cw + c), w1 = *(const f32x4*)(cw + D + c), w2 = *(const f32x4*)(cw + 2 * D + c);
                    const f32x4 u2 = *(const f32x4*)(U + (size_t)m * D + c); f32x4 u1, u0;
                    if (m < MP) { const int b = m / TP, t = m - b * TP;
                        u1 = t >= 1 ? *(const f32x4*)(U + (size_t)(m - 1) * D + c) : (f32x4){0.f, 0.f, 0.f, 0.f};
                        u0 = t >= 2 ? *(const f32x4*)(U + (size_t)(m - 2) * D + c) : (f32x4){0.f, 0.f, 0.f, 0.f};
                        if (t >= TP - 2) *(f32x4*)(out + O_CVP + ((size_t)b * 2 + (t - (TP - 2))) * D + c) = u2;
                    } else { const int s = m - MP;
                        u0 = *(const f32x4*)(cst + ((size_t)s * 2) * D + c); u1 = *(const f32x4*)(cst + ((size_t)s * 2 + 1) * D + c);
                        *(f32x4*)(out + O_CVS + ((size_t)s * 2) * D + c) = u1; *(f32x4*)(out + O_CVS + ((size_t)s * 2 + 1) * D + c) = u2; }
                    const f32x4 yv = w0 * u0 + w1 * u1 + w2 * u2;
                    const u32x2 bb = *(const u32x2*)(BC + (size_t)m * D + c);
                    const float b0 = __uint_as_float(bb.x << 16), b1 = __uint_as_float(bb.x & 0xffff0000u), b2 = __uint_as_float(bb.y << 16), b3 = __uint_as_float(bb.y & 0xffff0000u);
                    u32x2 wv; wv.x = cvt_pk_bf16(b0 * yv[0], b1 * yv[1]); wv.y = cvt_pk_bf16(b2 * yv[2], b3 * yv[3]);
                    *(u32x2*)(A2 + (size_t)m * D + c) = wv;
                }
            }
            PH_END
        }
        PH_BEGIN(7)
        {
            pg8::Gemm g{outA, outB, M, D, outK}; TailOrder S; S.init(D, outK, G, bid);
            EpiResid E{H, (rep_ & 1) ? -1.f : 1.f};
            pg8::gemm_phase<EpiResid, TailOrder, true, true>(lds, g, S, E);
        }
        PH_END
        PH_BEGIN(3)
        {
            const float* gain = a.in[9] + (size_t)layer * D;
            for (int m = gw; m < M; m += 2 * NGW) { const int m1 = m + NGW; const bool has1 = m1 < M; f32x4 v0[4], v1[4]; rms_row2(H + (size_t)m * D, H + (size_t)(has1 ? m1 : m) * D, gain, lane, v0, v1); store_row_bf16(XN + (size_t)m * D, lane, v0); if (has1) store_row_bf16(XN + (size_t)m1 * D, lane, v1); }
        }
        PH_END
        bf16* ACT = (bf16*)(ws + MB_ACT);
        PH_BEGIN(4)
        {
            pg8::Gemm g{XN, (const bf16*)(ws + WS_M1 + (size_t)layer * al((size_t)FF * D * 2)), M, FF, D}; pg8::StaticOrder S; S.init(M, FF, G, bid);
            EpiRelu2 E{ACT};
            pg8::gemm_phase<EpiRelu2, pg8::StaticOrder, true, true>(lds, g, S, E);
        }
        PH_END
        PH_BEGIN(7)
        {
            pg8::Gemm g{ACT, (const bf16*)(ws + WS_M2 + (size_t)layer * al((size_t)FF * D * 2)), M, D, FF}; TailOrder S; S.init(D, FF, G, bid);
            EpiResid E{H, (rep_ & 1) ? -1.f : 1.f};
            pg8::gemm_phase<EpiResid, TailOrder, true, true>(lds, g, S, E);
        }
        PH_END
        PH_BEGIN(3)
        {
            if (layer == 3) {
                for (int m = gw; m < M; m += NGW) {
                    float* dst;
                    if (m < MP) { const int b = m / TP, t = m - b * TP; if (t < 16) continue; dst = out + O_YP + ((size_t)b * 2048 + (t - 16)) * D; }
                    else dst = out + O_YS + (size_t)(m - MP) * D;
                    f32x4 v[4]; rms_row(H + (size_t)m * D, a.in[10], lane, v);
                    f32x4* o = (f32x4*)dst + lane;
#pragma unroll
                    for (int j = 0; j < 4; ++j) o[64 * j] = v[j];
                }
            } else if ((layer + 1) % 3 == 1) {
                const float* gain = a.in[8] + (size_t)(layer + 1) * D; const float* mix = a.in[13];
                bf16* XM = (bf16*)(ws + WB_XM);
                f32x4 mrow[6][4];
#pragma unroll
                for (int q = 0; q < 6; ++q)
#pragma unroll
                    for (int j = 0; j < 4; ++j) mrow[q][j] = ((const f32x4*)(mix + (size_t)q * D) + lane)[64 * j];
                for (int m = gw; m < M; m += NGW) {
                    f32x4 xn[4], xp[4];
                    rms_row(H + (size_t)m * D, gain, lane, xn);
                    int b = 0, t = 0;
                    if (m < MP) { b = m / TP; t = m - b * TP;
                        if (t > 0) rms_row(H + (size_t)(m - 1) * D, gain, lane, xp);
                        else {
#pragma unroll
                            for (int j = 0; j < 4; ++j) xp[j] = (f32x4){0.f, 0.f, 0.f, 0.f}; }
                        if (t == TP - 1) { f32x4* o = (f32x4*)(out + O_SHP + (size_t)b * D) + lane;
#pragma unroll
                            for (int j = 0; j < 4; ++j) o[64 * j] = xn[j]; }
                    } else { const int s = m - MP; const f32x4* sp = (const f32x4*)(a.in[3] + (size_t)s * D) + lane; f32x4* o = (f32x4*)(out + O_SHS + (size_t)s * D) + lane;
#pragma unroll
                        for (int j = 0; j < 4; ++j) { xp[j] = sp[64 * j]; o[64 * j] = xn[j]; } }
#pragma unroll
                    for (int j = 0; j < 4; ++j) xp[j] = xp[j] - xn[j];
#pragma unroll
                    for (int q = 0; q < 6; ++q) { f32x4 v[4];
#pragma unroll
                        for (int j = 0; j < 4; ++j) v[j] = xn[j] + xp[j] * mrow[q][j];
                        store_row_bf16(XM + ((size_t)q * M + m) * D, lane, v); }
                }
            } else {
                const float* gain = a.in[8] + (size_t)(layer + 1) * D;
                for (int m = gw; m < M; m += 2 * NGW) { const int m1 = m + NGW; const bool has1 = m1 < M; f32x4 v0[4], v1[4]; rms_row2(H + (size_t)m * D, H + (size_t)(has1 ? m1 : m) * D, gain, lane, v0, v1); store_row_bf16(XN + (size_t)m * D, lane, v0); if (has1) store_row_bf16(XN + (size_t)m1 * D, lane, v1); }
            }
        }
        PH_END
    }
#undef PH_BEGIN
#undef PH_END
}

constexpr int N_PHASES = 33;

#ifndef REP0
#define REP0 1
#define REP1 1
#define REP2 1
#define REP3 1
#define REP4 1
#endif
#ifndef REP5
#define REP5 1
#endif
#ifndef REP7
#define REP7 1
#endif
#ifndef MK_MULTI
#define MK_MULTI 0
#endif

extern "C" void kernel_launch(void* const* d_in, const int* in_sizes, int n_in, void* d_out, int out_size, void* d_ws, size_t ws_size, hipStream_t stream) {
    static int grid = 0;
    if (grid == 0) {
        if (n_in != 34 || (size_t)out_size != O_END || ws_size < WS_TOTAL) { fprintf(stderr, "kernel_launch: unexpected shapes: n_in %d out %d ws %zu (need %zu)\n", n_in, out_size, ws_size, (size_t)WS_TOTAL); grid = -1; return; }
        int dev = 0, cus = 0, per_cu = 0;
        hipGetDevice(&dev); hipDeviceGetAttribute(&cus, hipDeviceAttributeMultiprocessorCount, dev);
        if (hipFuncSetAttribute((const void*)fwd_kernel, hipFuncAttributeMaxDynamicSharedMemorySize, LDS_BYTES) != hipSuccess) { fprintf(stderr, "kernel_launch: hipFuncSetAttribute failed\n"); grid = -1; return; }
        if (hipOccupancyMaxActiveBlocksPerMultiprocessor(&per_cu, (const void*)fwd_kernel, 512, LDS_BYTES) != hipSuccess || per_cu < 1) { fprintf(stderr, "kernel_launch: occupancy query says %d\n", per_cu); (void)hipGetLastError(); grid = -1; return; }
        grid = cus * 1;
    }
    if (grid < 0) return;
    if (hipMemsetAsync((char*)d_ws + WS_BAR, 0, 16384, stream) != hipSuccess) { fprintf(stderr, "kernel_launch: memset failed\n"); return; }
    KArgs a{};
    for (int i = 0; i < 34; ++i) a.in[i] = (const float*)d_in[i];
    a.out = (float*)d_out; a.ws = (unsigned char*)d_ws;
    { const int reps[8] = {REP0, REP1, REP2, REP3, REP4, REP5, 1, REP7}; for (int i = 0; i < 8; ++i) a.rep[i] = reps[i]; }
#if MK_MULTI
    for (int p = 0; p < N_PHASES; ++p) { a.ph_lo = p; a.ph_hi = p + 1; a.coop = 0; hipLaunchKernelGGL(fwd_kernel, dim3(grid), dim3(512), LDS_BYTES, stream, a); }
#else
    a.ph_lo = 0; a.ph_hi = N_PHASES; a.coop = 1;
    void* args[] = {&a};
    hipError_t e = hipLaunchCooperativeKernel((const void*)fwd_kernel, dim3(grid), dim3(512), args, LDS_BYTES, stream);
    if (e != hipSuccess) fprintf(stderr, "cooperative launch failed: %s (grid %d)\n", hipGetErrorString(e), grid);
#endif
}
```

```cpp
#include <hip/hip_runtime.h>
#include <hip/hip_cooperative_groups.h>
#include <cstdio>
#include <cstdint>
namespace cg = cooperative_groups;
namespace pg8 {
#define PG8_LAS __attribute__((address_space(3)))
typedef unsigned short bf16_t;
typedef short bf16x8 __attribute__((ext_vector_type(8)));
typedef float f32x4 __attribute__((ext_vector_type(4)));
typedef unsigned u32x4 __attribute__((ext_vector_type(4)));
constexpr int BM = 256, BK = 64, HALF = 128, HTB = HALF * BK * 2  , STAGE_BYTES = 8 * HTB, NXCD = 8, WGM = 8;

__host__ __device__ __forceinline__ int lds_byte(int r, int c) { const int st = (r >> 4) * 2 + (c >> 5), rr = r & 15, cc = c & 31, ob = rr * 64 + cc * 2; return st * 1024 + (ob ^ (((ob >> 9) & 1) << 5)); }
__host__ __device__ __forceinline__ void stage_rc(int b, int& R, int& C) { const int st = b / 1024, sb = b % 1024, swz = sb ^ (((sb >> 9) & 1) << 5); R = (st >> 1) * 16 + swz / 64; C = (st & 1) * 32 + (swz % 64) / 2; }
__host__ __device__ __forceinline__ int perm32(int rho) { const int n = rho >> 4, i = rho & 15; return 8 * (i >> 2) + 4 * n + (i & 3); }

struct Unit { int pm, pn, k0, nt; };
struct Gemm { const bf16_t* A; const bf16_t* Bt; int M, N, K; };

struct StaticOrder {
    int nM, nN, nwg, G, c;
    __host__ __device__ void init(int M, int N, int G_, int c_) { nM = M / BM; nN = N / BM; nwg = nM * nN; G = G_; c = c_; }
    __host__ __device__ __forceinline__ bool next(int i, Unit& u) const {
        const long L = (long)i * G + c; if (L >= nwg) return false;
        int wgid = (int)L; { const int q = nwg / NXCD, r = nwg % NXCD, xcd = wgid % NXCD, off = wgid / NXCD; wgid = (xcd < r ? xcd * (q + 1) : r * (q + 1) + (xcd - r) * q) + off; }
        const int nig = WGM * nN, gid = wgid / nig, fm = gid * WGM, gsz = (nM - fm) < WGM ? (nM - fm) : WGM;
        u.pm = fm + ((wgid % nig) % gsz); u.pn = (wgid % nig) / gsz; u.k0 = 0; u.nt = 0; return true;
    }
    __device__ __forceinline__ void a_ready(const Unit&) const {}
    __device__ __forceinline__ void done(const Unit&) const {}
};

__device__ __forceinline__ unsigned cvt_pk_bf16(float lo, float hi) { unsigned r; asm volatile("v_cvt_pk_bf16_f32 %0, %1, %2" : "=v"(r) : "v"(lo), "v"(hi)); return r; }
template <class Epi, class Sched, bool ALIGN_EPI = false, bool SP2 = false>
__device__ __forceinline__ void gemm_phase(PG8_LAS unsigned char* lds, const Gemm g, const Sched& S, const Epi& E) {
    int tid_ = threadIdx.x; asm volatile("" : "+v"(tid_));
    const int tid = tid_, wid = __builtin_amdgcn_readfirstlane(tid >> 6), lane = tid & 63, wr = wid >> 2, wc = wid & 3, fr = lane & 15, fq = lane >> 4;
    const int K = g.K, nt = K / BK;
    unsigned voffA[2], voffB[2];
#pragma unroll
    for (int i = 0; i < 2; ++i) { int R, C; stage_rc(tid * 16 + i * 8192, R, C); const int Rb = Epi::PERM ? ((R & ~31) + perm32(R & 31)) : R;
        voffA[i] = (unsigned)(R * K + C) * 2u; voffB[i] = (unsigned)(Rb * K + C) * 2u; }
    const size_t kstep = (size_t)(BK * 2);
    const size_t hstep = (size_t)HALF * K * 2;
    const size_t tstep = 2 * hstep;
    const unsigned ldsw = (unsigned)wid * 1024u;
    const int aoff = lds_byte(wr * 64 + fr, fq * 8), boff = lds_byte(wc * 32 + fr, fq * 8);
#define PG8_SA(b, h) (((b) * 2 + (h)) * HTB)
#define PG8_SB(b, h) ((4 + (b) * 2 + (h)) * HTB)
#define PG8_STAGE(bufoff, gbase, voff) do { _Pragma("unroll") for (int _i = 0; _i < 2; ++_i) \
        __builtin_amdgcn_global_load_lds((const unsigned*)((const char*)(gbase) + (voff)[_i]), (PG8_LAS unsigned*)(lds + (bufoff) + ldsw + _i * 8192), 16, 0, 0); } while (0)
#define PG8_LDA(dst, b, h) do { _Pragma("unroll") for (int m = 0; m < 4; ++m) _Pragma("unroll") for (int k = 0; k < 2; ++k) dst[m][k] = *(const PG8_LAS bf16x8*)(lds + PG8_SA(b, h) + aoff + m * 2048 + k * 1024); } while (0)
#define PG8_LDB(dst, b, h) do { _Pragma("unroll") for (int n = 0; n < 2; ++n) _Pragma("unroll") for (int k = 0; k < 2; ++k) dst[n][k] = *(const PG8_LAS bf16x8*)(lds + PG8_SB(b, h) + boff + n * 2048 + k * 1024); } while (0)
#define PG8_MMA(ai, bj, At, Bt) do { __builtin_amdgcn_s_setprio(1); _Pragma("unroll") for (int m = 0; m < 4; ++m) _Pragma("unroll") for (int n = 0; n < 2; ++n) _Pragma("unroll") for (int k = 0; k < 2; ++k) \
        acc[ai][bj][m][n] = __builtin_amdgcn_mfma_f32_16x16x32_bf16(Bt[n][k], At[m][k], acc[ai][bj][m][n], 0, 0, 0); __builtin_amdgcn_s_setprio(0); } while (0)
#define PG8_WAIT_V(n) asm volatile("s_waitcnt vmcnt(" #n ")" ::: "memory")
#define PG8_WAIT_L(n) asm volatile("s_waitcnt lgkmcnt(" #n ")" ::: "memory")
#define PG8_BAR __builtin_amdgcn_s_barrier()
#define PG8_SCHED __builtin_amdgcn_sched_barrier(0)
    Unit cur, nxt; int ui = 0;
    if (!S.next(0, cur)) return;
    f32x4 acc[2][2][4][2];
#pragma unroll
    for (int a = 0; a < 2; ++a)
#pragma unroll
        for (int b = 0; b < 2; ++b)
#pragma unroll
            for (int m = 0; m < 4; ++m)
#pragma unroll
                for (int n = 0; n < 2; ++n) acc[a][b][m][n] = (f32x4){0.f, 0.f, 0.f, 0.f};
    bf16x8 At[4][2], B0[2][2], B1[2][2];
    const char* cA = (const char*)g.A + (size_t)cur.pm * tstep + (size_t)cur.k0 * 2; const char* cB = (const char*)g.Bt + (size_t)cur.pn * tstep + (size_t)cur.k0 * 2;
    S.a_ready(cur);
    if constexpr (SP2) {
        PG8_STAGE(PG8_SB(0, 0), cB, voffB); PG8_STAGE(PG8_SB(0, 1), cB + hstep, voffB); PG8_STAGE(PG8_SA(0, 0), cA, voffA); PG8_STAGE(PG8_SA(0, 1), cA + hstep, voffA);
        if (wr == 1) PG8_BAR;
        PG8_WAIT_V(2); PG8_BAR;
        PG8_STAGE(PG8_SB(1, 0), cB + kstep, voffB); PG8_STAGE(PG8_SA(1, 0), cA + kstep, voffA); PG8_STAGE(PG8_SB(1, 1), cB + hstep + kstep, voffB);
        PG8_WAIT_V(6); PG8_BAR;
    } else {
        PG8_STAGE(PG8_SB(0, 0), cB, voffB); PG8_STAGE(PG8_SA(0, 0), cA, voffA); PG8_STAGE(PG8_SB(0, 1), cB + hstep, voffB); PG8_STAGE(PG8_SA(0, 1), cA + hstep, voffA);
        if (wr == 1) PG8_BAR;
        PG8_WAIT_V(4); PG8_BAR;
        PG8_STAGE(PG8_SB(1, 0), cB + kstep, voffB); PG8_STAGE(PG8_SA(1, 0), cA + kstep, voffA); PG8_STAGE(PG8_SB(1, 1), cB + hstep + kstep, voffB);
        PG8_WAIT_V(6); PG8_BAR;
    }
    for (;;) {
        const bool has_next = S.next(ui + 1, nxt);
        const char* nA = has_next ? (const char*)g.A + (size_t)nxt.pm * tstep + (size_t)nxt.k0 * 2 : cA; const char* nB = has_next ? (const char*)g.Bt + (size_t)nxt.pn * tstep + (size_t)nxt.k0 * 2 : cB;
        const int ntc = cur.nt ? cur.nt : nt;
        for (int t = 0; t < ntc; t += 2) {
            const bool last = (t == ntc - 2);
            const char* a1 = cA + (size_t)(t + 1) * kstep;
            const char* a2 = last ? nA : cA + (size_t)(t + 2) * kstep; const char* b2 = last ? nB : cB + (size_t)(t + 2) * kstep;
            const char* a3 = a2 + kstep; const char* b3 = b2 + kstep;
            if (last && has_next) S.a_ready(nxt);
            if constexpr (SP2) {
            PG8_LDB(B0, 0, 0); PG8_LDB(B1, 0, 1); PG8_SCHED; PG8_LDA(At, 0, 0); PG8_STAGE(PG8_SA(1, 1), a1 + hstep, voffA);
            PG8_WAIT_V(8); PG8_WAIT_L(0); PG8_BAR; PG8_MMA(0, 0, At, B0); PG8_MMA(0, 1, At, B1); PG8_BAR; PG8_SCHED;
            PG8_LDA(At, 0, 1); PG8_STAGE(PG8_SB(0, 0), b2, voffB); PG8_STAGE(PG8_SB(0, 1), b2 + hstep, voffB); PG8_STAGE(PG8_SA(0, 0), a2, voffA);
            PG8_WAIT_V(8); PG8_WAIT_L(0); PG8_BAR; PG8_MMA(1, 0, At, B0); PG8_MMA(1, 1, At, B1); PG8_BAR; PG8_SCHED;
            PG8_LDB(B0, 1, 0); PG8_LDB(B1, 1, 1); PG8_SCHED; PG8_LDA(At, 1, 0); PG8_STAGE(PG8_SA(0, 1), a2 + hstep, voffA);
            PG8_WAIT_V(8); PG8_WAIT_L(0); PG8_BAR; PG8_MMA(0, 0, At, B0); PG8_MMA(0, 1, At, B1); PG8_BAR; PG8_SCHED;
            PG8_LDA(At, 1, 1); PG8_STAGE(PG8_SB(1, 0), b3, voffB); PG8_STAGE(PG8_SB(1, 1), b3 + hstep, voffB); PG8_STAGE(PG8_SA(1, 0), a3, voffA);
            PG8_WAIT_V(8); PG8_WAIT_L(0); PG8_BAR; PG8_MMA(1, 0, At, B0); PG8_MMA(1, 1, At, B1); PG8_BAR; PG8_SCHED;
            } else {
            PG8_LDB(B0, 0, 0); PG8_SCHED; PG8_LDA(At, 0, 0); PG8_STAGE(PG8_SA(1, 1), a1 + hstep, voffA);
            PG8_WAIT_L(8); PG8_BAR; PG8_WAIT_L(0); PG8_MMA(0, 0, At, B0); PG8_BAR; PG8_SCHED;
            PG8_LDB(B1, 0, 1); PG8_STAGE(PG8_SB(0, 0), b2, voffB);
            PG8_BAR; PG8_WAIT_L(0); PG8_MMA(0, 1, At, B1); PG8_BAR;
            PG8_LDA(At, 0, 1); PG8_STAGE(PG8_SA(0, 0), a2, voffA);
            PG8_BAR; PG8_WAIT_L(0); PG8_MMA(1, 0, At, B0); PG8_BAR; PG8_SCHED;
            PG8_STAGE(PG8_SB(0, 1), b2 + hstep, voffB);
            PG8_WAIT_V(6); PG8_BAR; PG8_MMA(1, 1, At, B1); PG8_BAR;
            PG8_LDB(B0, 1, 0); PG8_SCHED; PG8_LDA(At, 1, 0); PG8_STAGE(PG8_SA(0, 1), a2 + hstep, voffA);
            PG8_WAIT_L(8); PG8_BAR; PG8_WAIT_L(0); PG8_MMA(0, 0, At, B0); PG8_BAR; PG8_SCHED;
            PG8_LDB(B1, 1, 1); PG8_STAGE(PG8_SB(1, 0), b3, voffB);
            PG8_BAR; PG8_WAIT_L(0); PG8_MMA(0, 1, At, B1); PG8_BAR;
            PG8_LDA(At, 1, 1); PG8_STAGE(PG8_SA(1, 0), a3, voffA);
            PG8_BAR; PG8_WAIT_L(0); PG8_MMA(1, 0, At, B0); PG8_BAR; PG8_SCHED;
            PG8_STAGE(PG8_SB(1, 1), b3 + hstep, voffB);
            PG8_WAIT_V(6); PG8_BAR; PG8_MMA(1, 1, At, B1); PG8_BAR;
            }
        }
        if constexpr (ALIGN_EPI) { if (wr == 0) PG8_BAR; }
        if constexpr (!Epi::AFTER_DRAIN) { E(acc, cur, wr, wc, fr, fq); S.done(cur); }
        if (!has_next) break;
#pragma unroll
        for (int a = 0; a < 2; ++a)
#pragma unroll
            for (int b = 0; b < 2; ++b)
#pragma unroll
                for (int m = 0; m < 4; ++m)
#pragma unroll
                    for (int n = 0; n < 2; ++n) acc[a][b][m][n] = (f32x4){0.f, 0.f, 0.f, 0.f};
        cur = nxt; cA = nA; cB = nB; ++ui;
        if constexpr (ALIGN_EPI) { if (wr == 1) PG8_BAR; }
    }
    PG8_WAIT_V(0);
    if constexpr (!ALIGN_EPI) { if (wr == 0) PG8_BAR; }
    PG8_BAR;
    if constexpr (Epi::AFTER_DRAIN) { E.fused(acc, cur, wr, wc, fr, fq, lds, wid, lane); S.done(cur); }
#undef PG8_SA
#undef PG8_SB
#undef PG8_STAGE
#undef PG8_LDA
#undef PG8_LDB
#undef PG8_MMA
#undef PG8_WAIT_V
#undef PG8_WAIT_L
#undef PG8_BAR
#undef PG8_SCHED
}
}

#define LAS __attribute__((address_space(3)))
typedef unsigned short bf16;
typedef short bf16x8 __attribute__((ext_vector_type(8)));
typedef float f32x4 __attribute__((ext_vector_type(4)));
typedef float f32x2 __attribute__((ext_vector_type(2)));
typedef float f32x16 __attribute__((ext_vector_type(16)));
typedef unsigned u32x4 __attribute__((ext_vector_type(4)));
typedef unsigned u32x2 __attribute__((ext_vector_type(2)));
using pg8::cvt_pk_bf16;
using pg8::Unit;

constexpr int D = 1024, NB = 8, TP = 2064, MP = NB * TP, NS = 128, M = MP + NS, NMT = M / 256;
constexpr int FF = 4096, NRI = 6144, HV = 2048;
constexpr float EPS = 1e-6f;
static_assert(M % 256 == 0, "rows");

constexpr size_t O_YP = 0, O_YS = 16777216, O_R0P = 16908288, O_R0S = 21102592, O_SHP = 88211456, O_SHS = 88219648,
                 O_WKP = 88350720, O_WKS = 88875008, O_CVP = 97263616, O_CVS = 97280000, O_R3P = 97542144, O_R3S = 101736448, O_END = 168845312;

constexpr size_t al(size_t x) { return (x + 4095) & ~(size_t)4095; }
constexpr size_t WS_RI0 = 4096, WS_RI1 = WS_RI0 + al((size_t)NRI * D * 2), WS_RO0 = WS_RI1 + al((size_t)NRI * D * 2), WS_RO1 = WS_RO0 + al((size_t)D * HV * 2),
                 WS_RW1 = WS_RO1 + al((size_t)D * HV * 2), WS_RW2 = WS_RW1 + al((size_t)3840 * D * 2), WS_RWO = WS_RW2 + al((size_t)3072 * 256 * 2),
                 WS_CIN = WS_RWO + al((size_t)D * D * 2), WS_COUT = WS_CIN + al((size_t)3072 * D * 2), WS_M1 = WS_COUT + al((size_t)D * D * 2),
                 WS_M2 = WS_M1 + 4 * al((size_t)FF * D * 2), WS_ROPE = WS_M2 + 4 * al((size_t)FF * D * 2), WS_H = WS_ROPE + al((size_t)2065 * 128 * 8),
                 WS_XN = WS_H + al((size_t)M * D * 4), WS_B = WS_XN + al((size_t)M * D * 2);
constexpr size_t RB_Q = WS_B, RB_K = RB_Q + al((size_t)M * D * 2), RB_KTD = RB_K + al((size_t)M * D * 2), RB_VT = RB_KTD + al((size_t)32 * 256 * TP * 2),
                 RB_VS = RB_VT + al((size_t)32 * 512 * TP * 2), RB_SG = RB_VS + al((size_t)NS * HV * 4), RB_OB = RB_SG + al((size_t)M * HV * 2),
                 RB_Y = RB_OB + al((size_t)M * HV * 2), RB_END = RB_Y + al((size_t)M * HV * 2);
constexpr size_t WB_XM = WS_B, WB_DAG = WS_B  , WB_RKV = WB_XM + al((size_t)6 * M * D * 2), WB_L1 = WB_RKV + al((size_t)3 * M * D * 4),
                 WB_YR = WB_L1 + al((size_t)3 * M * 256 * 2), WB_Y = WB_YR + al((size_t)M * D * 4), WB_END = WB_Y + al((size_t)M * D * 2);
static_assert((size_t)3 * M * D * 4 <= (size_t)6 * M * D * 2, "DAG fits over XM");
constexpr size_t CB_BC = WS_B, CB_U = CB_BC + al((size_t)M * D * 2), CB_A2 = CB_U + al((size_t)M * D * 4), CB_END = CB_A2 + al((size_t)M * D * 2);
constexpr size_t MB_ACT = WS_B, MB_END = MB_ACT + al((size_t)M * FF * 2);
constexpr size_t cmax(size_t a, size_t b) { return a > b ? a : b; }
constexpr size_t WS_END = cmax(cmax(RB_END, WB_END), cmax(CB_END, MB_END));

constexpr size_t WS_BAR = al(WS_END), WS_TOTAL = WS_BAR + 16384;
constexpr int LDS_BYTES = 147456, LDS_MISC = 131072 + 256;

#define LDS_WAIT() asm volatile("s_waitcnt lgkmcnt(0)" ::: "memory")
__device__ __forceinline__ float bf2f(bf16 x) { return __uint_as_float((unsigned)x << 16); }
__device__ __forceinline__ unsigned f2bf(float f) { unsigned u = __builtin_bit_cast(unsigned, f); return (u + 0x7fffu + ((u >> 16) & 1u)) >> 16; }
__device__ __forceinline__ unsigned pk2(float lo, float hi) { return f2bf(lo) | (f2bf(hi) << 16); }
__device__ __forceinline__ float wave_sum(float v) {
#pragma unroll
    for (int o = 1; o < 64; o <<= 1) v += __shfl_xor(v, o);
    return v;
}
template <int CTRL> __device__ __forceinline__ float dpp_add(float x) {
    const int xi = __builtin_bit_cast(int, x);
    const int yi = __builtin_amdgcn_update_dpp(0, xi, CTRL, 0xF, 0xF, false);
    return x + __builtin_bit_cast(float, yi);
}
__device__ __forceinline__ float sum4(float x) { x = dpp_add<0xB1>(x); x = dpp_add<0x4E>(x); return x; }
__device__ __forceinline__ float sum16(float x) { x = sum4(x); x = dpp_add<0x141>(x); x = dpp_add<0x140>(x); return x; }
__device__ __forceinline__ int crow(int r, int hi) { return (r & 3) + 8 * (r >> 2) + 4 * hi; }
#define MFMA32(a, b, c) __builtin_amdgcn_mfma_f32_32x32x16_bf16((a), (b), (c), 0, 0, 0)

struct StackOrder {
    pg8::StaticOrder base; int mode;
    __device__ __forceinline__ bool next(int i, Unit& u) const {
        if (!base.next(i, u)) return false;
        const int j = mode == 1 ? (u.pn < 12 ? (u.pn >> 2) : u.pn - 9) : (u.pn >> 2);
        u.pm += NMT * j; return true;
    }
    __device__ __forceinline__ void a_ready(const Unit&) const {}
    __device__ __forceinline__ void done(const Unit&) const {}
};

struct TailOrder {
    pg8::StaticOrder base; int nN, nsmall, G, c;
    __device__ __forceinline__ void init(int N, int K, int G_, int c_) { base.init(M - 256, N, G_, c_); nN = N / 256; nsmall = nN * (K / 256); G = G_; c = c_; }
    __device__ __forceinline__ bool next(int i, Unit& u) const {
        const long L = (long)i * G + c;
        if (L < base.nwg) return base.next(i, u);
        const int s = (int)(L - base.nwg); if (s >= nsmall) return false;
        u.pm = NMT - 1; u.pn = s % nN; u.k0 = (s / nN) * 256; u.nt = 4; return true;
    }
    __device__ __forceinline__ void a_ready(const Unit&) const {}
    __device__ __forceinline__ void done(const Unit&) const {}
};

#define EPI_LOOP_ROWS for (int ai = 0; ai < 2; ++ai) for (int m = 0; m < 4; ++m)
#define EPI_LOOP_COLS for (int bj = 0; bj < 2; ++bj) for (int n = 0; n < 2; ++n)

struct EpiResid {
    static constexpr bool PERM = false, AFTER_DRAIN = false;
    float* H; float sgn;
    __device__ __forceinline__ void operator()(const f32x4 (&acc)[2][2][4][2], const Unit& u, int wr, int wc, int fr, int fq) const {
        const int row0 = u.pm * 256 + wr * 64 + fr, col0 = u.pn * 256 + wc * 32 + 4 * fq;
        if (u.nt == 0) {
#pragma unroll
            EPI_LOOP_ROWS { float* rp = H + (size_t)(row0 + ai * 128 + m * 16) * D + col0;
#pragma unroll
                EPI_LOOP_COLS { f32x4* p = (f32x4*)(rp + bj * 128 + n * 16); *p = *p + acc[ai][bj][m][n] * sgn; } }
        } else {
#pragma unroll
            EPI_LOOP_ROWS { float* rp = H + (size_t)(row0 + ai * 128 + m * 16) * D + col0;
#pragma unroll
                EPI_LOOP_COLS { float* p = rp + bj * 128 + n * 16;
#pragma unroll
                    for (int i = 0; i < 4; ++i) __hip_atomic_fetch_add(p + i, acc[ai][bj][m][n][i] * sgn, __ATOMIC_RELAXED, __HIP_MEMORY_SCOPE_AGENT); } }
        }
    }
};

struct EpiRelu2 {
    static constexpr bool PERM = true, AFTER_DRAIN = false;
    bf16* O;
    __device__ __forceinline__ void operator()(const f32x4 (&acc)[2][2][4][2], const Unit& u, int wr, int wc, int fr, int fq) const {
#ifdef SKIP_EPIRELU2
        return;
#endif

        const int row0 = u.pm * 256 + wr * 64 + fr, col0 = u.pn * 256 + wc * 32 + 8 * fq;
#pragma unroll
        EPI_LOOP_ROWS { bf16* rp = O + (size_t)(row0 + ai * 128 + m * 16) * FF + col0;
#pragma unroll
            for (int bj = 0; bj < 2; ++bj) { f32x4 a = acc[ai][bj][m][0], b = acc[ai][bj][m][1];
                a = __builtin_elementwise_max(a, (f32x4){0.f, 0.f, 0.f, 0.f}); b = __builtin_elementwise_max(b, (f32x4){0.f, 0.f, 0.f, 0.f}); a = a * a; b = b * b;
                u32x4 w; w.x = cvt_pk_bf16(a[0], a[1]); w.y = cvt_pk_bf16(a[2], a[3]); w.z = cvt_pk_bf16(b[0], b[1]); w.w = cvt_pk_bf16(b[2], b[3]);
                *(u32x4*)(rp + bj * 128) = w; } }
    }
};

struct EpiRetIn {
    static constexpr bool PERM = false, AFTER_DRAIN = false;
    bf16 *Qb, *Kb, *KTD, *VT, *SG; float* VS; const float* rope;
    __device__ __forceinline__ void operator()(const f32x4 (&acc)[2][2][4][2], const Unit& u, int wr, int wc, int fr, int fq) const {
#ifdef SKIP_EPIRETIN
        return;
#endif

        const int row0 = u.pm * 256 + wr * 64 + fr, cin0 = wc * 32 + 4 * fq, pn = u.pn;
#pragma unroll
        for (int ai = 0; ai < 2; ++ai)
#pragma unroll
            for (int m = 0; m < 4; ++m) {
                const int r = row0 + ai * 128 + m * 16;
                const bool prm = r < MP; const int b = prm ? r / TP : 0; const int t = prm ? r - b * TP : 0; const int pidx = prm ? t : TP;
                if (pn < 8) {
                    const int h = pn & 3; const bool isk = pn >= 4;
                    float kdec = 1.f;
                    if (isk && prm) { const int e = t < 16 ? 15 - t : 127 - ((t - 16) & 127); kdec = __builtin_amdgcn_exp2f((float)e * __log2f(1.f - __builtin_amdgcn_exp2f(-(float)(5 + h)))); }
#pragma unroll
                    EPI_LOOP_COLS { const int d = bj * 128 + n * 16 + cin0; const f32x4 x = acc[ai][bj][m][n];
                        const f32x4 cs = *(const f32x4*)(rope + ((size_t)pidx * 128 + (d >> 1)) * 2);
                        f32x4 o; o[0] = x[0] * cs[0] - x[1] * cs[1]; o[1] = x[0] * cs[1] + x[1] * cs[0]; o[2] = x[2] * cs[2] - x[3] * cs[3]; o[3] = x[2] * cs[3] + x[3] * cs[2];
                        if (isk) o = o * 0.0625f;
                        u32x2 w; w.x = cvt_pk_bf16(o[0], o[1]); w.y = cvt_pk_bf16(o[2], o[3]);
                        *(u32x2*)((isk ? Kb : Qb) + (size_t)r * D + h * 256 + d) = w;
                        if (isk && prm) { bf16* kp = KTD + ((size_t)((b * 4 + h) * 256 + d)) * TP + t;
                            kp[0] = (bf16)f2bf(o[0] * kdec); kp[TP] = (bf16)f2bf(o[1] * kdec); kp[2 * TP] = (bf16)f2bf(o[2] * kdec); kp[3 * TP] = (bf16)f2bf(o[3] * kdec); } }
                } else if (pn < 16) {
                    const int h = (pn - 8) >> 1, e0 = ((pn - 8) & 1) * 256;
#pragma unroll
                    EPI_LOOP_COLS { const int e = e0 + bj * 128 + n * 16 + cin0; const f32x4 x = acc[ai][bj][m][n];
                        if (prm) { bf16* vp = VT + ((size_t)((b * 4 + h) * 512 + e)) * TP + t;
                            vp[0] = (bf16)f2bf(x[0]); vp[TP] = (bf16)f2bf(x[1]); vp[2 * TP] = (bf16)f2bf(x[2]); vp[3 * TP] = (bf16)f2bf(x[3]); }
                        else *(f32x4*)(VS + (size_t)(r - MP) * HV + h * 512 + e) = x; }
                } else {
                    const int c0 = (pn - 16) * 256;
#pragma unroll
                    EPI_LOOP_COLS { const int c = c0 + bj * 128 + n * 16 + cin0; const f32x4 x = acc[ai][bj][m][n]; f32x4 o;
#pragma unroll
                        for (int i = 0; i < 4; ++i) o[i] = x[i] / (1.f + __expf(-x[i]));
                        u32x2 w; w.x = cvt_pk_bf16(o[0], o[1]); w.y = cvt_pk_bf16(o[2], o[3]);
                        *(u32x2*)(SG + (size_t)r * HV + c) = w; }
                }
            }
    }
};

struct EpiRw1 {
    static constexpr bool PERM = false, AFTER_DRAIN = false;
    float* RKV; bf16* L1;
    __device__ __forceinline__ void operator()(const f32x4 (&acc)[2][2][4][2], const Unit& u, int wr, int wc, int fr, int fq) const {
#ifdef SKIP_EPIRW1
        return;
#endif

        const int pmr = u.pm % NMT, row0 = pmr * 256 + wr * 64 + fr, cin0 = wc * 32 + 4 * fq, pn = u.pn;
        if (pn < 12) {
            float* base = RKV + (size_t)(pn >> 2) * M * D + (pn & 3) * 256 + cin0;
#pragma unroll
            EPI_LOOP_ROWS { float* rp = base + (size_t)(row0 + ai * 128 + m * 16) * D;
#pragma unroll
                EPI_LOOP_COLS *(f32x4*)(rp + bj * 128 + n * 16) = acc[ai][bj][m][n]; }
        } else {
            const int j = pn - 12; bf16* base = L1 + (size_t)j * M * 256 + cin0;
#pragma unroll
            for (int ai = 0; ai < 2; ++ai)
#pragma unroll
                for (int m = 0; m < 4; ++m) { bf16* rp = base + (size_t)(row0 + ai * 128 + m * 16) * 256;
#pragma unroll
                    EPI_LOOP_COLS { const f32x4 x = acc[ai][bj][m][n]; f32x4 o;
#pragma unroll
                        for (int i = 0; i < 4; ++i) o[i] = j == 0 ? tanhf(x[i]) : (j == 1 ? x[i] : 1.f / (1.f + __expf(-x[i])));
                        u32x2 w; w.x = cvt_pk_bf16(o[0], o[1]); w.y = cvt_pk_bf16(o[2], o[3]);
                        *(u32x2*)(rp + bj * 128 + n * 16) = w; } }
        }
    }
};

struct EpiRw2 {
    static constexpr bool PERM = false, AFTER_DRAIN = false;
    float* DAG; const float *w0, *a0;
    __device__ __forceinline__ void operator()(const f32x4 (&acc)[2][2][4][2], const Unit& u, int wr, int wc, int fr, int fq) const {
#ifdef SKIP_EPIRW2
        return;
#endif
        const int pmr = u.pm % NMT, row0 = pmr * 256 + wr * 64 + fr, pn = u.pn, j = pn >> 2, col0 = (pn & 3) * 256 + wc * 32 + 4 * fq;
        float* base = DAG + (size_t)j * M * D + (size_t)row0 * D + col0;
        const float* bias = j == 0 ? w0 : a0;
#pragma unroll
        EPI_LOOP_COLS { const int cc = bj * 128 + n * 16;
            f32x4 bb = (f32x4){0.f, 0.f, 0.f, 0.f}; if (j < 2) bb = *(const f32x4*)(bias + col0 + cc);
#pragma unroll
            EPI_LOOP_ROWS { const f32x4 x = acc[ai][bj][m][n] + bb; f32x4 o;
                if (j == 0) {
#pragma unroll
                    for (int i = 0; i < 4; ++i) { const float z = -x[i]; const float sp = fmaxf(z, 0.f) + __logf(1.f + __expf(-fabsf(z))); o[i] = __expf(-__expf(-sp - 0.5f)); } }
                else if (j == 1) {
#pragma unroll
                    for (int i = 0; i < 4; ++i) o[i] = 1.f / (1.f + __expf(-x[i])); }
                else o = x;
                if (j == 2) { u32x2 wv; wv.x = cvt_pk_bf16(o[0], o[1]); wv.y = cvt_pk_bf16(o[2], o[3]); *(u32x2*)((bf16*)(DAG + (size_t)2 * M * D) + (size_t)(row0 + ai * 128 + m * 16) * D + col0 + cc) = wv; }
                else *(f32x4*)(base + (size_t)(ai * 128 + m * 16) * D + cc) = o; }
            asm volatile("" ::: "memory"); }
    }
};

struct EpiConvIn {
    static constexpr bool PERM = false, AFTER_DRAIN = false;
    bf16* BC; float* U;
    __device__ __forceinline__ void operator()(const f32x4 (&acc)[2][2][4][2], const Unit& u, int wr, int wc, int fr, int fq) const {
#ifdef SKIP_EPICONVIN
        return;
#endif

        const int row0 = u.pm * 256 + wr * 64 + fr, cin0 = wc * 32 + 4 * fq, pn = u.pn;
        if (pn < 4) {
#pragma unroll
            EPI_LOOP_ROWS { bf16* rp = BC + (size_t)(row0 + ai * 128 + m * 16) * D + pn * 256 + cin0;
#pragma unroll
                EPI_LOOP_COLS { const f32x4 x = acc[ai][bj][m][n]; u32x2 w; w.x = cvt_pk_bf16(x[0], x[1]); w.y = cvt_pk_bf16(x[2], x[3]); *(u32x2*)(rp + bj * 128 + n * 16) = w; } }
        } else {
#pragma unroll
            EPI_LOOP_ROWS { float* rp = U + (size_t)(row0 + ai * 128 + m * 16) * D + (pn - 4) * 128 + cin0;
#pragma unroll
                for (int n = 0; n < 2; ++n) *(f32x4*)(rp + n * 16) = acc[ai][0][m][n] * acc[ai][1][m][n]; }
        }
    }
};

__device__ __forceinline__ void tr_item(const float* W, int K, int N, bf16* WT, int ldk, int drow0, int k0, int n0, LAS bf16* scr, int lane) {
    f32x4 v[16];
    const int nl = (lane & 15) * 4, kq = lane >> 4, n = n0 + nl;
#pragma unroll
    for (int i = 0; i < 16; ++i) { const int k = k0 + 4 * i + kq; v[i] = (k < K && n < N) ? *(const f32x4*)(W + (size_t)k * N + n) : (f32x4){0.f, 0.f, 0.f, 0.f}; }
#pragma unroll
    for (int i = 0; i < 16; ++i) { const int kl = 4 * i + kq;
#pragma unroll
        for (int j = 0; j < 4; ++j) scr[(nl + j) * 72 + kl] = (bf16)f2bf(v[i][j]); }
    LDS_WAIT(); asm volatile("" ::: "memory");
    const int c = lane & 7;
#pragma unroll
    for (int q = 0; q < 8; ++q) { const int nr = q * 8 + (lane >> 3);
        const u32x4 o = *(const LAS u32x4*)(scr + nr * 72 + 8 * c);
        *(u32x4*)(WT + (size_t)(drow0 + nr) * ldk + k0 + 8 * c) = o; }
    LDS_WAIT(); asm volatile("" ::: "memory");
}
__device__ __forceinline__ int cin_row(int n0) { if (n0 < 1024) return n0; if (n0 < 2048) { const int j = n0 - 1024; return 1024 + (j >> 7) * 256 + (j & 127); } const int j = n0 - 2048; return 1024 + (j >> 7) * 256 + 128 + (j & 127); }

__device__ __forceinline__ void rms_row(const float* xrow, const float* gain, int lane, f32x4 (&v)[4]) {
    const f32x4* xr = (const f32x4*)xrow + lane; const f32x4* gr = (const f32x4*)gain + lane; float s = 0.f;
#pragma unroll
    for (int j = 0; j < 4; ++j) { v[j] = xr[64 * j]; s += (v[j].x * v[j].x + v[j].y * v[j].y) + (v[j].z * v[j].z + v[j].w * v[j].w); }
    const float rstd = 1.0f / sqrtf(wave_sum(s) * (1.f / D) + EPS);
#pragma unroll
    for (int j = 0; j < 4; ++j) v[j] = v[j] * rstd * gr[64 * j];
}
__device__ __forceinline__ void rms_row2(const float* x0, const float* x1, const float* gain, int lane, f32x4 (&v0)[4], f32x4 (&v1)[4]) {
    const f32x4* p0 = (const f32x4*)x0 + lane; const f32x4* p1 = (const f32x4*)x1 + lane; const f32x4* gr = (const f32x4*)gain + lane; float s0 = 0.f, s1 = 0.f;
#pragma unroll
    for (int j = 0; j < 4; ++j) { v0[j] = p0[64 * j]; v1[j] = p1[64 * j]; }
#pragma unroll
    for (int j = 0; j < 4; ++j) { s0 += (v0[j].x * v0[j].x + v0[j].y * v0[j].y) + (v0[j].z * v0[j].z + v0[j].w * v0[j].w); s1 += (v1[j].x * v1[j].x + v1[j].y * v1[j].y) + (v1[j].z * v1[j].z + v1[j].w * v1[j].w); }
#pragma unroll
    for (int o = 1; o < 64; o <<= 1) { s0 += __shfl_xor(s0, o); s1 += __shfl_xor(s1, o); }
    const float r0 = 1.0f / sqrtf(s0 * (1.f / D) + EPS), r1 = 1.0f / sqrtf(s1 * (1.f / D) + EPS);
#pragma unroll
    for (int j = 0; j < 4; ++j) { const f32x4 g = gr[64 * j]; v0[j] = v0[j] * r0 * g; v1[j] = v1[j] * r1 * g; }
}
__device__ __forceinline__ void store_row_bf16(bf16* orow, int lane, const f32x4 (&v)[4]) {
    u32x2* o8 = (u32x2*)orow + lane;
#pragma unroll
    for (int j = 0; j < 4; ++j) { u32x2 w; w.x = pk2(v[j].x, v[j].y); w.y = pk2(v[j].z, v[j].w); o8[64 * j] = w; }
}

#define XB_TMO      128
#define XB_XCNT(j)  (256  + 64 * (j))
#define XB_XSUB(j)  (1280 + 64 * (j))
#define XB_XGEN(j)  (2304 + 64 * (j))
#define XB_TOP      3328
#define XB_TOPGEN   3392
#define XCD_BAR_WORDS 3456
#define XB_SPIN_CAP (1u << 18)

__device__ __forceinline__ unsigned xb_ld(unsigned* p)              { return __hip_atomic_load(p, __ATOMIC_RELAXED, __HIP_MEMORY_SCOPE_AGENT); }
__device__ __forceinline__ unsigned xb_add(unsigned* p, unsigned v) { return __hip_atomic_fetch_add(p, v, __ATOMIC_RELAXED, __HIP_MEMORY_SCOPE_AGENT); }
__device__ __forceinline__ unsigned xb_xcc_id() { return (unsigned)__builtin_amdgcn_s_getreg((3 << 11) | 20) & 0xFu; }
#define XB_SPIN(cond, bar) do { unsigned _sp = 0; while (cond) { __builtin_amdgcn_s_sleep(1); \
    if ((++_sp & 255u) == 0u) { if (xb_ld(&(bar)[XB_TMO])) break; if (_sp > XB_SPIN_CAP) { atomicAdd(&(bar)[XB_TMO], 1u); break; } } } } while (0)

struct XcdBarrier {
    unsigned* bar; unsigned x;
    volatile LAS unsigned* st;
};

__device__ __forceinline__ XcdBarrier xcd_barrier_post(unsigned* bar, volatile LAS unsigned* st) {
    XcdBarrier b; b.bar = bar; b.x = xb_xcc_id(); b.st = st;
    if (threadIdx.x == 0) (void)xb_add(&bar[XB_XCNT(b.x)], 1u);
    return b;
}
__device__ __forceinline__ void xcd_barrier_complete(unsigned* bar, unsigned x, unsigned& nloc, unsigned& nx) {
    const unsigned G = gridDim.x * gridDim.y * gridDim.z;
    unsigned sum, cnt, mine, sp = 0u;
    for (;;) {
        sum = 0u; cnt = 0u; mine = 0u;
#pragma unroll
        for (unsigned j = 0; j < 16; ++j) { const unsigned c = xb_ld(&bar[XB_XCNT(j)]); sum += c; cnt += (c > 0u) ? 1u : 0u; mine = (j == x) ? c : mine; }
        if (sum == G) break;
        __builtin_amdgcn_s_sleep(1);
        if ((++sp & 255u) == 0u) { if (xb_ld(&bar[XB_TMO])) break; if (sp > XB_SPIN_CAP) { atomicAdd(&bar[XB_TMO], 1u); break; } }
    }
    nloc = mine > 0u ? mine : 1u; nx = cnt > 0u ? cnt : 1u;
}

__device__ __forceinline__ void xcd_barrier(const XcdBarrier& b) {
    asm volatile("s_waitcnt vmcnt(0)" ::: "memory");
    __syncthreads();
    if (threadIdx.x == 0) {
        unsigned* bar = b.bar;
        __builtin_amdgcn_s_waitcnt(0);
        unsigned nloc = b.st[0], nx = b.st[1];
        if (nloc == 0u) { xcd_barrier_complete(bar, b.x, nloc, nx); b.st[0] = nloc; b.st[1] = nx; }
        const unsigned old = xb_add(&bar[XB_XSUB(b.x)], 1u);
        const unsigned gen = old / nloc;
        if (old + 1u == (gen + 1u) * nloc) {
            __builtin_amdgcn_fence(__ATOMIC_RELEASE, "agent");
            asm volatile("s_waitcnt vmcnt(0)" ::: "memory");
            const unsigned og = xb_add(&bar[XB_TOP], 1u);
            const unsigned tg = og / nx;
            if (og + 1u == (tg + 1u) * nx) xb_add(&bar[XB_TOPGEN], 1u);
            else XB_SPIN(xb_ld(&bar[XB_TOPGEN]) == tg, bar);
            __builtin_amdgcn_fence(__ATOMIC_ACQUIRE, "agent");
            xb_add(&bar[XB_XGEN(b.x)], 1u);
            asm volatile("s_waitcnt vmcnt(0)" ::: "memory");
        } else {
            XB_SPIN(xb_ld(&bar[XB_XGEN(b.x)]) == gen, bar);
            __builtin_amdgcn_fence(__ATOMIC_ACQUIRE, "agent");
            asm volatile("s_waitcnt vmcnt(0)" ::: "memory");
        }
    }
    __syncthreads();
}

struct KArgs { const float* in[34]; float* out; unsigned char* ws; int ph_lo, ph_hi, coop, pad; int rep[8]; };

__global__ void __launch_bounds__(512, 2) fwd_kernel(KArgs a) {
    extern __shared__ __attribute__((aligned(16))) unsigned char lds_raw[];
    LAS unsigned char* lds = (LAS unsigned char*)lds_raw;
    cg::grid_group grid = cg::this_grid();
    const int tid0 = threadIdx.x, wave = __builtin_amdgcn_readfirstlane(tid0 >> 6);
    const int G = gridDim.x, bid = blockIdx.x, gw = bid * 8 + wave, NGW = G * 8;
    unsigned char* ws = a.ws; float* out = a.out;
    float* H = (float*)(ws + WS_H); bf16* XN = (bf16*)(ws + WS_XN);
    const float* rope = (const float*)(ws + WS_ROPE);
    const int lo = a.ph_lo, hi = a.ph_hi; const bool coop = a.coop != 0;
    volatile LAS unsigned* MISC = (volatile LAS unsigned*)(lds + LDS_MISC);
    if (tid0 == 0) { MISC[0] = 0u; MISC[1] = 0u; }
    __syncthreads();
    XcdBarrier xbar = xcd_barrier_post((unsigned*)(ws + WS_BAR), MISC);
    int pc = 0;
#define PH_BEGIN(cat) if (pc >= lo && pc < hi) { for (int rep_ = 0; rep_ < a.rep[cat]; ++rep_) { int tid = tid0; asm volatile("" : "+v"(tid)); const int lane = tid & 63; (void)lane;
#define PH_END   __syncthreads(); } if (coop && pc + 1 < hi) { if (a.coop == 2) grid.sync();     \
        xcd_barrier(xbar); if (a.rep[5] > 1) xcd_barrier(xbar); } } ++pc;

    PH_BEGIN(0)
    {
        LAS bf16* scr = (LAS bf16*)(lds + wave * 9216);
        for (int it = gw; ; it += NGW) {
            int r = it; bool did = false; const float* jW = nullptr; bf16* jWT = nullptr; int jK = 0, jN = 0, jld = 0, jrow = 0, jk0 = 0, jn0 = 0;
#define TRJOB(Wp, K_, N_, KP_, NP_, WTp, LDK_, ROWEXPR) if (!did) { const int nnb = (NP_) / 64, cnt = ((KP_) / 64) * nnb; \
                if (r < cnt) { const int kb = r / nnb, nb = r - kb * nnb, n0 = nb * 64; jW = (Wp); jK = (K_); jN = (N_); jWT = (WTp); jld = (LDK_); jrow = (ROWEXPR) + n0; jk0 = kb * 64; jn0 = n0; did = true; } else r -= cnt; }
            TRJOB(a.in[11], D, NRI, D, NRI, (bf16*)(ws + WS_RI0), D, 0)
            TRJOB(a.in[11] + (size_t)D * NRI, D, NRI, D, NRI, (bf16*)(ws + WS_RI1), D, 0)
            TRJOB(a.in[12], HV, D, HV, D, (bf16*)(ws + WS_RO0), HV, 0)
            TRJOB(a.in[12] + (size_t)HV * D, HV, D, HV, D, (bf16*)(ws + WS_RO1), HV, 0)
            TRJOB(a.in[14], D, D, D, D, (bf16*)(ws + WS_RW1), D, 0)
            TRJOB(a.in[14] + (size_t)D * D, D, D, D, D, (bf16*)(ws + WS_RW1), D, 1024)
            TRJOB(a.in[14] + (size_t)2 * D * D, D, D, D, D, (bf16*)(ws + WS_RW1), D, 2048)
            TRJOB(a.in[16], D, 64, D, 256, (bf16*)(ws + WS_RW1), D, 3072)
            TRJOB(a.in[19], D, 64, D, 256, (bf16*)(ws + WS_RW1), D, 3328)
            TRJOB(a.in[21], D, 160, D, 256, (bf16*)(ws + WS_RW1), D, 3584)
            TRJOB(a.in[17], 64, D, 256, D, (bf16*)(ws + WS_RW2), 256, 0)
            TRJOB(a.in[20], 64, D, 256, D, (bf16*)(ws + WS_RW2), 256, 1024)
            TRJOB(a.in[22], 160, D, 256, D, (bf16*)(ws + WS_RW2), 256, 2048)
            TRJOB(a.in[28], D, D, D, D, (bf16*)(ws + WS_RWO), D, 0)
            TRJOB(a.in[29], D, 3072, D, 3072, (bf16*)(ws + WS_CIN), D, cin_row(n0) - n0)
            TRJOB(a.in[31], D, D, D, D, (bf16*)(ws + WS_COUT), D, 0)
#pragma unroll 1
            for (int l = 0; l < 4; ++l) {
                TRJOB(a.in[32] + (size_t)l * D * FF, D, FF, D, FF, (bf16*)(ws + WS_M1 + (size_t)l * al((size_t)FF * D * 2)), D, 0)
                TRJOB(a.in[33] + (size_t)l * D * FF, FF, D, FF, D, (bf16*)(ws + WS_M2 + (size_t)l * al((size_t)FF * D * 2)), FF, 0)
            }
#undef TRJOB
            if (!did) break;
            tr_item(jW, jK, jN, jWT, jld, jrow, jk0, jn0, scr, lane);
        }
        for (int e = bid * 512 + tid; e < 2065 * 128; e += G * 512) {
            const int p = e >> 7, i = e & 127;
            const float x = (float)i / 127.0f;
            const float inv = 1.0f / (float)exp((double)x * 9.210340371976184);
            const float ang = (float)(p == TP ? 16384 : p) * inv;
            double rev = (double)ang * 0.15915494309189535; rev -= rint(rev);
            const float fr = (float)rev;
            ((f32x2*)(ws + WS_ROPE))[e] = (f32x2){__builtin_amdgcn_cosf(fr), __builtin_amdgcn_sinf(fr)};
        }
        for (int m = gw; m < M; m += NGW) {
            const float* src;
            if (m < MP) { const int b = m / TP, t = m - b * TP; src = t < 16 ? a.in[7] + (size_t)t * D : a.in[0] + ((size_t)b * 2048 + (t - 16)) * D; }
            else src = a.in[1] + (size_t)(m - MP) * D;
            const f32x4* xr = (const f32x4*)src + lane; f32x4* hr = (f32x4*)(H + (size_t)m * D) + lane;
#pragma unroll
            for (int j = 0; j < 4; ++j) hr[64 * j] = xr[64 * j];
            f32x4 v[4]; rms_row(src, a.in[8], lane, v); store_row_bf16(XN + (size_t)m * D, lane, v);
        }
    }
    PH_END

#pragma unroll 1
    for (int layer = 0; layer < 4; ++layer) {
        const int kind = layer % 3;
        const bf16* outA; const bf16* outB; int outK;
        if (kind == 0) {
            const int jr = layer / 3;
            bf16 *Qb = (bf16*)(ws + RB_Q), *Kb = (bf16*)(ws + RB_K), *KTD = (bf16*)(ws + RB_KTD), *VT = (bf16*)(ws + RB_VT), *SG = (bf16*)(ws + RB_SG), *OB = (bf16*)(ws + RB_OB), *Y = (bf16*)(ws + RB_Y);
            float* VS = (float*)(ws + RB_VS);
            outA = Y; outB = (const bf16*)(ws + (jr ? WS_RO1 : WS_RO0)); outK = HV;
            PH_BEGIN(4)
            {
                pg8::Gemm g{XN, (const bf16*)(ws + (jr ? WS_RI1 : WS_RI0)), M, NRI, D}; pg8::StaticOrder S; S.init(M, NRI, G, bid);
                EpiRetIn E{Qb, Kb, KTD, VT, SG, VS, rope};
                pg8::gemm_phase<EpiRetIn, pg8::StaticOrder, true, true>(lds, g, S, E);
            }
            PH_END
            PH_BEGIN(1)
            {
                const float* S0in = a.in[jr ? 6 : 2];
                float* Sp_out = out + (jr ? O_R3P : O_R0P); float* Ss_out = out + (jr ? O_R3S : O_R0S);
                const int l32 = lane & 31, hi = lane >> 5, w = wave;
                LAS bf16* P = (LAS bf16*)lds;
                LAS bf16* ST = (LAS bf16*)(lds + 34816);
                for (int item = bid; item < 256; item += G) {
                    const int b = item >> 5, h = (item >> 3) & 3, es = item & 7;
                    const float lg2 = __log2f(1.f - __builtin_amdgcn_exp2f(-(float)(5 + h)));
                    const unsigned char* qbytes = (const unsigned char*)(Qb + (size_t)(b * TP) * D + h * 256);
                    const unsigned char* kbytes = (const unsigned char*)(Kb + (size_t)(b * TP) * D + h * 256);
                    const bf16* ktd = KTD + (size_t)((b * 4 + h) * 256) * TP;
                    const bf16* vt = VT + (size_t)((b * 4 + h) * 512 + es * 64) * TP;
                    LAS unsigned char* QH = lds;
                    LAS unsigned char* KH = lds + 34816;
                    LAS unsigned char* STb = lds + 69632;
                    LAS unsigned char* VTs = lds + 103424;
                    f32x16 S2[2];
#pragma unroll
                    for (int i = 0; i < 16; ++i) { S2[0][i] = 0.f; S2[1][i] = 0.f; }
                    for (int i = tid; i < 33792 / 16; i += 512) *(LAS u32x4*)(STb + i * 16) = (u32x4){0u, 0u, 0u, 0u};
                    const u32x4 z4 = {0u, 0u, 0u, 0u};
                    u32x4 rq[4], rk[4], rv[2];
#define RET_T0(cc) ((cc) == 0 ? 0 : 16 + 128 * ((cc) - 1))
#define RET_L(cc)  ((cc) == 0 ? 16 : 128)
#define LOADQK(cc, dh) do { const int t0c_ = RET_T0(cc), Lc_ = RET_L(cc); _Pragma("unroll") for (int i_ = 0; i_ < 4; ++i_) { const int id_ = tidc + 512 * i_, row_ = id_ >> 4, c16_ = id_ & 15; const bool ok_ = row_ < Lc_; \
        const size_t off_ = (size_t)(t0c_ + (ok_ ? row_ : 0)) * 2048 + (dh) * 256 + c16_ * 16; rq[i_] = *(const u32x4*)(qbytes + off_); rk[i_] = *(const u32x4*)(kbytes + off_); if (!ok_) { rq[i_] = z4; rk[i_] = z4; } } } while (0)
#define STOREQK() do { _Pragma("unroll") for (int i_ = 0; i_ < 4; ++i_) { const int id_ = tidc + 512 * i_, row_ = id_ >> 4, c16_ = id_ & 15; *(LAS u32x4*)(QH + row_ * 272 + c16_ * 16) = rq[i_]; *(LAS u32x4*)(KH + row_ * 272 + c16_ * 16) = rk[i_]; } } while (0)
#define LOADV(cc) do { const int t0c_ = RET_T0(cc), Lc_ = RET_L(cc); _Pragma("unroll") for (int i_ = 0; i_ < 2; ++i_) { const int id_ = tidc + 512 * i_, row_ = id_ >> 4, c16_ = id_ & 15; const bool ok_ = c16_ * 8 < Lc_; \
        rv[i_] = *(const u32x4*)(vt + (size_t)row_ * TP + t0c_ + (ok_ ? c16_ * 8 : 0)); if (!ok_) rv[i_] = z4; } } while (0)
#define STOREV() do { _Pragma("unroll") for (int i_ = 0; i_ < 2; ++i_) { const int id_ = tidc + 512 * i_, row_ = id_ >> 4, c16_ = id_ & 15; *(LAS u32x4*)(VTs + row_ * 272 + c16_ * 16) = rv[i_]; } } while (0)
                    { const int tidc = tid; LOADQK(0, 0); LOADV(0); }
                    const int lt = w >> 1, ei = w & 1;
                    __syncthreads();
#pragma unroll 1
                    for (int c = 0; c < 17; ++c) {
                        const int t0 = RET_T0(c), L = RET_L(c);
                        int tl_ = tid; asm volatile("" : "+v"(tl_));
                        const int tidc = tl_, l32 = tidc & 31, hi = (tidc >> 5) & 1, lrow = 32 * lt + l32, erow = 32 * ei + l32;
                        const bool act = 32 * lt < L;
                        f32x16 accP[2], aX;
#pragma unroll
                        for (int i = 0; i < 16; ++i) { accP[0][i] = 0.f; accP[1][i] = 0.f; aX[i] = 0.f; }
#pragma unroll
                        for (int dh = 0; dh < 2; ++dh) {
                            STOREQK(); if (dh == 0) STOREV();
                            if (dh == 0) LOADQK(c, 1); else if (c < 16) { LOADQK(c + 1, 0); LOADV(c + 1); }
                            __syncthreads();
                            if (act) {
                                const LAS unsigned char* qrow = QH + lrow * 272 + 16 * hi;
#pragma unroll
                                for (int j = 0; j < 2; ++j) { const int mt = 2 * (w & 1) + j;
                                    if (mt <= lt && 32 * mt < L) { const LAS unsigned char* krow = KH + (32 * mt + l32) * 272 + 16 * hi;
#pragma unroll 4
                                        for (int s = 0; s < 8; ++s) { const bf16x8 kf = *(const LAS bf16x8*)(krow + 32 * s), qf = *(const LAS bf16x8*)(qrow + 32 * s); accP[j] = MFMA32(kf, qf, accP[j]); } } }
                                const LAS unsigned char* srow = STb + erow * 528 + 256 * dh + 16 * hi;
#pragma unroll 4
                                for (int s = 0; s < 8; ++s) { const bf16x8 sf = *(const LAS bf16x8*)(srow + 32 * s), qf = *(const LAS bf16x8*)(qrow + 32 * s); aX = MFMA32(sf, qf, aX); }
                            }
                            __syncthreads();
                        }
                        bf16x8 kc[8];
                        { const bf16* kp = ktd + (size_t)(32 * w + l32) * TP + t0 + 8 * hi; const int nkc = L >> 4;
#pragma unroll
                          for (int s = 0; s < 8; ++s) kc[s] = *(const bf16x8*)(kp + (s < nkc ? 16 * s : 0)); }
                        if (act) {
#pragma unroll
                            for (int j = 0; j < 2; ++j) { const int mt = 2 * (w & 1) + j;
                                if (mt <= lt && 32 * mt < L) {
#pragma unroll
                                    for (int gq = 0; gq < 4; ++gq) { float o[4];
#pragma unroll
                                        for (int i = 0; i < 4; ++i) { const int mm = 32 * mt + 8 * gq + 4 * hi + i; const int df = lrow - mm;
                                            o[i] = df >= 0 ? accP[j][gq * 4 + i] * __builtin_amdgcn_exp2f((float)df * lg2) : 0.f; }
                                        u32x2 wv; wv.x = cvt_pk_bf16(o[0], o[1]); wv.y = cvt_pk_bf16(o[2], o[3]);
                                        *(LAS u32x2*)(KH + lrow * 272 + (32 * mt + 8 * gq + 4 * hi) * 2) = wv; } } }
                        }
                        __syncthreads();
                        if (act) {
                            f32x16 aI;
#pragma unroll
                            for (int i = 0; i < 16; ++i) aI[i] = 0.f;
                            const int nk = (32 * (lt + 1) < L ? 32 * (lt + 1) : L) >> 4;
#pragma unroll 2
                            for (int s = 0; s < nk; ++s) { const bf16x8 fa = *(const LAS bf16x8*)(VTs + erow * 272 + (16 * s + 8 * hi) * 2), fb = *(const LAS bf16x8*)(KH + lrow * 272 + (16 * s + 8 * hi) * 2); aI = MFMA32(fa, fb, aI); }
                            const float qd = __builtin_amdgcn_exp2f((float)(lrow + 1) * lg2);
                            if (lrow < L) {
                                bf16* op = OB + (size_t)(b * TP + t0 + lrow) * HV + h * 512 + es * 64 + 32 * ei + 4 * hi;
#pragma unroll
                                for (int gq = 0; gq < 4; ++gq) {
                                    u32x2 wv; wv.x = cvt_pk_bf16(aI[gq * 4 + 0] + qd * aX[gq * 4 + 0], aI[gq * 4 + 1] + qd * aX[gq * 4 + 1]);
                                    wv.y = cvt_pk_bf16(aI[gq * 4 + 2] + qd * aX[gq * 4 + 2], aI[gq * 4 + 3] + qd * aX[gq * 4 + 3]);
                                    *(u32x2*)(op + 8 * gq) = wv; }
                            }
                        }
                        {
                            const float gl = __builtin_amdgcn_exp2f((float)L * lg2);
                            S2[0] = S2[0] * gl; S2[1] = S2[1] * gl;
                            const int nkc = L >> 4;
#pragma unroll
                            for (int s = 0; s < 8; ++s) if (s < nkc) {
                                const bf16x8 fb0 = *(const LAS bf16x8*)(VTs + l32 * 272 + (16 * s + 8 * hi) * 2), fb1 = *(const LAS bf16x8*)(VTs + (32 + l32) * 272 + (16 * s + 8 * hi) * 2);
                                S2[0] = MFMA32(kc[s], fb0, S2[0]); S2[1] = MFMA32(kc[s], fb1, S2[1]); }
                        }
                        __syncthreads();
                        if (c < 16) {
#pragma unroll
                            for (int e2 = 0; e2 < 2; ++e2)
#pragma unroll
                                for (int gq = 0; gq < 4; ++gq) {
                                    u32x2 wv; wv.x = cvt_pk_bf16(S2[e2][gq * 4 + 0], S2[e2][gq * 4 + 1]); wv.y = cvt_pk_bf16(S2[e2][gq * 4 + 2], S2[e2][gq * 4 + 3]);
                                    *(LAS u32x2*)(STb + (32 * e2 + l32) * 528 + (32 * w + 8 * gq + 4 * hi) * 2) = wv; }
                        }
                    }
#undef LOADQK
#undef STOREQK
#undef LOADV
#undef STOREV
                    {
                        float* sp = Sp_out + (size_t)((b * 4 + h) * 256) * 512 + es * 64 + l32;
#pragma unroll
                        for (int e2 = 0; e2 < 2; ++e2)
#pragma unroll
                            for (int r = 0; r < 16; ++r) sp[(size_t)(32 * w + crow(r, hi)) * 512 + 32 * e2] = S2[e2][r];
                    }
                    __syncthreads();
                }
                {
                    LAS float* qk = (LAS float*)(lds + 69632);
                    LAS float* ored = (LAS float*)(lds + 69632 + 2048);
                    for (int item = bid; item < NS * 4; item += G) {
                        const int s = item >> 2, h = item & 3;
                        const float gamma = 1.f - __builtin_amdgcn_exp2f(-(float)(5 + h));
                        __syncthreads();
                        { const int which = tid >> 8, dd = tid & 255; qk[tid] = bf2f((which ? Kb : Qb)[(size_t)(MP + s) * D + h * 256 + dd]); }
                        __syncthreads();
                        const int e4 = (tid & 127) * 4, dg = tid >> 7;
                        const f32x4 v4 = *(const f32x4*)(VS + (size_t)s * HV + h * 512 + e4);
                        const float* sin_ = S0in + (size_t)(s * 4 + h) * 256 * 512 + e4; float* sout = Ss_out + (size_t)(s * 4 + h) * 256 * 512 + e4;
                        f32x4 o4 = {0.f, 0.f, 0.f, 0.f};
#pragma unroll 16
                        for (int i = 0; i < 64; ++i) { const int d = dg * 64 + i;
                            const f32x4 sv = __builtin_nontemporal_load((const f32x4*)(sin_ + (size_t)d * 512));
                            const f32x4 sn = sv * gamma + v4 * qk[256 + d];
                            __builtin_nontemporal_store(sn, (f32x4*)(sout + (size_t)d * 512));
                            o4 = o4 + sn * qk[d]; }
                        *(LAS f32x4*)(ored + dg * 512 + e4) = o4;
                        __syncthreads();
                        if (tid < 128) { const f32x4 r = *(LAS f32x4*)(ored + e4) + *(LAS f32x4*)(ored + 512 + e4) + *(LAS f32x4*)(ored + 1024 + e4) + *(LAS f32x4*)(ored + 1536 + e4);
                            u32x2 wv; wv.x = cvt_pk_bf16(r[0], r[1]); wv.y = cvt_pk_bf16(r[2], r[3]);
                            *(u32x2*)(OB + (size_t)(MP + s) * HV + h * 512 + e4) = wv; }
                    }
                }
            }
            PH_END
            PH_BEGIN(3)
            {
                for (int m = gw; m < M; m += NGW) {
                    const u32x4* op = (const u32x4*)(OB + (size_t)m * HV) + lane * 4; const u32x4* gp = (const u32x4*)(SG + (size_t)m * HV) + lane * 4;
                    u32x4 ov[4]; float ss = 0.f;
#pragma unroll
                    for (int j = 0; j < 4; ++j) { ov[j] = op[j];
#pragma unroll
                        for (int i = 0; i < 4; ++i) { const float x0 = __uint_as_float(ov[j][i] << 16), x1 = __uint_as_float(ov[j][i] & 0xffff0000u); ss += x0 * x0 + x1 * x1; } }
                    ss = sum16(ss);
                    const float rs = 1.0f / sqrtf(ss * (1.f / 512.f) + EPS);
                    u32x4* yp = (u32x4*)(Y + (size_t)m * HV) + lane * 4;
#pragma unroll
                    for (int j = 0; j < 4; ++j) { const u32x4 gv = gp[j]; u32x4 wv;
#pragma unroll
                        for (int i = 0; i < 4; ++i) { const float x0 = __uint_as_float(ov[j][i] << 16), x1 = __uint_as_float(ov[j][i] & 0xffff0000u);
                            const float g0 = __uint_as_float(gv[i] << 16), g1 = __uint_as_float(gv[i] & 0xffff0000u);
                            wv[i] = cvt_pk_bf16(x0 * rs * g0, x1 * rs * g1); }
                        yp[j] = wv; }
                }
            }
            PH_END
        } else if (kind == 1) {
            bf16* XM = (bf16*)(ws + WB_XM); float* RKV = (float*)(ws + WB_RKV); bf16* L1 = (bf16*)(ws + WB_L1); float* DAG = (float*)(ws + WB_DAG);
            float* YR = (float*)(ws + WB_YR); bf16* Y = (bf16*)(ws + WB_Y);
            outA = Y; outB = (const bf16*)(ws + WS_RWO); outK = D;
            PH_BEGIN(4)
            {
                pg8::Gemm g{XM, (const bf16*)(ws + WS_RW1), 6 * M, 3840, D}; StackOrder S; S.base.init(M, 3840, G, bid); S.mode = 1;
                EpiRw1 E{RKV, L1};
                pg8::gemm_phase<EpiRw1, StackOrder, true, true>(lds, g, S, E);
            }
            PH_END
            PH_BEGIN(4)
            {
                int K2 = 256; asm volatile("" : "+s"(K2));
                pg8::Gemm g{L1, (const bf16*)(ws + WS_RW2), 3 * M, 3072, K2}; StackOrder S; S.base.init(M, 3072, G, bid); S.mode = 2;
                EpiRw2 E{DAG, a.in[15], a.in[18]};
                pg8::gemm_phase<EpiRw2, StackOrder, true, true>(lds, g, S, E);
            }
            PH_END
            PH_BEGIN(2)
            {
                const float *Rr = RKV, *Kr = RKV + (size_t)M * D, *Vr = RKV + (size_t)2 * M * D, *DEC = DAG, *AAp = DAG + (size_t)M * D;
                const float *k_k = a.in[23], *k_a = a.in[24]; float* RKb = (float*)(ws + WB_L1);
                LAS float* ob = (LAS float*)lds;
                const int pair = (tid >> 4) & 15, p = tid & 15; const bool cw = tid < 256;
                const int st_ld = tid >> 5, kq = tid & 31;
                for (int item = bid; item < 2 * NB * 32; item += G) {
                    const int seq = item >> 5, h = (item >> 1) & 15, half = item & 1;
                    const bool indep = seq >= NB; const int s0 = (seq - NB) * 16;
                    const int T = indep ? 16 : TP; const int rowbase = indep ? MP + s0 : seq * TP;
                    const int vrow = half * 32 + 2 * pair, ch = h * 64;
                    f32x4 Sa = (f32x4){0.f, 0.f, 0.f, 0.f}, Sb = Sa;
                    const float* sin_ = a.in[4] + (size_t)(s0 * 16 + h) * 4096 + vrow * 64 + 4 * p; float* sout_ = out + O_WKS + (size_t)(s0 * 16 + h) * 4096 + vrow * 64 + 4 * p;
                    const f32x2 rk2 = *(const f32x2*)(a.in[25] + ch + 2 * kq);
                    const f32x2 kk2 = *(const f32x2*)(k_k + ch + 2 * kq), ka2 = *(const f32x2*)(k_a + ch + 2 * kq);
                    f32x2 lr, lk, lv, ld, la;
                    { const int t = st_ld; const bool ok = t < T; const size_t off = (size_t)(rowbase + (ok ? t : 0)) * D + ch + 2 * kq;
                      lr = *(const f32x2*)(Rr + off); lk = *(const f32x2*)(Kr + off); lv = *(const f32x2*)(Vr + off); ld = *(const f32x2*)(DEC + off); la = *(const f32x2*)(AAp + off); }
                    const int nch = (T + 15) >> 4;
                    __syncthreads();
#pragma unroll 1
                    for (int cidx = 0; cidx < nch; ++cidx) {
                        LAS float* B = ob + (cidx & 1) * 6144;
                        {
                            f32x2 kkv = lk * kk2; float ssq = kkv.x * kkv.x + kkv.y * kkv.y;
                            ssq = sum16(ssq); { const int si = __builtin_bit_cast(int, ssq); ssq += __builtin_bit_cast(float, __builtin_amdgcn_ds_swizzle(si, 0x401F)); }
                            const float nrm = fmaxf(sqrtf(ssq), 1e-12f); kkv = kkv * (1.f / nrm);
                            const f32x2 km = lk * (1.f + (la - 1.f) * ka2), kav = kkv * la;
                            { float rkp = lr.x * km.x * rk2.x + lr.y * km.y * rk2.y; rkp = sum16(rkp); { const int si = __builtin_bit_cast(int, rkp); rkp += __builtin_bit_cast(float, __builtin_amdgcn_ds_swizzle(si, 0x401F)); }
                              const int tt = cidx * 16 + st_ld; if (kq == 0 && half == 0 && tt < T) RKb[(size_t)(rowbase + tt) * 16 + h] = rkp; }
                            const int o = st_ld * 64 + 2 * kq;
                            *(LAS f32x2*)(B + o) = ld; *(LAS f32x2*)(B + 1024 + o) = kkv; *(LAS f32x2*)(B + 2048 + o) = kav; *(LAS f32x2*)(B + 3072 + o) = km; *(LAS f32x2*)(B + 4096 + o) = lr; *(LAS f32x2*)(B + 5120 + o) = lv;
                        }
                        if (cidx + 1 < nch) { const int t = (cidx + 1) * 16 + st_ld; const bool ok = t < T; const size_t off = (size_t)(rowbase + (ok ? t : 0)) * D + ch + 2 * kq;
                            lr = *(const f32x2*)(Rr + off); lk = *(const f32x2*)(Kr + off); lv = *(const f32x2*)(Vr + off); ld = *(const f32x2*)(DEC + off); la = *(const f32x2*)(AAp + off); }
                        __syncthreads();
                        const int t0 = cidx * 16;
                        f32x2 ykeep = {0.f, 0.f}; f32x4 nSa = Sa, nSb = Sb;
#define SCAN_STEP(st, IND) { if (IND) { Sa = nSa; Sb = nSb; const int sn_ = (st) < 15 ? (st) + 1 : 15; nSa = *(const f32x4*)(sin_ + (size_t)sn_ * 65536); nSb = *(const f32x4*)(sin_ + (size_t)sn_ * 65536 + 64); }     \
                            const LAS float* bs = B + (st) * 64 + 4 * p; \
                            const f32x4 w4 = *(const LAS f32x4*)bs, kk4 = *(const LAS f32x4*)(bs + 1024), ka4 = *(const LAS f32x4*)(bs + 2048), km4 = *(const LAS f32x4*)(bs + 3072), r4 = *(const LAS f32x4*)(bs + 4096); \
                            const f32x2 vv = *(const LAS f32x2*)(B + 5120 + (st) * 64 + vrow); \
                            float sa0 = (Sa.x * kk4.x + Sa.y * kk4.y) + (Sa.z * kk4.z + Sa.w * kk4.w), sa1 = (Sb.x * kk4.x + Sb.y * kk4.y) + (Sb.z * kk4.z + Sb.w * kk4.w); \
                            sa0 = -sum16(sa0); sa1 = -sum16(sa1); \
                            Sa = Sa * w4 + ka4 * sa0 + km4 * vv.x; Sb = Sb * w4 + ka4 * sa1 + km4 * vv.y; \
                            float y0 = (Sa.x * r4.x + Sa.y * r4.y) + (Sa.z * r4.z + Sa.w * r4.w), y1 = (Sb.x * r4.x + Sb.y * r4.y) + (Sb.z * r4.z + Sb.w * r4.w); \
                            y0 = sum16(y0); y1 = sum16(y1); \
                            if (p == (st)) { ykeep.x = y0; ykeep.y = y1; } \
                            if (IND) { *(f32x4*)(sout_ + (size_t)(st) * 65536) = Sa; *(f32x4*)(sout_ + (size_t)(st) * 65536 + 64) = Sb; } }
                        if (cw) {
                            if (!indep) {
#pragma unroll
                                for (int st = 0; st < 16; ++st) SCAN_STEP(st, false)
                            } else {
                                nSa = *(const f32x4*)sin_; nSb = *(const f32x4*)(sin_ + 64);
#pragma unroll 1
                                for (int st = 0; st < 16; ++st) SCAN_STEP(st, true)
                            }
                            *(f32x2*)(YR + (size_t)(rowbase + t0 + p) * D + ch + vrow) = ykeep;
                        }
#undef SCAN_STEP
                    }
                    if (!indep && cw) { float* so = out + O_WKP + (size_t)(seq * 16 + h) * 4096 + vrow * 64 + 4 * p; *(f32x4*)so = Sa; *(f32x4*)(so + 64) = Sb; }
                    __syncthreads();
                }
            }
            PH_END
            PH_BEGIN(3)
            {
                const float *Vr = RKV + (size_t)2 * M * D; const bf16* GB = (const bf16*)(DAG + (size_t)2 * M * D); const float* RKb = (const float*)(ws + WB_L1);
                const float *ln_g = a.in[26], *ln_b = a.in[27];
                for (int m = gw; m < M; m += NGW) {
                    const size_t off = (size_t)m * D + lane * 16; const int c0 = lane * 16;
                    f32x4 y[4]; float s1 = 0.f;
                    const float rk = RKb[(size_t)m * 16 + (lane >> 2)];
                    const u32x4 g0 = *(const u32x4*)(GB + off), g1 = *(const u32x4*)(GB + off + 8);
#pragma unroll
                    for (int j = 0; j < 4; ++j) { y[j] = *(const f32x4*)(YR + off + 4 * j); s1 += (y[j].x + y[j].y) + (y[j].z + y[j].w); }
                    s1 = sum4(s1);
                    const float mu = s1 * (1.f / 64.f); float s2 = 0.f;
#pragma unroll
                    for (int j = 0; j < 4; ++j) { const f32x4 d = y[j] - mu; s2 += (d.x * d.x + d.y * d.y) + (d.z * d.z + d.w * d.w); }
                    s2 = sum4(s2);
                    const float rstd = 1.0f / sqrtf(s2 * (1.f / 64.f) + 64e-5f);
                    u32x4 w0, w1;
#pragma unroll
                    for (int j = 0; j < 4; ++j) { const f32x4 lg = *(const f32x4*)(ln_g + c0 + 4 * j), lb = *(const f32x4*)(ln_b + c0 + 4 * j), v = *(const f32x4*)(Vr + off + 4 * j);
                        const unsigned ga = j == 0 ? g0.x : (j == 1 ? g0.z : (j == 2 ? g1.x : g1.z)), gb = j == 0 ? g0.y : (j == 1 ? g0.w : (j == 2 ? g1.y : g1.w));
                        const f32x4 g = {__uint_as_float(ga << 16), __uint_as_float(ga & 0xffff0000u), __uint_as_float(gb << 16), __uint_as_float(gb & 0xffff0000u)};
                        const f32x4 o = ((y[j] - mu) * rstd * lg + lb + v * rk) * g;
                        const unsigned a0 = cvt_pk_bf16(o[0], o[1]), a1 = cvt_pk_bf16(o[2], o[3]);
                        if (j == 0) { w0.x = a0; w0.y = a1; } else if (j == 1) { w0.z = a0; w0.w = a1; } else if (j == 2) { w1.x = a0; w1.y = a1; } else { w1.z = a0; w1.w = a1; } }
                    u32x4* yp = (u32x4*)(Y + off); yp[0] = w0; yp[1] = w1;
                }
            }
            PH_END
        } else {
            bf16* BC = (bf16*)(ws + CB_BC); float* U = (float*)(ws + CB_U); bf16* A2 = (bf16*)(ws + CB_A2);
            outA = A2; outB = (const bf16*)(ws + WS_COUT); outK = D;
            PH_BEGIN(4)
            {
                pg8::Gemm g{XN, (const bf16*)(ws + WS_CIN), M, 3072, D}; pg8::StaticOrder S; S.init(M, 3072, G, bid);
                EpiConvIn E{BC, U};
                pg8::gemm_phase<EpiConvIn, pg8::StaticOrder, true, true>(lds, g, S, E);
            }
            PH_END
            PH_BEGIN(3)
            {
                const float* cw = a.in[30]; const float* cst = a.in[5];
                for (size_t e = (size_t)bid * 512 + tid; e < (size_t)M * 256; e += (size_t)G * 512) {
                    const int m = (int)(e >> 8), c = (int)(e & 255) * 4;
                    const f32x4 w0 = *(const f32x4*)(cw + c), w1 = *(const f32x4*)(cw + D + c), w2 = *(const f32x4*)(cw + 2 * D + c);
                    const f32x4 u2 = *(const f32x4*)(U + (size_t)m * D + c); f32x4 u1, u0;
                    if (m < MP) { const int b = m / TP, t = m - b * TP;
                        u1 = t >= 1 ? *(const f32x4*)(U + (size_t)(m - 1) * D + c) : (f32x4){0.f, 0.f, 0.f, 0.f};
                        u0 = t >= 2 ? *(const f32x4*)(U + (size_t)(m - 2) * D + c) : (f32x4){0.f, 0.f, 0.f, 0.f};
                        if (t >= TP - 2) *(f32x4*)(out + O_CVP + ((size_t)b * 2 + (t - (TP - 2))) * D + c) = u2;
                    } else { const int s = m - MP;
                        u0 = *(const f32x4*)(cst + ((size_t)s * 2) * D + c); u1 = *(const f32x4*)(cst + ((size_t)s * 2 + 1) * D + c);
                        *(f32x4*)(out + O_CVS + ((size_t)s * 2) * D + c) = u1; *(f32x4*)(out + O_CVS + ((size_t)s * 2 + 1) * D + c) = u2; }
                    const f32x4 yv = w0 * u0 + w1 * u1 + w2 * u2;
                    const u32x2 bb = *(const u32x2*)(BC + (size_t)m * D + c);
                    const float b0 = __uint_as_float(bb.x << 16), b1 = __uint_as_float(bb.x & 0xffff0000u), b2 = __uint_as_float(bb.y << 16), b3 = __uint_as_float(bb.y & 0xffff0000u);
                    u32x2 wv; wv.x = cvt_pk_bf16(b0 * yv[0], b1 * yv[1]); wv.y = cvt_pk_bf16(b2 * yv[2], b3 * yv[3]);
                    *(u32x2*)(A2 + (size_t)m * D + c) = wv;
                }
            }
            PH_END
        }
        PH_BEGIN(7)
        {
            pg8::Gemm g{outA, outB, M, D, outK}; TailOrder S; S.init(D, outK, G, bid);
            EpiResid E{H, (rep_ & 1) ? -1.f : 1.f};
            pg8::gemm_phase<EpiResid, TailOrder, true, true>(lds, g, S, E);
        }
        PH_END
        PH_BEGIN(3)
        {
            const float* gain = a.in[9] + (size_t)layer * D;
            for (int m = gw; m < M; m += 2 * NGW) { const int m1 = m + NGW; const bool has1 = m1 < M; f32x4 v0[4], v1[4]; rms_row2(H + (size_t)m * D, H + (size_t)(has1 ? m1 : m) * D, gain, lane, v0, v1); store_row_bf16(XN + (size_t)m * D, lane, v0); if (has1) store_row_bf16(XN + (size_t)m1 * D, lane, v1); }
        }
        PH_END
        bf16* ACT = (bf16*)(ws + MB_ACT);
        PH_BEGIN(4)
        {
            pg8::Gemm g{XN, (const bf16*)(ws + WS_M1 + (size_t)layer * al((size_t)FF * D * 2)), M, FF, D}; pg8::StaticOrder S; S.init(M, FF, G, bid);
            EpiRelu2 E{ACT};
            pg8::gemm_phase<EpiRelu2, pg8::StaticOrder, true, true>(lds, g, S, E);
        }
        PH_END
        PH_BEGIN(7)
        {
            pg8::Gemm g{ACT, (const bf16*)(ws + WS_M2 + (size_t)layer * al((size_t)FF * D * 2)), M, D, FF}; TailOrder S; S.init(D, FF, G, bid);
            EpiResid E{H, (rep_ & 1) ? -1.f : 1.f};
            pg8::gemm_phase<EpiResid, TailOrder, true, true>(lds, g, S, E);
        }
        PH_END
        PH_BEGIN(3)
        {
            if (layer == 3) {
                for (int m = gw; m < M; m += NGW) {
                    float* dst;
                    if (m < MP) { const int b = m / TP, t = m - b * TP; if (t < 16) continue; dst = out + O_YP + ((size_t)b * 2048 + (t - 16)) * D; }
                    else dst = out + O_YS + (size_t)(m - MP) * D;
                    f32x4 v[4]; rms_row(H + (size_t)m * D, a.in[10], lane, v);
                    f32x4* o = (f32x4*)dst + lane;
#pragma unroll
                    for (int j = 0; j < 4; ++j) o[64 * j] = v[j];
                }
            } else if ((layer + 1) % 3 == 1) {
                const float* gain = a.in[8] + (size_t)(layer + 1) * D; const float* mix = a.in[13];
                bf16* XM = (bf16*)(ws + WB_XM);
                f32x4 mrow[6][4];
#pragma unroll
                for (int q = 0; q < 6; ++q)
#pragma unroll
                    for (int j = 0; j < 4; ++j) mrow[q][j] = ((const f32x4*)(mix + (size_t)q * D) + lane)[64 * j];
                for (int m = gw; m < M; m += NGW) {
                    f32x4 xn[4], xp[4];
                    rms_row(H + (size_t)m * D, gain, lane, xn);
                    int b = 0, t = 0;
                    if (m < MP) { b = m / TP; t = m - b * TP;
                        if (t > 0) rms_row(H + (size_t)(m - 1) * D, gain, lane, xp);
                        else {
#pragma unroll
                            for (int j = 0; j < 4; ++j) xp[j] = (f32x4){0.f, 0.f, 0.f, 0.f}; }
                        if (t == TP - 1) { f32x4* o = (f32x4*)(out + O_SHP + (size_t)b * D) + lane;
#pragma unroll
                            for (int j = 0; j < 4; ++j) o[64 * j] = xn[j]; }
                    } else { const int s = m - MP; const f32x4* sp = (const f32x4*)(a.in[3] + (size_t)s * D) + lane; f32x4* o = (f32x4*)(out + O_SHS + (size_t)s * D) + lane;
#pragma unroll
                        for (int j = 0; j < 4; ++j) { xp[j] = sp[64 * j]; o[64 * j] = xn[j]; } }
#pragma unroll
                    for (int j = 0; j < 4; ++j) xp[j] = xp[j] - xn[j];
#pragma unroll
                    for (int q = 0; q < 6; ++q) { f32x4 v[4];
#pragma unroll
                        for (int j = 0; j < 4; ++j) v[j] = xn[j] + xp[j] * mrow[q][j];
                        store_row_bf16(XM + ((size_t)q * M + m) * D, lane, v); }
                }
            } else {
                const float* gain = a.in[8] + (size_t)(layer + 1) * D;
                for (int m = gw; m < M; m += 2 * NGW) { const int m1 = m + NGW; const bool has1 = m1 < M; f32x4 v0[4], v1[4]; rms_row2(H + (size_t)m * D, H + (size_t)(has1 ? m1 : m) * D, gain, lane, v0, v1); store_row_bf16(XN + (size_t)m * D, lane, v0); if (has1) store_row_bf16(XN + (size_t)m1 * D, lane, v1); }
            }
        }
        PH_END
    }
#undef PH_BEGIN
#undef PH_END
}

constexpr int N_PHASES = 33;

#ifndef REP0
#define REP0 1
#define REP1 1
#define REP2 1
#define REP3 1
#define REP4 1
#endif
#ifndef REP5
#define REP5 1
#endif
#ifndef REP7
#define REP7 1
#endif
#ifndef MK_MULTI
#define MK_MULTI 0
#endif

extern "C" void kernel_launch(void* const* d_in, const int* in_sizes, int n_in, void* d_out, int out_size, void* d_ws, size_t ws_size, hipStream_t stream) {
    static int grid = 0;
    if (grid == 0) {
        if (n_in != 34 || (size_t)out_size != O_END || ws_size < WS_TOTAL) { fprintf(stderr, "kernel_launch: unexpected shapes: n_in %d out %d ws %zu (need %zu)\n", n_in, out_size, ws_size, (size_t)WS_TOTAL); grid = -1; return; }
        int dev = 0, cus = 0, per_cu = 0;
        hipGetDevice(&dev); hipDeviceGetAttribute(&cus, hipDeviceAttributeMultiprocessorCount, dev);
        if (hipFuncSetAttribute((const void*)fwd_kernel, hipFuncAttributeMaxDynamicSharedMemorySize, LDS_BYTES) != hipSuccess) { fprintf(stderr, "kernel_launch: hipFuncSetAttribute failed\n"); grid = -1; return; }
        if (hipOccupancyMaxActiveBlocksPerMultiprocessor(&per_cu, (const void*)fwd_kernel, 512, LDS_BYTES) != hipSuccess || per_cu < 1) { fprintf(stderr, "kernel_launch: occupancy query says %d\n", per_cu); (void)hipGetLastError(); grid = -1; return; }
        grid = cus * 1;
    }
    if (grid < 0) return;
    if (hipMemsetAsync((char*)d_ws + WS_BAR, 0, 16384, stream) != hipSuccess) { fprintf(stderr, "kernel_launch: memset failed\n"); return; }
    KArgs a{};
    for (int i = 0; i < 34; ++i) a.in[i] = (const float*)d_in[i];
    a.out = (float*)d_out; a.ws = (unsigned char*)d_ws;
    { const int reps[8] = {REP0, REP1, REP2, REP3, REP4, REP5, 1, REP7}; for (int i = 0; i < 8; ++i) a.rep[i] = reps[i]; }
#if MK_MULTI
    for (int p = 0; p < N_PHASES; ++p) { a.ph_lo = p; a.ph_hi = p + 1; a.coop = 0; hipLaunchKernelGGL(fwd_kernel, dim3(grid), dim3(512), LDS_BYTES, stream, a); }
#else
    a.ph_lo = 0; a.ph_hi = N_PHASES; a.coop = 1;
    void* args[] = {&a};
    hipError_t e = hipLaunchCooperativeKernel((const void*)fwd_kernel, dim3(grid), dim3(512), args, LDS_BYTES, stream);
    if (e != hipSuccess) fprintf(stderr, "cooperative launch failed: %s (grid %d)\n", hipGetErrorString(e), grid);
#endif
}
```

```cpp
#include <hip/hip_runtime.h>
#include <hip/hip_cooperative_groups.h>
#include <cstdio>
#include <cstdint>
namespace cg = cooperative_groups;
namespace pg8 {
#define PG8_LAS __attribute__((address_space(3)))
typedef unsigned short bf16_t;
typedef short bf16x8 __attribute__((ext_vector_type(8)));
typedef float f32x4 __attribute__((ext_vector_type(4)));
typedef unsigned u32x4 __attribute__((ext_vector_type(4)));
constexpr int BM = 256, BK = 64, HALF = 128, HTB = HALF * BK * 2  , STAGE_BYTES = 8 * HTB, NXCD = 8, WGM = 8;

__host__ __device__ __forceinline__ int lds_byte(int r, int c) { const int st = (r >> 4) * 2 + (c >> 5), rr = r & 15, cc = c & 31, ob = rr * 64 + cc * 2; return st * 1024 + (ob ^ (((ob >> 9) & 1) << 5)); }
__host__ __device__ __forceinline__ void stage_rc(int b, int& R, int& C) { const int st = b / 1024, sb = b % 1024, swz = sb ^ (((sb >> 9) & 1) << 5); R = (st >> 1) * 16 + swz / 64; C = (st & 1) * 32 + (swz % 64) / 2; }
__host__ __device__ __forceinline__ int perm32(int rho) { const int n = rho >> 4, i = rho & 15; return 8 * (i >> 2) + 4 * n + (i & 3); }

struct Unit { int pm, pn, k0, nt; };
struct Gemm { const bf16_t* A; const bf16_t* Bt; int M, N, K; };

struct StaticOrder {
    int nM, nN, nwg, G, c;
    __host__ __device__ void init(int M, int N, int G_, int c_) { nM = M / BM; nN = N / BM; nwg = nM * nN; G = G_; c = c_; }
    __host__ __device__ __forceinline__ bool next(int i, Unit& u) const {
        const long L = (long)i * G + c; if (L >= nwg) return false;
        int wgid = (int)L; { const int q = nwg / NXCD, r = nwg % NXCD, xcd = wgid % NXCD, off = wgid / NXCD; wgid = (xcd < r ? xcd * (q + 1) : r * (q + 1) + (xcd - r) * q) + off; }
        const int nig = WGM * nN, gid = wgid / nig, fm = gid * WGM, gsz = (nM - fm) < WGM ? (nM - fm) : WGM;
        u.pm = fm + ((wgid % nig) % gsz); u.pn = (wgid % nig) / gsz; u.k0 = 0; u.nt = 0; return true;
    }
    __device__ __forceinline__ void a_ready(const Unit&) const {}
    __device__ __forceinline__ void done(const Unit&) const {}
};

__device__ __forceinline__ unsigned cvt_pk_bf16(float lo, float hi) { unsigned r; asm volatile("v_cvt_pk_bf16_f32 %0, %1, %2" : "=v"(r) : "v"(lo), "v"(hi)); return r; }
template <class Epi, class Sched, bool ALIGN_EPI = false, bool SP2 = false>
__device__ __forceinline__ void gemm_phase(PG8_LAS unsigned char* lds, const Gemm g, const Sched& S, const Epi& E) {
    int tid_ = threadIdx.x; asm volatile("" : "+v"(tid_));
    const int tid = tid_, wid = __builtin_amdgcn_readfirstlane(tid >> 6), lane = tid & 63, wr = wid >> 2, wc = wid & 3, fr = lane & 15, fq = lane >> 4;
    const int K = g.K, nt = K / BK;
    unsigned voffA[2], voffB[2];
#pragma unroll
    for (int i = 0; i < 2; ++i) { int R, C; stage_rc(tid * 16 + i * 8192, R, C); const int Rb = Epi::PERM ? ((R & ~31) + perm32(R & 31)) : R;
        voffA[i] = (unsigned)(R * K + C) * 2u; voffB[i] = (unsigned)(Rb * K + C) * 2u; }
    const size_t kstep = (size_t)(BK * 2);
    const size_t hstep = (size_t)HALF * K * 2;
    const size_t tstep = 2 * hstep;
    const unsigned ldsw = (unsigned)wid * 1024u;
    const int aoff = lds_byte(wr * 64 + fr, fq * 8), boff = lds_byte(wc * 32 + fr, fq * 8);
#define PG8_SA(b, h) (((b) * 2 + (h)) * HTB)
#define PG8_SB(b, h) ((4 + (b) * 2 + (h)) * HTB)
#define PG8_STAGE(bufoff, gbase, voff) do { _Pragma("unroll") for (int _i = 0; _i < 2; ++_i) \
        __builtin_amdgcn_global_load_lds((const unsigned*)((const char*)(gbase) + (voff)[_i]), (PG8_LAS unsigned*)(lds + (bufoff) + ldsw + _i * 8192), 16, 0, 0); } while (0)
#define PG8_LDA(dst, b, h) do { _Pragma("unroll") for (int m = 0; m < 4; ++m) _Pragma("unroll") for (int k = 0; k < 2; ++k) dst[m][k] = *(const PG8_LAS bf16x8*)(lds + PG8_SA(b, h) + aoff + m * 2048 + k * 1024); } while (0)
#define PG8_LDB(dst, b, h) do { _Pragma("unroll") for (int n = 0; n < 2; ++n) _Pragma("unroll") for (int k = 0; k < 2; ++k) dst[n][k] = *(const PG8_LAS bf16x8*)(lds + PG8_SB(b, h) + boff + n * 2048 + k * 1024); } while (0)
#define PG8_MMA(ai, bj, At, Bt) do { __builtin_amdgcn_s_setprio(1); _Pragma("unroll") for (int m = 0; m < 4; ++m) _Pragma("unroll") for (int n = 0; n < 2; ++n) _Pragma("unroll") for (int k = 0; k < 2; ++k) \
        acc[ai][bj][m][n] = __builtin_amdgcn_mfma_f32_16x16x32_bf16(Bt[n][k], At[m][k], acc[ai][bj][m][n], 0, 0, 0); __builtin_amdgcn_s_setprio(0); } while (0)
#define PG8_WAIT_V(n) asm volatile("s_waitcnt vmcnt(" #n ")" ::: "memory")
#define PG8_WAIT_L(n) asm volatile("s_waitcnt lgkmcnt(" #n ")" ::: "memory")
#define PG8_BAR __builtin_amdgcn_s_barrier()
#define PG8_SCHED __builtin_amdgcn_sched_barrier(0)
    Unit cur, nxt; int ui = 0;
    if (!S.next(0, cur)) return;
    f32x4 acc[2][2][4][2];
#pragma unroll
    for (int a = 0; a < 2; ++a)
#pragma unroll
        for (int b = 0; b < 2; ++b)
#pragma unroll
            for (int m = 0; m < 4; ++m)
#pragma unroll
                for (int n = 0; n < 2; ++n) acc[a][b][m][n] = (f32x4){0.f, 0.f, 0.f, 0.f};
    bf16x8 At[4][2], B0[2][2], B1[2][2];
    const char* cA = (const char*)g.A + (size_t)cur.pm * tstep + (size_t)cur.k0 * 2; const char* cB = (const char*)g.Bt + (size_t)cur.pn * tstep + (size_t)cur.k0 * 2;
    S.a_ready(cur);
    if constexpr (SP2) {
        PG8_STAGE(PG8_SB(0, 0), cB, voffB); PG8_STAGE(PG8_SB(0, 1), cB + hstep, voffB); PG8_STAGE(PG8_SA(0, 0), cA, voffA); PG8_STAGE(PG8_SA(0, 1), cA + hstep, voffA);
        if (wr == 1) PG8_BAR;
        PG8_WAIT_V(2); PG8_BAR;
        PG8_STAGE(PG8_SB(1, 0), cB + kstep, voffB); PG8_STAGE(PG8_SA(1, 0), cA + kstep, voffA); PG8_STAGE(PG8_SB(1, 1), cB + hstep + kstep, voffB);
        PG8_WAIT_V(6); PG8_BAR;
    } else {
        PG8_STAGE(PG8_SB(0, 0), cB, voffB); PG8_STAGE(PG8_SA(0, 0), cA, voffA); PG8_STAGE(PG8_SB(0, 1), cB + hstep, voffB); PG8_STAGE(PG8_SA(0, 1), cA + hstep, voffA);
        if (wr == 1) PG8_BAR;
        PG8_WAIT_V(4); PG8_BAR;
        PG8_STAGE(PG8_SB(1, 0), cB + kstep, voffB); PG8_STAGE(PG8_SA(1, 0), cA + kstep, voffA); PG8_STAGE(PG8_SB(1, 1), cB + hstep + kstep, voffB);
        PG8_WAIT_V(6); PG8_BAR;
    }
    for (;;) {
        const bool has_next = S.next(ui + 1, nxt);
        const char* nA = has_next ? (const char*)g.A + (size_t)nxt.pm * tstep + (size_t)nxt.k0 * 2 : cA; const char* nB = has_next ? (const char*)g.Bt + (size_t)nxt.pn * tstep + (size_t)nxt.k0 * 2 : cB;
        const int ntc = cur.nt ? cur.nt : nt;
        for (int t = 0; t < ntc; t += 2) {
            const bool last = (t == ntc - 2);
            const char* a1 = cA + (size_t)(t + 1) * kstep;
            const char* a2 = last ? nA : cA + (size_t)(t + 2) * kstep; const char* b2 = last ? nB : cB + (size_t)(t + 2) * kstep;
            const char* a3 = a2 + kstep; const char* b3 = b2 + kstep;
            if (last && has_next) S.a_ready(nxt);
            if constexpr (SP2) {
            PG8_LDB(B0, 0, 0); PG8_LDB(B1, 0, 1); PG8_SCHED; PG8_LDA(At, 0, 0); PG8_STAGE(PG8_SA(1, 1), a1 + hstep, voffA);
            PG8_WAIT_V(8); PG8_WAIT_L(0); PG8_BAR; PG8_MMA(0, 0, At, B0); PG8_MMA(0, 1, At, B1); PG8_BAR; PG8_SCHED;
            PG8_LDA(At, 0, 1); PG8_STAGE(PG8_SB(0, 0), b2, voffB); PG8_STAGE(PG8_SB(0, 1), b2 + hstep, voffB); PG8_STAGE(PG8_SA(0, 0), a2, voffA);
            PG8_WAIT_V(8); PG8_WAIT_L(0); PG8_BAR; PG8_MMA(1, 0, At, B0); PG8_MMA(1, 1, At, B1); PG8_BAR; PG8_SCHED;
            PG8_LDB(B0, 1, 0); PG8_LDB(B1, 1, 1); PG8_SCHED; PG8_LDA(At, 1, 0); PG8_STAGE(PG8_SA(0, 1), a2 + hstep, voffA);
            PG8_WAIT_V(8); PG8_WAIT_L(0); PG8_BAR; PG8_MMA(0, 0, At, B0); PG8_MMA(0, 1, At, B1); PG8_BAR; PG8_SCHED;
            PG8_LDA(At, 1, 1); PG8_STAGE(PG8_SB(1, 0), b3, voffB); PG8_STAGE(PG8_SB(1, 1), b3 + hstep, voffB); PG8_STAGE(PG8_SA(1, 0), a3, voffA);
            PG8_WAIT_V(8); PG8_WAIT_L(0); PG8_BAR; PG8_MMA(1, 0, At, B0); PG8_MMA(1, 1, At, B1); PG8_BAR; PG8_SCHED;
            } else {
            PG8_LDB(B0, 0, 0); PG8_SCHED; PG8_LDA(At, 0, 0); PG8_STAGE(PG8_SA(1, 1), a1 + hstep, voffA);
            PG8_WAIT_L(8); PG8_BAR; PG8_WAIT_L(0); PG8_MMA(0, 0, At, B0); PG8_BAR; PG8_SCHED;
            PG8_LDB(B1, 0, 1); PG8_STAGE(PG8_SB(0, 0), b2, voffB);
            PG8_BAR; PG8_WAIT_L(0); PG8_MMA(0, 1, At, B1); PG8_BAR;
            PG8_LDA(At, 0, 1); PG8_STAGE(PG8_SA(0, 0), a2, voffA);
            PG8_BAR; PG8_WAIT_L(0); PG8_MMA(1, 0, At, B0); PG8_BAR; PG8_SCHED;
            PG8_STAGE(PG8_SB(0, 1), b2 + hstep, voffB);
            PG8_WAIT_V(6); PG8_BAR; PG8_MMA(1, 1, At, B1); PG8_BAR;
            PG8_LDB(B0, 1, 0); PG8_SCHED; PG8_LDA(At, 1, 0); PG8_STAGE(PG8_SA(0, 1), a2 + hstep, voffA);
            PG8_WAIT_L(8); PG8_BAR; PG8_WAIT_L(0); PG8_MMA(0, 0, At, B0); PG8_BAR; PG8_SCHED;
            PG8_LDB(B1, 1, 1); PG8_STAGE(PG8_SB(1, 0), b3, voffB);
            PG8_BAR; PG8_WAIT_L(0); PG8_MMA(0, 1, At, B1); PG8_BAR;
            PG8_LDA(At, 1, 1); PG8_STAGE(PG8_SA(1, 0), a3, voffA);
            PG8_BAR; PG8_WAIT_L(0); PG8_MMA(1, 0, At, B0); PG8_BAR; PG8_SCHED;
            PG8_STAGE(PG8_SB(1, 1), b3 + hstep, voffB);
            PG8_WAIT_V(6); PG8_BAR; PG8_MMA(1, 1, At, B1); PG8_BAR;
            }
        }
        if constexpr (ALIGN_EPI) { if (wr == 0) PG8_BAR; }
        if constexpr (!Epi::AFTER_DRAIN) { E(acc, cur, wr, wc, fr, fq); S.done(cur); }
        if (!has_next) break;
#pragma unroll
        for (int a = 0; a < 2; ++a)
#pragma unroll
            for (int b = 0; b < 2; ++b)
#pragma unroll
                for (int m = 0; m < 4; ++m)
#pragma unroll
                    for (int n = 0; n < 2; ++n) acc[a][b][m][n] = (f32x4){0.f, 0.f, 0.f, 0.f};
        cur = nxt; cA = nA; cB = nB; ++ui;
        if constexpr (ALIGN_EPI) { if (wr == 1) PG8_BAR; }
    }
    PG8_WAIT_V(0);
    if constexpr (!ALIGN_EPI) { if (wr == 0) PG8_BAR; }
    PG8_BAR;
    if constexpr (Epi::AFTER_DRAIN) { E.fused(acc, cur, wr, wc, fr, fq, lds, wid, lane); S.done(cur); }
#undef PG8_SA
#undef PG8_SB
#undef PG8_STAGE
#undef PG8_LDA
#undef PG8_LDB
#undef PG8_MMA
#undef PG8_WAIT_V
#undef PG8_WAIT_L
#undef PG8_BAR
#undef PG8_SCHED
}
}

#define LAS __attribute__((address_space(3)))
typedef unsigned short bf16;
typedef short bf16x8 __attribute__((ext_vector_type(8)));
typedef float f32x4 __attribute__((ext_vector_type(4)));
typedef float f32x2 __attribute__((ext_vector_type(2)));
typedef float f32x16 __attribute__((ext_vector_type(16)));
typedef unsigned u32x4 __attribute__((ext_vector_type(4)));
typedef unsigned u32x2 __attribute__((ext_vector_type(2)));
using pg8::cvt_pk_bf16;
using pg8::Unit;

constexpr int D = 1024, NB = 8, TP = 2064, MP = NB * TP, NS = 128, M = MP + NS, NMT = M / 256;
constexpr int FF = 4096, NRI = 6144, HV = 2048;
constexpr float EPS = 1e-6f;
static_assert(M % 256 == 0, "rows");

constexpr size_t O_YP = 0, O_YS = 16777216, O_R0P = 16908288, O_R0S = 21102592, O_SHP = 88211456, O_SHS = 88219648,
                 O_WKP = 88350720, O_WKS = 88875008, O_CVP = 97263616, O_CVS = 97280000, O_R3P = 97542144, O_R3S = 101736448, O_END = 168845312;

constexpr size_t al(size_t x) { return (x + 4095) & ~(size_t)4095; }
constexpr size_t WS_RI0 = 4096, WS_RI1 = WS_RI0 + al((size_t)NRI * D * 2), WS_RO0 = WS_RI1 + al((size_t)NRI * D * 2), WS_RO1 = WS_RO0 + al((size_t)D * HV * 2),
                 WS_RW1 = WS_RO1 + al((size_t)D * HV * 2), WS_RW2 = WS_RW1 + al((size_t)3840 * D * 2), WS_RWO = WS_RW2 + al((size_t)3072 * 256 * 2),
                 WS_CIN = WS_RWO + al((size_t)D * D * 2), WS_COUT = WS_CIN + al((size_t)3072 * D * 2), WS_M1 = WS_COUT + al((size_t)D * D * 2),
                 WS_M2 = WS_M1 + 4 * al((size_t)FF * D * 2), WS_ROPE = WS_M2 + 4 * al((size_t)FF * D * 2), WS_H = WS_ROPE + al((size_t)2065 * 128 * 8),
                 WS_XN = WS_H + al((size_t)M * D * 4), WS_B = WS_XN + al((size_t)M * D * 2);
constexpr size_t RB_Q = WS_B, RB_K = RB_Q + al((size_t)M * D * 2), RB_KTD = RB_K + al((size_t)M * D * 2), RB_VT = RB_KTD + al((size_t)32 * 256 * TP * 2),
                 RB_VS = RB_VT + al((size_t)32 * 512 * TP * 2), RB_SG = RB_VS + al((size_t)NS * HV * 4), RB_OB = RB_SG + al((size_t)M * HV * 2),
                 RB_Y = RB_OB + al((size_t)M * HV * 2), RB_END = RB_Y + al((size_t)M * HV * 2);
constexpr size_t WB_XM = WS_B, WB_DAG = WS_B  , WB_RKV = WB_XM + al((size_t)6 * M * D * 2), WB_L1 = WB_RKV + al((size_t)3 * M * D * 4),
                 WB_YR = WB_L1 + al((size_t)3 * M * 256 * 2), WB_Y = WB_YR + al((size_t)M * D * 4), WB_END = WB_Y + al((size_t)M * D * 2);
static_assert((size_t)3 * M * D * 4 <= (size_t)6 * M * D * 2, "DAG fits over XM");
constexpr size_t CB_BC = WS_B, CB_U = CB_BC + al((size_t)M * D * 2), CB_A2 = CB_U + al((size_t)M * D * 4), CB_END = CB_A2 + al((size_t)M * D * 2);
constexpr size_t MB_ACT = WS_B, MB_END = MB_ACT + al((size_t)M * FF * 2);
constexpr size_t cmax(size_t a, size_t b) { return a > b ? a : b; }
constexpr size_t WS_END = cmax(cmax(RB_END, WB_END), cmax(CB_END, MB_END));

constexpr size_t WS_BAR = al(WS_END), WS_TOTAL = WS_BAR + 16384;
constexpr int LDS_BYTES = 147456, LDS_MISC = 131072 + 256;

#define LDS_WAIT() asm volatile("s_waitcnt lgkmcnt(0)" ::: "memory")
__device__ __forceinline__ float bf2f(bf16 x) { return __uint_as_float((unsigned)x << 16); }
__device__ __forceinline__ unsigned f2bf(float f) { unsigned u = __builtin_bit_cast(unsigned, f); return (u + 0x7fffu + ((u >> 16) & 1u)) >> 16; }
__device__ __forceinline__ unsigned pk2(float lo, float hi) { return f2bf(lo) | (f2bf(hi) << 16); }
__device__ __forceinline__ float wave_sum(float v) {
#pragma unroll
    for (int o = 1; o < 64; o <<= 1) v += __shfl_xor(v, o);
    return v;
}
template <int CTRL> __device__ __forceinline__ float dpp_add(float x) {
    const int xi = __builtin_bit_cast(int, x);
    const int yi = __builtin_amdgcn_update_dpp(0, xi, CTRL, 0xF, 0xF, false);
    return x + __builtin_bit_cast(float, yi);
}
__device__ __forceinline__ float sum4(float x) { x = dpp_add<0xB1>(x); x = dpp_add<0x4E>(x); return x; }
__device__ __forceinline__ float sum16(float x) { x = sum4(x); x = dpp_add<0x141>(x); x = dpp_add<0x140>(x); return x; }
__device__ __forceinline__ int crow(int r, int hi) { return (r & 3) + 8 * (r >> 2) + 4 * hi; }
#define MFMA32(a, b, c) __builtin_amdgcn_mfma_f32_32x32x16_bf16((a), (b), (c), 0, 0, 0)

struct StackOrder {
    pg8::StaticOrder base; int mode;
    __device__ __forceinline__ bool next(int i, Unit& u) const {
        if (!base.next(i, u)) return false;
        const int j = mode == 1 ? (u.pn < 12 ? (u.pn >> 2) : u.pn - 9) : (u.pn >> 2);
        u.pm += NMT * j; return true;
    }
    __device__ __forceinline__ void a_ready(const Unit&) const {}
    __device__ __forceinline__ void done(const Unit&) const {}
};

struct TailOrder {
    pg8::StaticOrder base; int nN, nsmall, G, c;
    __device__ __forceinline__ void init(int N, int K, int G_, int c_) { base.init(M - 256, N, G_, c_); nN = N / 256; nsmall = nN * (K / 256); G = G_; c = c_; }
    __device__ __forceinline__ bool next(int i, Unit& u) const {
        const long L = (long)i * G + c;
        if (L < base.nwg) return base.next(i, u);
        const int s = (int)(L - base.nwg); if (s >= nsmall) return false;
        u.pm = NMT - 1; u.pn = s % nN; u.k0 = (s / nN) * 256; u.nt = 4; return true;
    }
    __device__ __forceinline__ void a_ready(const Unit&) const {}
    __device__ __forceinline__ void done(const Unit&) const {}
};

#define EPI_LOOP_ROWS for (int ai = 0; ai < 2; ++ai) for (int m = 0; m < 4; ++m)
#define EPI_LOOP_COLS for (int bj = 0; bj < 2; ++bj) for (int n = 0; n < 2; ++n)

struct EpiResid {
    static constexpr bool PERM = false, AFTER_DRAIN = false;
    float* H; float sgn;
    __device__ __forceinline__ void operator()(const f32x4 (&acc)[2][2][4][2], const Unit& u, int wr, int wc, int fr, int fq) const {
        const int row0 = u.pm * 256 + wr * 64 + fr, col0 = u.pn * 256 + wc * 32 + 4 * fq;
        if (u.nt == 0) {
#pragma unroll
            EPI_LOOP_ROWS { float* rp = H + (size_t)(row0 + ai * 128 + m * 16) * D + col0;
#pragma unroll
                EPI_LOOP_COLS { f32x4* p = (f32x4*)(rp + bj * 128 + n * 16); *p = *p + acc[ai][bj][m][n] * sgn; } }
        } else {
#pragma unroll
            EPI_LOOP_ROWS { float* rp = H + (size_t)(row0 + ai * 128 + m * 16) * D + col0;
#pragma unroll
                EPI_LOOP_COLS { float* p = rp + bj * 128 + n * 16;
#pragma unroll
                    for (int i = 0; i < 4; ++i) __hip_atomic_fetch_add(p + i, acc[ai][bj][m][n][i] * sgn, __ATOMIC_RELAXED, __HIP_MEMORY_SCOPE_AGENT); } }
        }
    }
};

struct EpiRelu2 {
    static constexpr bool PERM = true, AFTER_DRAIN = false;
    bf16* O;
    __device__ __forceinline__ void operator()(const f32x4 (&acc)[2][2][4][2], const Unit& u, int wr, int wc, int fr, int fq) const {
#ifdef SKIP_EPIRELU2
        return;
#endif

        const int row0 = u.pm * 256 + wr * 64 + fr, col0 = u.pn * 256 + wc * 32 + 8 * fq;
#pragma unroll
        EPI_LOOP_ROWS { bf16* rp = O + (size_t)(row0 + ai * 128 + m * 16) * FF + col0;
#pragma unroll
            for (int bj = 0; bj < 2; ++bj) { f32x4 a = acc[ai][bj][m][0], b = acc[ai][bj][m][1];
                a = __builtin_elementwise_max(a, (f32x4){0.f, 0.f, 0.f, 0.f}); b = __builtin_elementwise_max(b, (f32x4){0.f, 0.f, 0.f, 0.f}); a = a * a; b = b * b;
                u32x4 w; w.x = cvt_pk_bf16(a[0], a[1]); w.y = cvt_pk_bf16(a[2], a[3]); w.z = cvt_pk_bf16(b[0], b[1]); w.w = cvt_pk_bf16(b[2], b[3]);
                *(u32x4*)(rp + bj * 128) = w; } }
    }
};

struct EpiRetIn {
    static constexpr bool PERM = false, AFTER_DRAIN = false;
    bf16 *Qb, *Kb, *KTD, *VT, *SG; float* VS; const float* rope;
    __device__ __forceinline__ void operator()(const f32x4 (&acc)[2][2][4][2], const Unit& u, int wr, int wc, int fr, int fq) const {
#ifdef SKIP_EPIRETIN
        return;
#endif

        const int row0 = u.pm * 256 + wr * 64 + fr, cin0 = wc * 32 + 4 * fq, pn = u.pn;
#pragma unroll
        for (int ai = 0; ai < 2; ++ai)
#pragma unroll
            for (int m = 0; m < 4; ++m) {
                const int r = row0 + ai * 128 + m * 16;
                const bool prm = r < MP; const int b = prm ? r / TP : 0; const int t = prm ? r - b * TP : 0; const int pidx = prm ? t : TP;
                if (pn < 8) {
                    const int h = pn & 3; const bool isk = pn >= 4;
                    float kdec = 1.f;
                    if (isk && prm) { const int e = t < 16 ? 15 - t : 127 - ((t - 16) & 127); kdec = __builtin_amdgcn_exp2f((float)e * __log2f(1.f - __builtin_amdgcn_exp2f(-(float)(5 + h)))); }
#pragma unroll
                    EPI_LOOP_COLS { const int d = bj * 128 + n * 16 + cin0; const f32x4 x = acc[ai][bj][m][n];
                        const f32x4 cs = *(const f32x4*)(rope + ((size_t)pidx * 128 + (d >> 1)) * 2);
                        f32x4 o; o[0] = x[0] * cs[0] - x[1] * cs[1]; o[1] = x[0] * cs[1] + x[1] * cs[0]; o[2] = x[2] * cs[2] - x[3] * cs[3]; o[3] = x[2] * cs[3] + x[3] * cs[2];
                        if (isk) o = o * 0.0625f;
                        u32x2 w; w.x = cvt_pk_bf16(o[0], o[1]); w.y = cvt_pk_bf16(o[2], o[3]);
                        *(u32x2*)((isk ? Kb : Qb) + (size_t)r * D + h * 256 + d) = w;
                        if (isk && prm) { bf16* kp = KTD + ((size_t)((b * 4 + h) * 256 + d)) * TP + t;
                            kp[0] = (bf16)f2bf(o[0] * kdec); kp[TP] = (bf16)f2bf(o[1] * kdec); kp[2 * TP] = (bf16)f2bf(o[2] * kdec); kp[3 * TP] = (bf16)f2bf(o[3] * kdec); } }
                } else if (pn < 16) {
                    const int h = (pn - 8) >> 1, e0 = ((pn - 8) & 1) * 256;
#pragma unroll
                    EPI_LOOP_COLS { const int e = e0 + bj * 128 + n * 16 + cin0; const f32x4 x = acc[ai][bj][m][n];
                        if (prm) { bf16* vp = VT + ((size_t)((b * 4 + h) * 512 + e)) * TP + t;
                            vp[0] = (bf16)f2bf(x[0]); vp[TP] = (bf16)f2bf(x[1]); vp[2 * TP] = (bf16)f2bf(x[2]); vp[3 * TP] = (bf16)f2bf(x[3]); }
                        else *(f32x4*)(VS + (size_t)(r - MP) * HV + h * 512 + e) = x; }
                } else {
                    const int c0 = (pn - 16) * 256;
#pragma unroll
                    EPI_LOOP_COLS { const int c = c0 + bj * 128 + n * 16 + cin0; const f32x4 x = acc[ai][bj][m][n]; f32x4 o;
#pragma unroll
                        for (int i = 0; i < 4; ++i) o[i] = x[i] / (1.f + __expf(-x[i]));
                        u32x2 w; w.x = cvt_pk_bf16(o[0], o[1]); w.y = cvt_pk_bf16(o[2], o[3]);
                        *(u32x2*)(SG + (size_t)r * HV + c) = w; }
                }
            }
    }
};

struct EpiRw1 {
    static constexpr bool PERM = false, AFTER_DRAIN = false;
    float* RKV; bf16* L1;
    __device__ __forceinline__ void operator()(const f32x4 (&acc)[2][2][4][2], const Unit& u, int wr, int wc, int fr, int fq) const {
#ifdef SKIP_EPIRW1
        return;
#endif

        const int pmr = u.pm % NMT, row0 = pmr * 256 + wr * 64 + fr, cin0 = wc * 32 + 4 * fq, pn = u.pn;
        if (pn < 12) {
            float* base = RKV + (size_t)(pn >> 2) * M * D + (pn & 3) * 256 + cin0;
#pragma unroll
            EPI_LOOP_ROWS { float* rp = base + (size_t)(row0 + ai * 128 + m * 16) * D;
#pragma unroll
                EPI_LOOP_COLS *(f32x4*)(rp + bj * 128 + n * 16) = acc[ai][bj][m][n]; }
        } else {
            const int j = pn - 12; bf16* base = L1 + (size_t)j * M * 256 + cin0;
#pragma unroll
            for (int ai = 0; ai < 2; ++ai)
#pragma unroll
                for (int m = 0; m < 4; ++m) { bf16* rp = base + (size_t)(row0 + ai * 128 + m * 16) * 256;
#pragma unroll
                    EPI_LOOP_COLS { const f32x4 x = acc[ai][bj][m][n]; f32x4 o;
#pragma unroll
                        for (int i = 0; i < 4; ++i) o[i] = j == 0 ? tanhf(x[i]) : (j == 1 ? x[i] : 1.f / (1.f + __expf(-x[i])));
                        u32x2 w; w.x = cvt_pk_bf16(o[0], o[1]); w.y = cvt_pk_bf16(o[2], o[3]);
                        *(u32x2*)(rp + bj * 128 + n * 16) = w; } }
        }
    }
};

struct EpiRw2 {
    static constexpr bool PERM = false, AFTER_DRAIN = false;
    float* DAG; const float *w0, *a0;
    __device__ __forceinline__ void operator()(const f32x4 (&acc)[2][2][4][2], const Unit& u, int wr, int wc, int fr, int fq) const {
#ifdef SKIP_EPIRW2
        return;
#endif
        const int pmr = u.pm % NMT, row0 = pmr * 256 + wr * 64 + fr, pn = u.pn, j = pn >> 2, col0 = (pn & 3) * 256 + wc * 32 + 4 * fq;
        float* base = DAG + (size_t)j * M * D + (size_t)row0 * D + col0;
        const float* bias = j == 0 ? w0 : a0;
#pragma unroll
        EPI_LOOP_COLS { const int cc = bj * 128 + n * 16;
            f32x4 bb = (f32x4){0.f, 0.f, 0.f, 0.f}; if (j < 2) bb = *(const f32x4*)(bias + col0 + cc);
#pragma unroll
            EPI_LOOP_ROWS { const f32x4 x = acc[ai][bj][m][n] + bb; f32x4 o;
                if (j == 0) {
#pragma unroll
                    for (int i = 0; i < 4; ++i) { const float z = -x[i]; const float sp = fmaxf(z, 0.f) + __logf(1.f + __expf(-fabsf(z))); o[i] = __expf(-__expf(-sp - 0.5f)); } }
                else if (j == 1) {
#pragma unroll
                    for (int i = 0; i < 4; ++i) o[i] = 1.f / (1.f + __expf(-x[i])); }
                else o = x;
                if (j == 2) { u32x2 wv; wv.x = cvt_pk_bf16(o[0], o[1]); wv.y = cvt_pk_bf16(o[2], o[3]); *(u32x2*)((bf16*)(DAG + (size_t)2 * M * D) + (size_t)(row0 + ai * 128 + m * 16) * D + col0 + cc) = wv; }
                else *(f32x4*)(base + (size_t)(ai * 128 + m * 16) * D + cc) = o; }
            asm volatile("" ::: "memory"); }
    }
};

struct EpiConvIn {
    static constexpr bool PERM = false, AFTER_DRAIN = false;
    bf16* BC; float* U;
    __device__ __forceinline__ void operator()(const f32x4 (&acc)[2][2][4][2], const Unit& u, int wr, int wc, int fr, int fq) const {
#ifdef SKIP_EPICONVIN
        return;
#endif

        const int row0 = u.pm * 256 + wr * 64 + fr, cin0 = wc * 32 + 4 * fq, pn = u.pn;
        if (pn < 4) {
#pragma unroll
            EPI_LOOP_ROWS { bf16* rp = BC + (size_t)(row0 + ai * 128 + m * 16) * D + pn * 256 + cin0;
#pragma unroll
                EPI_LOOP_COLS { const f32x4 x = acc[ai][bj][m][n]; u32x2 w; w.x = cvt_pk_bf16(x[0], x[1]); w.y = cvt_pk_bf16(x[2], x[3]); *(u32x2*)(rp + bj * 128 + n * 16) = w; } }
        } else {
#pragma unroll
            EPI_LOOP_ROWS { float* rp = U + (size_t)(row0 + ai * 128 + m * 16) * D + (pn - 4) * 128 + cin0;
#pragma unroll
                for (int n = 0; n < 2; ++n) *(f32x4*)(rp + n * 16) = acc[ai][0][m][n] * acc[ai][1][m][n]; }
        }
    }
};

__device__ __forceinline__ void tr_item(const float* W, int K, int N, bf16* WT, int ldk, int drow0, int k0, int n0, LAS bf16* scr, int lane) {
    f32x4 v[16];
    const int nl = (lane & 15) * 4, kq = lane >> 4, n = n0 + nl;
#pragma unroll
    for (int i = 0; i < 16; ++i) { const int k = k0 + 4 * i + kq; v[i] = (k < K && n < N) ? *(const f32x4*)(W + (size_t)k * N + n) : (f32x4){0.f, 0.f, 0.f, 0.f}; }
#pragma unroll
    for (int i = 0; i < 16; ++i) { const int kl = 4 * i + kq;
#pragma unroll
        for (int j = 0; j < 4; ++j) scr[(nl + j) * 72 + kl] = (bf16)f2bf(v[i][j]); }
    LDS_WAIT(); asm volatile("" ::: "memory");
    const int c = lane & 7;
#pragma unroll
    for (int q = 0; q < 8; ++q) { const int nr = q * 8 + (lane >> 3);
        const u32x4 o = *(const LAS u32x4*)(scr + nr * 72 + 8 * c);
        *(u32x4*)(WT + (size_t)(drow0 + nr) * ldk + k0 + 8 * c) = o; }
    LDS_WAIT(); asm volatile("" ::: "memory");
}
__device__ __forceinline__ int cin_row(int n0) { if (n0 < 1024) return n0; if (n0 < 2048) { const int j = n0 - 1024; return 1024 + (j >> 7) * 256 + (j & 127); } const int j = n0 - 2048; return 1024 + (j >> 7) * 256 + 128 + (j & 127); }

__device__ __forceinline__ void rms_row(const float* xrow, const float* gain, int lane, f32x4 (&v)[4]) {
    const f32x4* xr = (const f32x4*)xrow + lane; const f32x4* gr = (const f32x4*)gain + lane; float s = 0.f;
#pragma unroll
    for (int j = 0; j < 4; ++j) { v[j] = xr[64 * j]; s += (v[j].x * v[j].x + v[j].y * v[j].y) + (v[j].z * v[j].z + v[j].w * v[j].w); }
    const float rstd = 1.0f / sqrtf(wave_sum(s) * (1.f / D) + EPS);
#pragma unroll
    for (int j = 0; j < 4; ++j) v[j] = v[j] * rstd * gr[64 * j];
}
__device__ __forceinline__ void rms_row2(const float* x0, const float* x1, const float* gain, int lane, f32x4 (&v0)[4], f32x4 (&v1)[4]) {
    const f32x4* p0 = (const f32x4*)x0 + lane; const f32x4* p1 = (const f32x4*)x1 + lane; const f32x4* gr = (const f32x4*)gain + lane; float s0 = 0.f, s1 = 0.f;
#pragma unroll
    for (int j = 0; j < 4; ++j) { v0[j] = p0[64 * j]; v1[j] = p1[64 * j]; }
#pragma unroll
    for (int j = 0; j < 4; ++j) { s0 += (v0[j].x * v0[j].x + v0[j].y * v0[j].y) + (v0[j].z * v0[j].z + v0[j].w * v0[j].w); s1 += (v1[j].x * v1[j].x + v1[j].y * v1[j].y) + (v1[j].z * v1[j].z + v1[j].w * v1[j].w); }
#pragma unroll
    for (int o = 1; o < 64; o <<= 1) { s0 += __shfl_xor(s0, o); s1 += __shfl_xor(s1, o); }
    const float r0 = 1.0f / sqrtf(s0 * (1.f / D) + EPS), r1 = 1.0f / sqrtf(s1 * (1.f / D) + EPS);
#pragma unroll
    for (int j = 0; j < 4; ++j) { const f32x4 g = gr[64 * j]; v0[j] = v0[j] * r0 * g; v1[j] = v1[j] * r1 * g; }
}
__device__ __forceinline__ void store_row_bf16(bf16* orow, int lane, const f32x4 (&v)[4]) {
    u32x2* o8 = (u32x2*)orow + lane;
#pragma unroll
    for (int j = 0; j < 4; ++j) { u32x2 w; w.x = pk2(v[j].x, v[j].y); w.y = pk2(v[j].z, v[j].w); o8[64 * j] = w; }
}

#define XB_TMO      128
#define XB_XCNT(j)  (256  + 64 * (j))
#define XB_XSUB(j)  (1280 + 64 * (j))
#define XB_XGEN(j)  (2304 + 64 * (j))
#define XB_TOP      3328
#define XB_TOPGEN   3392
#define XCD_BAR_WORDS 3456
#define XB_SPIN_CAP (1u << 18)

__device__ __forceinline__ unsigned xb_ld(unsigned* p)              { return __hip_atomic_load(p, __ATOMIC_RELAXED, __HIP_MEMORY_SCOPE_AGENT); }
__device__ __forceinline__ unsigned xb_add(unsigned* p, unsigned v) { return __hip_atomic_fetch_add(p, v, __ATOMIC_RELAXED, __HIP_MEMORY_SCOPE_AGENT); }
__device__ __forceinline__ unsigned xb_xcc_id() { return (unsigned)__builtin_amdgcn_s_getreg((3 << 11) | 20) & 0xFu; }
#define XB_SPIN(cond, bar) do { unsigned _sp = 0; while (cond) { __builtin_amdgcn_s_sleep(1); \
    if ((++_sp & 255u) == 0u) { if (xb_ld(&(bar)[XB_TMO])) break; if (_sp > XB_SPIN_CAP) { atomicAdd(&(bar)[XB_TMO], 1u); break; } } } } while (0)

struct XcdBarrier {
    unsigned* bar; unsigned x;
    volatile LAS unsigned* st;
};

__device__ __forceinline__ XcdBarrier xcd_barrier_post(unsigned* bar, volatile LAS unsigned* st) {
    XcdBarrier b; b.bar = bar; b.x = xb_xcc_id(); b.st = st;
    if (threadIdx.x == 0) (void)xb_add(&bar[XB_XCNT(b.x)], 1u);
    return b;
}
__device__ __forceinline__ void xcd_barrier_complete(unsigned* bar, unsigned x, unsigned& nloc, unsigned& nx) {
    const unsigned G = gridDim.x * gridDim.y * gridDim.z;
    unsigned sum, cnt, mine, sp = 0u;
    for (;;) {
        sum = 0u; cnt = 0u; mine = 0u;
#pragma unroll
        for (unsigned j = 0; j < 16; ++j) { const unsigned c = xb_ld(&bar[XB_XCNT(j)]); sum += c; cnt += (c > 0u) ? 1u : 0u; mine = (j == x) ? c : mine; }
        if (sum == G) break;
        __builtin_amdgcn_s_sleep(1);
        if ((++sp & 255u) == 0u) { if (xb_ld(&bar[XB_TMO])) break; if (sp > XB_SPIN_CAP) { atomicAdd(&bar[XB_TMO], 1u); break; } }
    }
    nloc = mine > 0u ? mine : 1u; nx = cnt > 0u ? cnt : 1u;
}

__device__ __forceinline__ void xcd_barrier(const XcdBarrier& b) {
    asm volatile("s_waitcnt vmcnt(0)" ::: "memory");
    __syncthreads();
    if (threadIdx.x == 0) {
        unsigned* bar = b.bar;
        __builtin_amdgcn_s_waitcnt(0);
        unsigned nloc = b.st[0], nx = b.st[1];
        if (nloc == 0u) { xcd_barrier_complete(bar, b.x, nloc, nx); b.st[0] = nloc; b.st[1] = nx; }
        const unsigned old = xb_add(&bar[XB_XSUB(b.x)], 1u);
        const unsigned gen = old / nloc;
        if (old + 1u == (gen + 1u) * nloc) {
            __builtin_amdgcn_fence(__ATOMIC_RELEASE, "agent");
            asm volatile("s_waitcnt vmcnt(0)" ::: "memory");
            const unsigned og = xb_add(&bar[XB_TOP], 1u);
            const unsigned tg = og / nx;
            if (og + 1u == (tg + 1u) * nx) xb_add(&bar[XB_TOPGEN], 1u);
            else XB_SPIN(xb_ld(&bar[XB_TOPGEN]) == tg, bar);
            __builtin_amdgcn_fence(__ATOMIC_ACQUIRE, "agent");
            xb_add(&bar[XB_XGEN(b.x)], 1u);
            asm volatile("s_waitcnt vmcnt(0)" ::: "memory");
        } else {
            XB_SPIN(xb_ld(&bar[XB_XGEN(b.x)]) == gen, bar);
            __builtin_amdgcn_fence(__ATOMIC_ACQUIRE, "agent");
            asm volatile("s_waitcnt vmcnt(0)" ::: "memory");
        }
    }
    __syncthreads();
}

struct KArgs { const float* in[34]; float* out; unsigned char* ws; int ph_lo, ph_hi, coop, pad; int rep[8]; };

__global__ void __launch_bounds__(512, 2) fwd_kernel(KArgs a) {
    extern __shared__ __attribute__((aligned(16))) unsigned char lds_raw[];
    LAS unsigned char* lds = (LAS unsigned char*)lds_raw;
    cg::grid_group grid = cg::this_grid();
    const int tid0 = threadIdx.x, wave = __builtin_amdgcn_readfirstlane(tid0 >> 6);
    const int G = gridDim.x, bid = blockIdx.x, gw = bid * 8 + wave, NGW = G * 8;
    unsigned char* ws = a.ws; float* out = a.out;
    float* H = (float*)(ws + WS_H); bf16* XN = (bf16*)(ws + WS_XN);
    const float* rope = (const float*)(ws + WS_ROPE);
    const int lo = a.ph_lo, hi = a.ph_hi; const bool coop = a.coop != 0;
    volatile LAS unsigned* MISC = (volatile LAS unsigned*)(lds + LDS_MISC);
    if (tid0 == 0) { MISC[0] = 0u; MISC[1] = 0u; }
    __syncthreads();
    XcdBarrier xbar = xcd_barrier_post((unsigned*)(ws + WS_BAR), MISC);
    int pc = 0;
#define PH_BEGIN(cat) if (pc >= lo && pc < hi) { for (int rep_ = 0; rep_ < a.rep[cat]; ++rep_) { int tid = tid0; asm volatile("" : "+v"(tid)); const int lane = tid & 63; (void)lane;
#define PH_END   __syncthreads(); } if (coop && pc + 1 < hi) { if (a.coop == 2) grid.sync();     \
        xcd_barrier(xbar); if (a.rep[5] > 1) xcd_barrier(xbar); } } ++pc;

    PH_BEGIN(0)
    {
        LAS bf16* scr = (LAS bf16*)(lds + wave * 9216);
        for (int it = gw; ; it += NGW) {
            int r = it; bool did = false; const float* jW = nullptr; bf16* jWT = nullptr; int jK = 0, jN = 0, jld = 0, jrow = 0, jk0 = 0, jn0 = 0;
#define TRJOB(Wp, K_, N_, KP_, NP_, WTp, LDK_, ROWEXPR) if (!did) { const int nnb = (NP_) / 64, cnt = ((KP_) / 64) * nnb; \
                if (r < cnt) { const int kb = r / nnb, nb = r - kb * nnb, n0 = nb * 64; jW = (Wp); jK = (K_); jN = (N_); jWT = (WTp); jld = (LDK_); jrow = (ROWEXPR) + n0; jk0 = kb * 64; jn0 = n0; did = true; } else r -= cnt; }
            TRJOB(a.in[11], D, NRI, D, NRI, (bf16*)(ws + WS_RI0), D, 0)
            TRJOB(a.in[11] + (size_t)D * NRI, D, NRI, D, NRI, (bf16*)(ws + WS_RI1), D, 0)
            TRJOB(a.in[12], HV, D, HV, D, (bf16*)(ws + WS_RO0), HV, 0)
            TRJOB(a.in[12] + (size_t)HV * D, HV, D, HV, D, (bf16*)(ws + WS_RO1), HV, 0)
            TRJOB(a.in[14], D, D, D, D, (bf16*)(ws + WS_RW1), D, 0)
            TRJOB(a.in[14] + (size_t)D * D, D, D, D, D, (bf16*)(ws + WS_RW1), D, 1024)
            TRJOB(a.in[14] + (size_t)2 * D * D, D, D, D, D, (bf16*)(ws + WS_RW1), D, 2048)
            TRJOB(a.in[16], D, 64, D, 256, (bf16*)(ws + WS_RW1), D, 3072)
            TRJOB(a.in[19], D, 64, D, 256, (bf16*)(ws + WS_RW1), D, 3328)
            TRJOB(a.in[21], D, 160, D, 256, (bf16*)(ws + WS_RW1), D, 3584)
            TRJOB(a.in[17], 64, D, 256, D, (bf16*)(ws + WS_RW2), 256, 0)
            TRJOB(a.in[20], 64, D, 256, D, (bf16*)(ws + WS_RW2), 256, 1024)
            TRJOB(a.in[22], 160, D, 256, D, (bf16*)(ws + WS_RW2), 256, 2048)
            TRJOB(a.in[28], D, D, D, D, (bf16*)(ws + WS_RWO), D, 0)
            TRJOB(a.in[29], D, 3072, D, 3072, (bf16*)(ws + WS_CIN), D, cin_row(n0) - n0)
            TRJOB(a.in[31], D, D, D, D, (bf16*)(ws + WS_COUT), D, 0)
#pragma unroll 1
            for (int l = 0; l < 4; ++l) {
                TRJOB(a.in[32] + (size_t)l * D * FF, D, FF, D, FF, (bf16*)(ws + WS_M1 + (size_t)l * al((size_t)FF * D * 2)), D, 0)
                TRJOB(a.in[33] + (size_t)l * D * FF, FF, D, FF, D, (bf16*)(ws + WS_M2 + (size_t)l * al((size_t)FF * D * 2)), FF, 0)
            }
#undef TRJOB
            if (!did) break;
            tr_item(jW, jK, jN, jWT, jld, jrow, jk0, jn0, scr, lane);
        }
        for (int e = bid * 512 + tid; e < 2065 * 128; e += G * 512) {
            const int p = e >> 7, i = e & 127;
            const float x = (float)i / 127.0f;
            const float inv = 1.0f / (float)exp((double)x * 9.210340371976184);
            const float ang = (float)(p == TP ? 16384 : p) * inv;
            double rev = (double)ang * 0.15915494309189535; rev -= rint(rev);
            const float fr = (float)rev;
            ((f32x2*)(ws + WS_ROPE))[e] = (f32x2){__builtin_amdgcn_cosf(fr), __builtin_amdgcn_sinf(fr)};
        }
        for (int m = gw; m < M; m += NGW) {
            const float* src;
            if (m < MP) { const int b = m / TP, t = m - b * TP; src = t < 16 ? a.in[7] + (size_t)t * D : a.in[0] + ((size_t)b * 2048 + (t - 16)) * D; }
            else src = a.in[1] + (size_t)(m - MP) * D;
            const f32x4* xr = (const f32x4*)src + lane; f32x4* hr = (f32x4*)(H + (size_t)m * D) + lane;
#pragma unroll
            for (int j = 0; j < 4; ++j) hr[64 * j] = xr[64 * j];
            f32x4 v[4]; rms_row(src, a.in[8], lane, v); store_row_bf16(XN + (size_t)m * D, lane, v);
        }
    }
    PH_END

#pragma unroll 1
    for (int layer = 0; layer < 4; ++layer) {
        const int kind = layer % 3;
        const bf16* outA; const bf16* outB; int outK;
        if (kind == 0) {
            const int jr = layer / 3;
            bf16 *Qb = (bf16*)(ws + RB_Q), *Kb = (bf16*)(ws + RB_K), *KTD = (bf16*)(ws + RB_KTD), *VT = (bf16*)(ws + RB_VT), *SG = (bf16*)(ws + RB_SG), *OB = (bf16*)(ws + RB_OB), *Y = (bf16*)(ws + RB_Y);
            float* VS = (float*)(ws + RB_VS);
            outA = Y; outB = (const bf16*)(ws + (jr ? WS_RO1 : WS_RO0)); outK = HV;
            PH_BEGIN(4)
            {
                pg8::Gemm g{XN, (const bf16*)(ws + (jr ? WS_RI1 : WS_RI0)), M, NRI, D}; pg8::StaticOrder S; S.init(M, NRI, G, bid);
                EpiRetIn E{Qb, Kb, KTD, VT, SG, VS, rope};
                pg8::gemm_phase<EpiRetIn, pg8::StaticOrder, true, true>(lds, g, S, E);
            }
            PH_END
            PH_BEGIN(1)
            {
                const float* S0in = a.in[jr ? 6 : 2];
                float* Sp_out = out + (jr ? O_R3P : O_R0P); float* Ss_out = out + (jr ? O_R3S : O_R0S);
                const int l32 = lane & 31, hi = lane >> 5, w = wave;
                LAS bf16* P = (LAS bf16*)lds;
                LAS bf16* ST = (LAS bf16*)(lds + 34816);
                for (int item = bid; item < 256; item += G) {
                    const int b = item >> 5, h = (item >> 3) & 3, es = item & 7;
                    const float lg2 = __log2f(1.f - __builtin_amdgcn_exp2f(-(float)(5 + h)));
                    const unsigned char* qbytes = (const unsigned char*)(Qb + (size_t)(b * TP) * D + h * 256);
                    const unsigned char* kbytes = (const unsigned char*)(Kb + (size_t)(b * TP) * D + h * 256);
                    const bf16* ktd = KTD + (size_t)((b * 4 + h) * 256) * TP;
                    const bf16* vt = VT + (size_t)((b * 4 + h) * 512 + es * 64) * TP;
                    LAS unsigned char* QH = lds;
                    LAS unsigned char* KH = lds + 34816;
                    LAS unsigned char* STb = lds + 69632;
                    LAS unsigned char* VTs = lds + 103424;
                    f32x16 S2[2];
#pragma unroll
                    for (int i = 0; i < 16; ++i) { S2[0][i] = 0.f; S2[1][i] = 0.f; }
                    for (int i = tid; i < 33792 / 16; i += 512) *(LAS u32x4*)(STb + i * 16) = (u32x4){0u, 0u, 0u, 0u};
                    const u32x4 z4 = {0u, 0u, 0u, 0u};
                    u32x4 rq[4], rk[4], rv[2];
#define RET_T0(cc) ((cc) == 0 ? 0 : 16 + 128 * ((cc) - 1))
#define RET_L(cc)  ((cc) == 0 ? 16 : 128)
#define LOADQK(cc, dh) do { const int t0c_ = RET_T0(cc), Lc_ = RET_L(cc); _Pragma("unroll") for (int i_ = 0; i_ < 4; ++i_) { const int id_ = tidc + 512 * i_, row_ = id_ >> 4, c16_ = id_ & 15; const bool ok_ = row_ < Lc_; \
        const size_t off_ = (size_t)(t0c_ + (ok_ ? row_ : 0)) * 2048 + (dh) * 256 + c16_ * 16; rq[i_] = *(const u32x4*)(qbytes + off_); rk[i_] = *(const u32x4*)(kbytes + off_); if (!ok_) { rq[i_] = z4; rk[i_] = z4; } } } while (0)
#define STOREQK() do { _Pragma("unroll") for (int i_ = 0; i_ < 4; ++i_) { const int id_ = tidc + 512 * i_, row_ = id_ >> 4, c16_ = id_ & 15; *(LAS u32x4*)(QH + row_ * 272 + c16_ * 16) = rq[i_]; *(LAS u32x4*)(KH + row_ * 272 + c16_ * 16) = rk[i_]; } } while (0)
#define LOADV(cc) do { const int t0c_ = RET_T0(cc), Lc_ = RET_L(cc); _Pragma("unroll") for (int i_ = 0; i_ < 2; ++i_) { const int id_ = tidc + 512 * i_, row_ = id_ >> 4, c16_ = id_ & 15; const bool ok_ = c16_ * 8 < Lc_; \
        rv[i_] = *(const u32x4*)(vt + (size_t)row_ * TP + t0c_ + (ok_ ? c16_ * 8 : 0)); if (!ok_) rv[i_] = z4; } } while (0)
#define STOREV() do { _Pragma("unroll") for (int i_ = 0; i_ < 2; ++i_) { const int id_ = tidc + 512 * i_, row_ = id_ >> 4, c16_ = id_ & 15; *(LAS u32x4*)(VTs + row_ * 272 + c16_ * 16) = rv[i_]; } } while (0)
                    { const int tidc = tid; LOADQK(0, 0); LOADV(0); }
                    const int lt = w >> 1, ei = w & 1;
                    __syncthreads();
#pragma unroll 1
                    for (int c = 0; c < 17; ++c) {
                        const int t0 = RET_T0(c), L = RET_L(c);
                        int tl_ = tid; asm volatile("" : "+v"(tl_));
                        const int tidc = tl_, l32 = tidc & 31, hi = (tidc >> 5) & 1, lrow = 32 * lt + l32, erow = 32 * ei + l32;
                        const bool act = 32 * lt < L;
                        f32x16 accP[2], aX;
#pragma unroll
                        for (int i = 0; i < 16; ++i) { accP[0][i] = 0.f; accP[1][i] = 0.f; aX[i] = 0.f; }
#pragma unroll
                        for (int dh = 0; dh < 2; ++dh) {
                            STOREQK(); if (dh == 0) STOREV();
                            if (dh == 0) LOADQK(c, 1); else if (c < 16) { LOADQK(c + 1, 0); LOADV(c + 1); }
                            __syncthreads();
                            if (act) {
                                const LAS unsigned char* qrow = QH + lrow * 272 + 16 * hi;
#pragma unroll
                                for (int j = 0; j < 2; ++j) { const int mt = 2 * (w & 1) + j;
                                    if (mt <= lt && 32 * mt < L) { const LAS unsigned char* krow = KH + (32 * mt + l32) * 272 + 16 * hi;
#pragma unroll 4
                                        for (int s = 0; s < 8; ++s) { const bf16x8 kf = *(const LAS bf16x8*)(krow + 32 * s), qf = *(const LAS bf16x8*)(qrow + 32 * s); accP[j] = MFMA32(kf, qf, accP[j]); } } }
                                const LAS unsigned char* srow = STb + erow * 528 + 256 * dh + 16 * hi;
#pragma unroll 4
                                for (int s = 0; s < 8; ++s) { const bf16x8 sf = *(const LAS bf16x8*)(srow + 32 * s), qf = *(const LAS bf16x8*)(qrow + 32 * s); aX = MFMA32(sf, qf, aX); }
                            }
                            __syncthreads();
                        }
                        bf16x8 kc[8];
                        { const bf16* kp = ktd + (size_t)(32 * w + l32) * TP + t0 + 8 * hi; const int nkc = L >> 4;
#pragma unroll
                          for (int s = 0; s < 8; ++s) kc[s] = *(const bf16x8*)(kp + (s < nkc ? 16 * s : 0)); }
                        if (act) {
#pragma unroll
                            for (int j = 0; j < 2; ++j) { const int mt = 2 * (w & 1) + j;
                                if (mt <= lt && 32 * mt < L) {
#pragma unroll
                                    for (int gq = 0; gq < 4; ++gq) { float o[4];
#pragma unroll
                                        for (int i = 0; i < 4; ++i) { const int mm = 32 * mt + 8 * gq + 4 * hi + i; const int df = lrow - mm;
                                            o[i] = df >= 0 ? accP[j][gq * 4 + i] * __builtin_amdgcn_exp2f((float)df * lg2) : 0.f; }
                                        u32x2 wv; wv.x = cvt_pk_bf16(o[0], o[1]); wv.y = cvt_pk_bf16(o[2], o[3]);
                                        *(LAS u32x2*)(KH + lrow * 272 + (32 * mt + 8 * gq + 4 * hi) * 2) = wv; } } }
                        }
                        __syncthreads();
                        if (act) {
                            f32x16 aI;
#pragma unroll
                            for (int i = 0; i < 16; ++i) aI[i] = 0.f;
                            const int nk = (32 * (lt + 1) < L ? 32 * (lt + 1) : L) >> 4;
#pragma unroll 2
                            for (int s = 0; s < nk; ++s) { const bf16x8 fa = *(const LAS bf16x8*)(VTs + erow * 272 + (16 * s + 8 * hi) * 2), fb = *(const LAS bf16x8*)(KH + lrow * 272 + (16 * s + 8 * hi) * 2); aI = MFMA32(fa, fb, aI); }
                            const float qd = __builtin_amdgcn_exp2f((float)(lrow + 1) * lg2);
                            if (lrow < L) {
                                bf16* op = OB + (size_t)(b * TP + t0 + lrow) * HV + h * 512 + es * 64 + 32 * ei + 4 * hi;
#pragma unroll
                                for (int gq = 0; gq < 4; ++gq) {
                                    u32x2 wv; wv.x = cvt_pk_bf16(aI[gq * 4 + 0] + qd * aX[gq * 4 + 0], aI[gq * 4 + 1] + qd * aX[gq * 4 + 1]);
                                    wv.y = cvt_pk_bf16(aI[gq * 4 + 2] + qd * aX[gq * 4 + 2], aI[gq * 4 + 3] + qd * aX[gq * 4 + 3]);
                                    *(u32x2*)(op + 8 * gq) = wv; }
                            }
                        }
                        {
                            const float gl = __builtin_amdgcn_exp2f((float)L * lg2);
                            S2[0] = S2[0] * gl; S2[1] = S2[1] * gl;
                            const int nkc = L >> 4;
#pragma unroll
                            for (int s = 0; s < 8; ++s) if (s < nkc) {
                                const bf16x8 fb0 = *(const LAS bf16x8*)(VTs + l32 * 272 + (16 * s + 8 * hi) * 2), fb1 = *(const LAS bf16x8*)(VTs + (32 + l32) * 272 + (16 * s + 8 * hi) * 2);
                                S2[0] = MFMA32(kc[s], fb0, S2[0]); S2[1] = MFMA32(kc[s], fb1, S2[1]); }
                        }
                        __syncthreads();
                        if (c < 16) {
#pragma unroll
                            for (int e2 = 0; e2 < 2; ++e2)
#pragma unroll
                                for (int gq = 0; gq < 4; ++gq) {
                                    u32x2 wv; wv.x = cvt_pk_bf16(S2[e2][gq * 4 + 0], S2[e2][gq * 4 + 1]); wv.y = cvt_pk_bf16(S2[e2][gq * 4 + 2], S2[e2][gq * 4 + 3]);
                                    *(LAS u32x2*)(STb + (32 * e2 + l32) * 528 + (32 * w + 8 * gq + 4 * hi) * 2) = wv; }
                        }
                    }
#undef LOADQK
#undef STOREQK
#undef LOADV
#undef STOREV
                    {
                        float* sp = Sp_out + (size_t)((b * 4 + h) * 256) * 512 + es * 64 + l32;
#pragma unroll
                        for (int e2 = 0; e2 < 2; ++e2)
#pragma unroll
                            for (int r = 0; r < 16; ++r) sp[(size_t)(32 * w + crow(r, hi)) * 512 + 32 * e2] = S2[e2][r];
                    }
                    __syncthreads();
                }
                {
                    LAS float* qk = (LAS float*)(lds + 69632);
                    LAS float* ored = (LAS float*)(lds + 69632 + 2048);
                    for (int item = bid; item < NS * 4; item += G) {
                        const int s = item >> 2, h = item & 3;
                        const float gamma = 1.f - __builtin_amdgcn_exp2f(-(float)(5 + h));
                        __syncthreads();
                        { const int which = tid >> 8, dd = tid & 255; qk[tid] = bf2f((which ? Kb : Qb)[(size_t)(MP + s) * D + h * 256 + dd]); }
                        __syncthreads();
                        const int e4 = (tid & 127) * 4, dg = tid >> 7;
                        const f32x4 v4 = *(const f32x4*)(VS + (size_t)s * HV + h * 512 + e4);
                        const float* sin_ = S0in + (size_t)(s * 4 + h) * 256 * 512 + e4; float* sout = Ss_out + (size_t)(s * 4 + h) * 256 * 512 + e4;
                        f32x4 o4 = {0.f, 0.f, 0.f, 0.f};
#pragma unroll 16
                        for (int i = 0; i < 64; ++i) { const int d = dg * 64 + i;
                            const f32x4 sv = __builtin_nontemporal_load((const f32x4*)(sin_ + (size_t)d * 512));
                            const f32x4 sn = sv * gamma + v4 * qk[256 + d];
                            __builtin_nontemporal_store(sn, (f32x4*)(sout + (size_t)d * 512));
                            o4 = o4 + sn * qk[d]; }
                        *(LAS f32x4*)(ored + dg * 512 + e4) = o4;
                        __syncthreads();
                        if (tid < 128) { const f32x4 r = *(LAS f32x4*)(ored + e4) + *(LAS f32x4*)(ored + 512 + e4) + *(LAS f32x4*)(ored + 1024 + e4) + *(LAS f32x4*)(ored + 1536 + e4);
                            u32x2 wv; wv.x = cvt_pk_bf16(r[0], r[1]); wv.y = cvt_pk_bf16(r[2], r[3]);
                            *(u32x2*)(OB + (size_t)(MP + s) * HV + h * 512 + e4) = wv; }
                    }
                }
            }
            PH_END
            PH_BEGIN(3)
            {
                for (int m = gw; m < M; m += 2 * NGW) {
                    const int m1 = (m + NGW < M) ? m + NGW : m;
                    u32x4 ov[2][4]; float ss[2] = {0.f, 0.f};
#pragma unroll
                    for (int q = 0; q < 2; ++q) { const u32x4* op = (const u32x4*)(OB + (size_t)(q ? m1 : m) * HV) + lane * 4;
#pragma unroll
                        for (int j = 0; j < 4; ++j) ov[q][j] = op[j]; }
#pragma unroll
                    for (int q = 0; q < 2; ++q) {
#pragma unroll
                        for (int j = 0; j < 4; ++j)
#pragma unroll
                            for (int i = 0; i < 4; ++i) { const float x0 = __uint_as_float(ov[q][j][i] << 16), x1 = __uint_as_float(ov[q][j][i] & 0xffff0000u); ss[q] += x0 * x0 + x1 * x1; }
                        ss[q] = sum16(ss[q]); }
#pragma unroll
                    for (int q = 0; q < 2; ++q) { if (q == 1 && m1 == m) break;
                        const int mr = q ? m1 : m; const float rs = 1.0f / sqrtf(ss[q] * (1.f / 512.f) + EPS);
                        const u32x4* gp = (const u32x4*)(SG + (size_t)mr * HV) + lane * 4; u32x4* yp = (u32x4*)(Y + (size_t)mr * HV) + lane * 4;
#pragma unroll
                        for (int j = 0; j < 4; ++j) { const u32x4 gv = gp[j]; u32x4 wv;
#pragma unroll
                            for (int i = 0; i < 4; ++i) { const float x0 = __uint_as_float(ov[q][j][i] << 16), x1 = __uint_as_float(ov[q][j][i] & 0xffff0000u);
                                const float g0 = __uint_as_float(gv[i] << 16), g1 = __uint_as_float(gv[i] & 0xffff0000u);
                                wv[i] = cvt_pk_bf16(x0 * rs * g0, x1 * rs * g1); }
                            yp[j] = wv; } }
                }
            }
            PH_END
        } else if (kind == 1) {
            bf16* XM = (bf16*)(ws + WB_XM); float* RKV = (float*)(ws + WB_RKV); bf16* L1 = (bf16*)(ws + WB_L1); float* DAG = (float*)(ws + WB_DAG);
            float* YR = (float*)(ws + WB_YR); bf16* Y = (bf16*)(ws + WB_Y);
            outA = Y; outB = (const bf16*)(ws + WS_RWO); outK = D;
            PH_BEGIN(4)
            {
                pg8::Gemm g{XM, (const bf16*)(ws + WS_RW1), 6 * M, 3840, D}; StackOrder S; S.base.init(M, 3840, G, bid); S.mode = 1;
                EpiRw1 E{RKV, L1};
                pg8::gemm_phase<EpiRw1, StackOrder, true, true>(lds, g, S, E);
            }
            PH_END
            PH_BEGIN(4)
            {
                int K2 = 256; asm volatile("" : "+s"(K2));
                pg8::Gemm g{L1, (const bf16*)(ws + WS_RW2), 3 * M, 3072, K2}; StackOrder S; S.base.init(M, 3072, G, bid); S.mode = 2;
                EpiRw2 E{DAG, a.in[15], a.in[18]};
                pg8::gemm_phase<EpiRw2, StackOrder, true, true>(lds, g, S, E);
            }
            PH_END
            PH_BEGIN(2)
            {
                const float *Rr = RKV, *Kr = RKV + (size_t)M * D, *Vr = RKV + (size_t)2 * M * D, *DEC = DAG, *AAp = DAG + (size_t)M * D;
                const float *k_k = a.in[23], *k_a = a.in[24]; float* RKb = (float*)(ws + WB_L1);
                LAS float* ob = (LAS float*)lds;
                const int pair = (tid >> 4) & 15, p = tid & 15; const bool cw = tid < 256;
                const int st_ld = tid >> 5, kq = tid & 31;
                for (int item = bid; item < 2 * NB * 32; item += G) {
                    const int seq = item >> 5, h = (item >> 1) & 15, half = item & 1;
                    const bool indep = seq >= NB; const int s0 = (seq - NB) * 16;
                    const int T = indep ? 16 : TP; const int rowbase = indep ? MP + s0 : seq * TP;
                    const int vrow = half * 32 + 2 * pair, ch = h * 64;
                    f32x4 Sa = (f32x4){0.f, 0.f, 0.f, 0.f}, Sb = Sa;
                    const float* sin_ = a.in[4] + (size_t)(s0 * 16 + h) * 4096 + vrow * 64 + 4 * p; float* sout_ = out + O_WKS + (size_t)(s0 * 16 + h) * 4096 + vrow * 64 + 4 * p;
                    const f32x2 rk2 = *(const f32x2*)(a.in[25] + ch + 2 * kq);
                    const f32x2 kk2 = *(const f32x2*)(k_k + ch + 2 * kq), ka2 = *(const f32x2*)(k_a + ch + 2 * kq);
                    f32x2 lr, lk, lv, ld, la;
                    { const int t = st_ld; const bool ok = t < T; const size_t off = (size_t)(rowbase + (ok ? t : 0)) * D + ch + 2 * kq;
                      lr = *(const f32x2*)(Rr + off); lk = *(const f32x2*)(Kr + off); lv = *(const f32x2*)(Vr + off); ld = *(const f32x2*)(DEC + off); la = *(const f32x2*)(AAp + off); }
                    const int nch = (T + 15) >> 4;
                    __syncthreads();
#pragma unroll 1
                    for (int cidx = 0; cidx < nch; ++cidx) {
                        LAS float* B = ob + (cidx & 1) * 6144;
                        {
                            f32x2 kkv = lk * kk2; float ssq = kkv.x * kkv.x + kkv.y * kkv.y;
                            ssq = sum16(ssq); { const int si = __builtin_bit_cast(int, ssq); ssq += __builtin_bit_cast(float, __builtin_amdgcn_ds_swizzle(si, 0x401F)); }
                            const float nrm = fmaxf(sqrtf(ssq), 1e-12f); kkv = kkv * (1.f / nrm);
                            const f32x2 km = lk * (1.f + (la - 1.f) * ka2), kav = kkv * la;
                            { float rkp = lr.x * km.x * rk2.x + lr.y * km.y * rk2.y; rkp = sum16(rkp); { const int si = __builtin_bit_cast(int, rkp); rkp += __builtin_bit_cast(float, __builtin_amdgcn_ds_swizzle(si, 0x401F)); }
                              const int tt = cidx * 16 + st_ld; if (kq == 0 && half == 0 && tt < T) RKb[(size_t)(rowbase + tt) * 16 + h] = rkp; }
                            const int o = st_ld * 64 + 2 * kq;
                            *(LAS f32x2*)(B + o) = ld; *(LAS f32x2*)(B + 1024 + o) = kkv; *(LAS f32x2*)(B + 2048 + o) = kav; *(LAS f32x2*)(B + 3072 + o) = km; *(LAS f32x2*)(B + 4096 + o) = lr; *(LAS f32x2*)(B + 5120 + o) = lv;
                        }
                        if (cidx + 1 < nch) { const int t = (cidx + 1) * 16 + st_ld; const bool ok = t < T; const size_t off = (size_t)(rowbase + (ok ? t : 0)) * D + ch + 2 * kq;
                            lr = *(const f32x2*)(Rr + off); lk = *(const f32x2*)(Kr + off); lv = *(const f32x2*)(Vr + off); ld = *(const f32x2*)(DEC + off); la = *(const f32x2*)(AAp + off); }
                        __syncthreads();
                        const int t0 = cidx * 16;
                        f32x2 ykeep = {0.f, 0.f}; f32x4 nSa = Sa, nSb = Sb;
#define SCAN_STEP(st, IND) { if (IND) { Sa = nSa; Sb = nSb; const int sn_ = (st) < 15 ? (st) + 1 : 15; nSa = *(const f32x4*)(sin_ + (size_t)sn_ * 65536); nSb = *(const f32x4*)(sin_ + (size_t)sn_ * 65536 + 64); }     \
                            const LAS float* bs = B + (st) * 64 + 4 * p; \
                            const f32x4 w4 = *(const LAS f32x4*)bs, kk4 = *(const LAS f32x4*)(bs + 1024), ka4 = *(const LAS f32x4*)(bs + 2048), km4 = *(const LAS f32x4*)(bs + 3072), r4 = *(const LAS f32x4*)(bs + 4096); \
                            const f32x2 vv = *(const LAS f32x2*)(B + 5120 + (st) * 64 + vrow); \
                            float sa0 = (Sa.x * kk4.x + Sa.y * kk4.y) + (Sa.z * kk4.z + Sa.w * kk4.w), sa1 = (Sb.x * kk4.x + Sb.y * kk4.y) + (Sb.z * kk4.z + Sb.w * kk4.w); \
                            sa0 = -sum16(sa0); sa1 = -sum16(sa1); \
                            Sa = Sa * w4 + ka4 * sa0 + km4 * vv.x; Sb = Sb * w4 + ka4 * sa1 + km4 * vv.y; \
                            float y0 = (Sa.x * r4.x + Sa.y * r4.y) + (Sa.z * r4.z + Sa.w * r4.w), y1 = (Sb.x * r4.x + Sb.y * r4.y) + (Sb.z * r4.z + Sb.w * r4.w); \
                            y0 = sum16(y0); y1 = sum16(y1); \
                            if (p == (st)) { ykeep.x = y0; ykeep.y = y1; } \
                            if (IND) { *(f32x4*)(sout_ + (size_t)(st) * 65536) = Sa; *(f32x4*)(sout_ + (size_t)(st) * 65536 + 64) = Sb; } }
                        if (cw) {
                            if (!indep) {
#pragma unroll
                                for (int st = 0; st < 16; ++st) SCAN_STEP(st, false)
                            } else {
                                nSa = *(const f32x4*)sin_; nSb = *(const f32x4*)(sin_ + 64);
#pragma unroll 1
                                for (int st = 0; st < 16; ++st) SCAN_STEP(st, true)
                            }
                            *(f32x2*)(YR + (size_t)(rowbase + t0 + p) * D + ch + vrow) = ykeep;
                        }
#undef SCAN_STEP
                    }
                    if (!indep && cw) { float* so = out + O_WKP + (size_t)(seq * 16 + h) * 4096 + vrow * 64 + 4 * p; *(f32x4*)so = Sa; *(f32x4*)(so + 64) = Sb; }
                    __syncthreads();
                }
            }
            PH_END
            PH_BEGIN(3)
            {
                const float *Vr = RKV + (size_t)2 * M * D; const bf16* GB = (const bf16*)(DAG + (size_t)2 * M * D); const float* RKb = (const float*)(ws + WB_L1);
                const float *ln_g = a.in[26], *ln_b = a.in[27];
                for (int m = gw; m < M; m += NGW) {
                    const size_t off = (size_t)m * D + lane * 16; const int c0 = lane * 16;
                    f32x4 y[4]; float s1 = 0.f;
                    const float rk = RKb[(size_t)m * 16 + (lane >> 2)];
                    const u32x4 g0 = *(const u32x4*)(GB + off), g1 = *(const u32x4*)(GB + off + 8);
#pragma unroll
                    for (int j = 0; j < 4; ++j) { y[j] = *(const f32x4*)(YR + off + 4 * j); s1 += (y[j].x + y[j].y) + (y[j].z + y[j].w); }
                    s1 = sum4(s1);
                    const float mu = s1 * (1.f / 64.f); float s2 = 0.f;
#pragma unroll
                    for (int j = 0; j < 4; ++j) { const f32x4 d = y[j] - mu; s2 += (d.x * d.x + d.y * d.y) + (d.z * d.z + d.w * d.w); }
                    s2 = sum4(s2);
                    const float rstd = 1.0f / sqrtf(s2 * (1.f / 64.f) + 64e-5f);
                    u32x4 w0, w1;
#pragma unroll
                    for (int j = 0; j < 4; ++j) { const f32x4 lg = *(const f32x4*)(ln_g + c0 + 4 * j), lb = *(const f32x4*)(ln_b + c0 + 4 * j), v = *(const f32x4*)(Vr + off + 4 * j);
                        const unsigned ga = j == 0 ? g0.x : (j == 1 ? g0.z : (j == 2 ? g1.x : g1.z)), gb = j == 0 ? g0.y : (j == 1 ? g0.w : (j == 2 ? g1.y : g1.w));
                        const f32x4 g = {__uint_as_float(ga << 16), __uint_as_float(ga & 0xffff0000u), __uint_as_float(gb << 16), __uint_as_float(gb & 0xffff0000u)};
                        const f32x4 o = ((y[j] - mu) * rstd * lg + lb + v * rk) * g;
                        const unsigned a0 = cvt_pk_bf16(o[0], o[1]), a1 = cvt_pk_bf16(o[2], o[3]);
                        if (j == 0) { w0.x = a0; w0.y = a1; } else if (j == 1) { w0.z = a0; w0.w = a1; } else if (j == 2) { w1.x = a0; w1.y = a1; } else { w1.z = a0; w1.w = a1; } }
                    u32x4* yp = (u32x4*)(Y + off); yp[0] = w0; yp[1] = w1;
                }
            }
            PH_END
        } else {
            bf16* BC = (bf16*)(ws + CB_BC); float* U = (float*)(ws + CB_U); bf16* A2 = (bf16*)(ws + CB_A2);
            outA = A2; outB = (const bf16*)(ws + WS_COUT); outK = D;
            PH_BEGIN(4)
            {
                pg8::Gemm g{XN, (const bf16*)(ws + WS_CIN), M, 3072, D}; pg8::StaticOrder S; S.init(M, 3072, G, bid);
                EpiConvIn E{BC, U};
                pg8::gemm_phase<EpiConvIn, pg8::StaticOrder, true, true>(lds, g, S, E);
            }
            PH_END
            PH_BEGIN(3)
            {
                const float* cw = a.in[30]; const float* cst = a.in[5];
                for (size_t e = (size_t)bid * 512 + tid; e < (size_t)M * 256; e += (size_t)G * 512) {
                    const int m = (int)(e >> 8), c = (int)(e & 255) * 4;
                    const f32x4 w0 = *(const f32x4*)(cw + c), w1 = *(const f32x4*)(cw + D + c), w2 = *(const f32x4*)(cw + 2 * D + c);
                    const f32x4 u2 = *(const f32x4*)(U + (size_t)m * D + c); f32x4 u1, u0;
                    if (m < MP) { const int b = m / TP, t = m - b * TP;
                        u1 = t >= 1 ? *(const f32x4*)(U + (size_t)(m - 1) * D + c) : (f32x4){0.f, 0.f, 0.f, 0.f};
                        u0 = t >= 2 ? *(const f32x4*)(U + (size_t)(m - 2) * D + c) : (f32x4){0.f, 0.f, 0.f, 0.f};
                        if (t >= TP - 2) *(f32x4*)(out + O_CVP + ((size_t)b * 2 + (t - (TP - 2))) * D + c) = u2;
                    } else { const int s = m - MP;
                        u0 = *(const f32x4*)(cst + ((size_t)s * 2) * D + c); u1 = *(const f32x4*)(cst + ((size_t)s * 2 + 1) * D + c);
                        *(f32x4*)(out + O_CVS + ((size_t)s * 2) * D + c) = u1; *(f32x4*)(out + O_CVS + ((size_t)s * 2 + 1) * D + c) = u2; }
                    const f32x4 yv = w0 * u0 + w1 * u1 + w2 * u2;
                    const u32x2 bb = *(const u32x2*)(BC + (size_t)m * D + c);
                    const float b0 = __uint_as_float(bb.x << 16), b1 = __uint_as_float(bb.x & 0xffff0000u), b2 = __uint_as_float(bb.y << 16), b3 = __uint_as_float(bb.y & 0xffff0000u);
                    u32x2 wv; wv.x = cvt_pk_bf16(b0 * yv[0], b1 * yv[1]); wv.y = cvt_pk_bf16(b2 * yv[2], b3 * yv[3]);
                    *(u32x2*)(A2 + (size_t)m * D + c) = wv;
                }
            }
            PH_END
        }
        PH_BEGIN(7)
        {
            pg8::Gemm g{outA, outB, M, D, outK}; TailOrder S; S.init(D, outK, G, bid);
            EpiResid E{H, (rep_ & 1) ? -1.f : 1.f};
            pg8::gemm_phase<EpiResid, TailOrder, true, true>(lds, g, S, E);
        }
        PH_END
        PH_BEGIN(3)
        {
            const float* gain = a.in[9] + (size_t)layer * D;
            for (int m = gw; m < M; m += 2 * NGW) { const int m1 = m + NGW; const bool has1 = m1 < M; f32x4 v0[4], v1[4]; rms_row2(H + (size_t)m * D, H + (size_t)(has1 ? m1 : m) * D, gain, lane, v0, v1); store_row_bf16(XN + (size_t)m * D, lane, v0); if (has1) store_row_bf16(XN + (size_t)m1 * D, lane, v1); }
        }
        PH_END
        bf16* ACT = (bf16*)(ws + MB_ACT);
        PH_BEGIN(4)
        {
            pg8::Gemm g{XN, (const bf16*)(ws + WS_M1 + (size_t)layer * al((size_t)FF * D * 2)), M, FF, D}; pg8::StaticOrder S; S.init(M, FF, G, bid);
            EpiRelu2 E{ACT};
            pg8::gemm_phase<EpiRelu2, pg8::StaticOrder, true, true>(lds, g, S, E);
        }
        PH_END
        PH_BEGIN(7)
        {
            pg8::Gemm g{ACT, (const bf16*)(ws + WS_M2 + (size_t)layer * al((size_t)FF * D * 2)), M, D, FF}; TailOrder S; S.init(D, FF, G, bid);
            EpiResid E{H, (rep_ & 1) ? -1.f : 1.f};
            pg8::gemm_phase<EpiResid, TailOrder, true, true>(lds, g, S, E);
        }
        PH_END
        PH_BEGIN(3)
        {
            if (layer == 3) {
                for (int m = gw; m < M; m += NGW) {
                    float* dst;
                    if (m < MP) { const int b = m / TP, t = m - b * TP; if (t < 16) continue; dst = out + O_YP + ((size_t)b * 2048 + (t - 16)) * D; }
                    else dst = out + O_YS + (size_t)(m - MP) * D;
                    f32x4 v[4]; rms_row(H + (size_t)m * D, a.in[10], lane, v);
                    f32x4* o = (f32x4*)dst + lane;
#pragma unroll
                    for (int j = 0; j < 4; ++j) o[64 * j] = v[j];
                }
            } else if ((layer + 1) % 3 == 1) {
                const float* gain = a.in[8] + (size_t)(layer + 1) * D; const float* mix = a.in[13];
                bf16* XM = (bf16*)(ws + WB_XM);
                f32x4 mrow[6][4];
#pragma unroll
                for (int q = 0; q < 6; ++q)
#pragma unroll
                    for (int j = 0; j < 4; ++j) mrow[q][j] = ((const f32x4*)(mix + (size_t)q * D) + lane)[64 * j];
                for (int m = gw; m < M; m += NGW) {
                    f32x4 xn[4], xp[4];
                    rms_row(H + (size_t)m * D, gain, lane, xn);
                    int b = 0, t = 0;
                    if (m < MP) { b = m / TP; t = m - b * TP;
                        if (t > 0) rms_row(H + (size_t)(m - 1) * D, gain, lane, xp);
                        else {
#pragma unroll
                            for (int j = 0; j < 4; ++j) xp[j] = (f32x4){0.f, 0.f, 0.f, 0.f}; }
                        if (t == TP - 1) { f32x4* o = (f32x4*)(out + O_SHP + (size_t)b * D) + lane;
#pragma unroll
                            for (int j = 0; j < 4; ++j) o[64 * j] = xn[j]; }
                    } else { const int s = m - MP; const f32x4* sp = (const f32x4*)(a.in[3] + (size_t)s * D) + lane; f32x4* o = (f32x4*)(out + O_SHS + (size_t)s * D) + lane;
#pragma unroll
                        for (int j = 0; j < 4; ++j) { xp[j] = sp[64 * j]; o[64 * j] = xn[j]; } }
#pragma unroll
                    for (int j = 0; j < 4; ++j) xp[j] = xp[j] - xn[j];
#pragma unroll
                    for (int q = 0; q < 6; ++q) { f32x4 v[4];
#pragma unroll
                        for (int j = 0; j < 4; ++j) v[j] = xn[j] + xp[j] * mrow[q][j];
                        store_row_bf16(XM + ((size_t)q * M + m) * D, lane, v); }
                }
            } else {
                const float* gain = a.in[8] + (size_t)(layer + 1) * D;
                for (int m = gw; m < M; m += 2 * NGW) { const int m1 = m + NGW; const bool has1 = m1 < M; f32x4 v0[4], v1[4]; rms_row2(H + (size_t)m * D, H + (size_t)(has1 ? m1 : m) * D, gain, lane, v0, v1); store_row_bf16(XN + (size_t)m * D, lane, v0); if (has1) store_row_bf16(XN + (size_t)m1 * D, lane, v1); }
            }
        }
        PH_END
    }
#undef PH_BEGIN
#undef PH_END
}

constexpr int N_PHASES = 33;

#ifndef REP0
#define REP0 1
#define REP1 1
#define REP2 1
#define REP3 1
#define REP4 1
#endif
#ifndef REP5
#define REP5 1
#endif
#ifndef REP7
#define REP7 1
#endif
#ifndef MK_MULTI
#define MK_MULTI 0
#endif

extern "C" void kernel_launch(void* const* d_in, const int* in_sizes, int n_in, void* d_out, int out_size, void* d_ws, size_t ws_size, hipStream_t stream) {
    static int grid = 0;
    if (grid == 0) {
        if (n_in != 34 || (size_t)out_size != O_END || ws_size < WS_TOTAL) { fprintf(stderr, "kernel_launch: unexpected shapes: n_in %d out %d ws %zu (need %zu)\n", n_in, out_size, ws_size, (size_t)WS_TOTAL); grid = -1; return; }
        int dev = 0, cus = 0, per_cu = 0;
        hipGetDevice(&dev); hipDeviceGetAttribute(&cus, hipDeviceAttributeMultiprocessorCount, dev);
        if (hipFuncSetAttribute((const void*)fwd_kernel, hipFuncAttributeMaxDynamicSharedMemorySize, LDS_BYTES) != hipSuccess) { fprintf(stderr, "kernel_launch: hipFuncSetAttribute failed\n"); grid = -1; return; }
        if (hipOccupancyMaxActiveBlocksPerMultiprocessor(&per_cu, (const void*)fwd_kernel, 512, LDS_BYTES) != hipSuccess || per_cu < 1) { fprintf(stderr, "kernel_launch: occupancy query says %d\n", per_cu); (void)hipGetLastError(); grid = -1; return; }
        grid = cus * 1;
    }
    if (grid < 0) return;
    if (hipMemsetAsync((char*)d_ws + WS_BAR, 0, 16384, stream) != hipSuccess) { fprintf(stderr, "kernel_launch: memset failed\n"); return; }
    KArgs a{};
    for (int i = 0; i < 34; ++i) a.in[i] = (const float*)d_in[i];
    a.out = (float*)d_out; a.ws = (unsigned char*)d_ws;
    { const int reps[8] = {REP0, REP1, REP2, REP3, REP4, REP5, 1, REP7}; for (int i = 0; i < 8; ++i) a.rep[i] = reps[i]; }
#if MK_MULTI
    for (int p = 0; p < N_PHASES; ++p) { a.ph_lo = p; a.ph_hi = p + 1; a.coop = 0; hipLaunchKernelGGL(fwd_kernel, dim3(grid), dim3(512), LDS_BYTES, stream, a); }
#else
    a.ph_lo = 0; a.ph_hi = N_PHASES; a.coop = 1;
    void* args[] = {&a};
    hipError_t e = hipLaunchCooperativeKernel((const void*)fwd_kernel, dim3(grid), dim3(512), args, LDS_BYTES, stream);
    if (e != hipSuccess) fprintf(stderr, "cooperative launch failed: %s (grid %d)\n", hipGetErrorString(e), grid);
#endif
}
```

```cpp
#include <hip/hip_runtime.h>
#include <hip/hip_cooperative_groups.h>
#include <cstdio>
#include <cstdint>
namespace cg = cooperative_groups;
namespace pg8 {
#define PG8_LAS __attribute__((address_space(3)))
typedef unsigned short bf16_t;
typedef short bf16x8 __attribute__((ext_vector_type(8)));
typedef float f32x4 __attribute__((ext_vector_type(4)));
typedef unsigned u32x4 __attribute__((ext_vector_type(4)));
constexpr int BM = 256, BK = 64, HALF = 128, HTB = HALF * BK * 2  , STAGE_BYTES = 8 * HTB, NXCD = 8, WGM = 8;

__host__ __device__ __forceinline__ int lds_byte(int r, int c) { const int st = (r >> 4) * 2 + (c >> 5), rr = r & 15, cc = c & 31, ob = rr * 64 + cc * 2; return st * 1024 + (ob ^ (((ob >> 9) & 1) << 5)); }
__host__ __device__ __forceinline__ void stage_rc(int b, int& R, int& C) { const int st = b / 1024, sb = b % 1024, swz = sb ^ (((sb >> 9) & 1) << 5); R = (st >> 1) * 16 + swz / 64; C = (st & 1) * 32 + (swz % 64) / 2; }
__host__ __device__ __forceinline__ int perm32(int rho) { const int n = rho >> 4, i = rho & 15; return 8 * (i >> 2) + 4 * n + (i & 3); }

struct Unit { int pm, pn, k0, nt; };
struct Gemm { const bf16_t* A; const bf16_t* Bt; int M, N, K; };

struct StaticOrder {
    int nM, nN, nwg, G, c;
    __host__ __device__ void init(int M, int N, int G_, int c_) { nM = M / BM; nN = N / BM; nwg = nM * nN; G = G_; c = c_; }
    __host__ __device__ __forceinline__ bool next(int i, Unit& u) const {
        const long L = (long)i * G + c; if (L >= nwg) return false;
        int wgid = (int)L; { const int q = nwg / NXCD, r = nwg % NXCD, xcd = wgid % NXCD, off = wgid / NXCD; wgid = (xcd < r ? xcd * (q + 1) : r * (q + 1) + (xcd - r) * q) + off; }
        const int nig = WGM * nN, gid = wgid / nig, fm = gid * WGM, gsz = (nM - fm) < WGM ? (nM - fm) : WGM;
        u.pm = fm + ((wgid % nig) % gsz); u.pn = (wgid % nig) / gsz; u.k0 = 0; u.nt = 0; return true;
    }
    __device__ __forceinline__ void a_ready(const Unit&) const {}
    __device__ __forceinline__ void done(const Unit&) const {}
};

__device__ __forceinline__ unsigned cvt_pk_bf16(float lo, float hi) { unsigned r; asm volatile("v_cvt_pk_bf16_f32 %0, %1, %2" : "=v"(r) : "v"(lo), "v"(hi)); return r; }
template <class Epi, class Sched, bool ALIGN_EPI = false, bool SP2 = false>
__device__ __forceinline__ void gemm_phase(PG8_LAS unsigned char* lds, const Gemm g, const Sched& S, const Epi& E) {
    int tid_ = threadIdx.x; asm volatile("" : "+v"(tid_));
    const int tid = tid_, wid = __builtin_amdgcn_readfirstlane(tid >> 6), lane = tid & 63, wr = wid >> 2, wc = wid & 3, fr = lane & 15, fq = lane >> 4;
    const int K = g.K, nt = K / BK;
    unsigned voffA[2], voffB[2];
#pragma unroll
    for (int i = 0; i < 2; ++i) { int R, C; stage_rc(tid * 16 + i * 8192, R, C); const int Rb = Epi::PERM ? ((R & ~31) + perm32(R & 31)) : R;
        voffA[i] = (unsigned)(R * K + C) * 2u; voffB[i] = (unsigned)(Rb * K + C) * 2u; }
    const size_t kstep = (size_t)(BK * 2);
    const size_t hstep = (size_t)HALF * K * 2;
    const size_t tstep = 2 * hstep;
    const unsigned ldsw = (unsigned)wid * 1024u;
    const int aoff = lds_byte(wr * 64 + fr, fq * 8), boff = lds_byte(wc * 32 + fr, fq * 8);
#define PG8_SA(b, h) (((b) * 2 + (h)) * HTB)
#define PG8_SB(b, h) ((4 + (b) * 2 + (h)) * HTB)
#define PG8_STAGE(bufoff, gbase, voff) do { _Pragma("unroll") for (int _i = 0; _i < 2; ++_i) \
        __builtin_amdgcn_global_load_lds((const unsigned*)((const char*)(gbase) + (voff)[_i]), (PG8_LAS unsigned*)(lds + (bufoff) + ldsw + _i * 8192), 16, 0, 0); } while (0)
#define PG8_LDA(dst, b, h) do { _Pragma("unroll") for (int m = 0; m < 4; ++m) _Pragma("unroll") for (int k = 0; k < 2; ++k) dst[m][k] = *(const PG8_LAS bf16x8*)(lds + PG8_SA(b, h) + aoff + m * 2048 + k * 1024); } while (0)
#define PG8_LDB(dst, b, h) do { _Pragma("unroll") for (int n = 0; n < 2; ++n) _Pragma("unroll") for (int k = 0; k < 2; ++k) dst[n][k] = *(const PG8_LAS bf16x8*)(lds + PG8_SB(b, h) + boff + n * 2048 + k * 1024); } while (0)
#define PG8_MMA(ai, bj, At, Bt) do { __builtin_amdgcn_s_setprio(1); _Pragma("unroll") for (int m = 0; m < 4; ++m) _Pragma("unroll") for (int n = 0; n < 2; ++n) _Pragma("unroll") for (int k = 0; k < 2; ++k) \
        acc[ai][bj][m][n] = __builtin_amdgcn_mfma_f32_16x16x32_bf16(Bt[n][k], At[m][k], acc[ai][bj][m][n], 0, 0, 0); __builtin_amdgcn_s_setprio(0); } while (0)
#define PG8_WAIT_V(n) asm volatile("s_waitcnt vmcnt(" #n ")" ::: "memory")
#define PG8_WAIT_L(n) asm volatile("s_waitcnt lgkmcnt(" #n ")" ::: "memory")
#define PG8_BAR __builtin_amdgcn_s_barrier()
#define PG8_SCHED __builtin_amdgcn_sched_barrier(0)
    Unit cur, nxt; int ui = 0;
    if (!S.next(0, cur)) return;
    f32x4 acc[2][2][4][2];
#pragma unroll
    for (int a = 0; a < 2; ++a)
#pragma unroll
        for (int b = 0; b < 2; ++b)
#pragma unroll
            for (int m = 0; m < 4; ++m)
#pragma unroll
                for (int n = 0; n < 2; ++n) acc[a][b][m][n] = (f32x4){0.f, 0.f, 0.f, 0.f};
    bf16x8 At[4][2], B0[2][2], B1[2][2];
    const char* cA = (const char*)g.A + (size_t)cur.pm * tstep + (size_t)cur.k0 * 2; const char* cB = (const char*)g.Bt + (size_t)cur.pn * tstep + (size_t)cur.k0 * 2;
    S.a_ready(cur);
    if constexpr (SP2) {
        PG8_STAGE(PG8_SB(0, 0), cB, voffB); PG8_STAGE(PG8_SB(0, 1), cB + hstep, voffB); PG8_STAGE(PG8_SA(0, 0), cA, voffA); PG8_STAGE(PG8_SA(0, 1), cA + hstep, voffA);
        if (wr == 1) PG8_BAR;
        PG8_WAIT_V(2); PG8_BAR;
        PG8_STAGE(PG8_SB(1, 0), cB + kstep, voffB); PG8_STAGE(PG8_SA(1, 0), cA + kstep, voffA); PG8_STAGE(PG8_SB(1, 1), cB + hstep + kstep, voffB);
        PG8_WAIT_V(6); PG8_BAR;
    } else {
        PG8_STAGE(PG8_SB(0, 0), cB, voffB); PG8_STAGE(PG8_SA(0, 0), cA, voffA); PG8_STAGE(PG8_SB(0, 1), cB + hstep, voffB); PG8_STAGE(PG8_SA(0, 1), cA + hstep, voffA);
        if (wr == 1) PG8_BAR;
        PG8_WAIT_V(4); PG8_BAR;
        PG8_STAGE(PG8_SB(1, 0), cB + kstep, voffB); PG8_STAGE(PG8_SA(1, 0), cA + kstep, voffA); PG8_STAGE(PG8_SB(1, 1), cB + hstep + kstep, voffB);
        PG8_WAIT_V(6); PG8_BAR;
    }
    for (;;) {
        const bool has_next = S.next(ui + 1, nxt);
        const char* nA = has_next ? (const char*)g.A + (size_t)nxt.pm * tstep + (size_t)nxt.k0 * 2 : cA; const char* nB = has_next ? (const char*)g.Bt + (size_t)nxt.pn * tstep + (size_t)nxt.k0 * 2 : cB;
        const int ntc = cur.nt ? cur.nt : nt;
        for (int t = 0; t < ntc; t += 2) {
            const bool last = (t == ntc - 2);
            const char* a1 = cA + (size_t)(t + 1) * kstep;
            const char* a2 = last ? nA : cA + (size_t)(t + 2) * kstep; const char* b2 = last ? nB : cB + (size_t)(t + 2) * kstep;
            const char* a3 = a2 + kstep; const char* b3 = b2 + kstep;
            if (last && has_next) S.a_ready(nxt);
            if constexpr (SP2) {
            PG8_LDB(B0, 0, 0); PG8_LDB(B1, 0, 1); PG8_SCHED; PG8_LDA(At, 0, 0); PG8_STAGE(PG8_SA(1, 1), a1 + hstep, voffA);
            PG8_WAIT_V(8); PG8_WAIT_L(0); PG8_BAR; PG8_MMA(0, 0, At, B0); PG8_MMA(0, 1, At, B1); PG8_BAR; PG8_SCHED;
            PG8_LDA(At, 0, 1); PG8_STAGE(PG8_SB(0, 0), b2, voffB); PG8_STAGE(PG8_SB(0, 1), b2 + hstep, voffB); PG8_STAGE(PG8_SA(0, 0), a2, voffA);
            PG8_WAIT_V(8); PG8_WAIT_L(0); PG8_BAR; PG8_MMA(1, 0, At, B0); PG8_MMA(1, 1, At, B1); PG8_BAR; PG8_SCHED;
            PG8_LDB(B0, 1, 0); PG8_LDB(B1, 1, 1); PG8_SCHED; PG8_LDA(At, 1, 0); PG8_STAGE(PG8_SA(0, 1), a2 + hstep, voffA);
            PG8_WAIT_V(8); PG8_WAIT_L(0); PG8_BAR; PG8_MMA(0, 0, At, B0); PG8_MMA(0, 1, At, B1); PG8_BAR; PG8_SCHED;
            PG8_LDA(At, 1, 1); PG8_STAGE(PG8_SB(1, 0), b3, voffB); PG8_STAGE(PG8_SB(1, 1), b3 + hstep, voffB); PG8_STAGE(PG8_SA(1, 0), a3, voffA);
            PG8_WAIT_V(8); PG8_WAIT_L(0); PG8_BAR; PG8_MMA(1, 0, At, B0); PG8_MMA(1, 1, At, B1); PG8_BAR; PG8_SCHED;
            } else {
            PG8_LDB(B0, 0, 0); PG8_SCHED; PG8_LDA(At, 0, 0); PG8_STAGE(PG8_SA(1, 1), a1 + hstep, voffA);
            PG8_WAIT_L(8); PG8_BAR; PG8_WAIT_L(0); PG8_MMA(0, 0, At, B0); PG8_BAR; PG8_SCHED;
            PG8_LDB(B1, 0, 1); PG8_STAGE(PG8_SB(0, 0), b2, voffB);
            PG8_BAR; PG8_WAIT_L(0); PG8_MMA(0, 1, At, B1); PG8_BAR;
            PG8_LDA(At, 0, 1); PG8_STAGE(PG8_SA(0, 0), a2, voffA);
            PG8_BAR; PG8_WAIT_L(0); PG8_MMA(1, 0, At, B0); PG8_BAR; PG8_SCHED;
            PG8_STAGE(PG8_SB(0, 1), b2 + hstep, voffB);
            PG8_WAIT_V(6); PG8_BAR; PG8_MMA(1, 1, At, B1); PG8_BAR;
            PG8_LDB(B0, 1, 0); PG8_SCHED; PG8_LDA(At, 1, 0); PG8_STAGE(PG8_SA(0, 1), a2 + hstep, voffA);
            PG8_WAIT_L(8); PG8_BAR; PG8_WAIT_L(0); PG8_MMA(0, 0, At, B0); PG8_BAR; PG8_SCHED;
            PG8_LDB(B1, 1, 1); PG8_STAGE(PG8_SB(1, 0), b3, voffB);
            PG8_BAR; PG8_WAIT_L(0); PG8_MMA(0, 1, At, B1); PG8_BAR;
            PG8_LDA(At, 1, 1); PG8_STAGE(PG8_SA(1, 0), a3, voffA);
            PG8_BAR; PG8_WAIT_L(0); PG8_MMA(1, 0, At, B0); PG8_BAR; PG8_SCHED;
            PG8_STAGE(PG8_SB(1, 1), b3 + hstep, voffB);
            PG8_WAIT_V(6); PG8_BAR; PG8_MMA(1, 1, At, B1); PG8_BAR;
            }
        }
        if constexpr (ALIGN_EPI) { if (wr == 0) PG8_BAR; }
        if constexpr (!Epi::AFTER_DRAIN) { E(acc, cur, wr, wc, fr, fq); S.done(cur); }
        if (!has_next) break;
#pragma unroll
        for (int a = 0; a < 2; ++a)
#pragma unroll
            for (int b = 0; b < 2; ++b)
#pragma unroll
                for (int m = 0; m < 4; ++m)
#pragma unroll
                    for (int n = 0; n < 2; ++n) acc[a][b][m][n] = (f32x4){0.f, 0.f, 0.f, 0.f};
        cur = nxt; cA = nA; cB = nB; ++ui;
        if constexpr (ALIGN_EPI) { if (wr == 1) PG8_BAR; }
    }
    PG8_WAIT_V(0);
    if constexpr (!ALIGN_EPI) { if (wr == 0) PG8_BAR; }
    PG8_BAR;
    if constexpr (Epi::AFTER_DRAIN) { E.fused(acc, cur, wr, wc, fr, fq, lds, wid, lane); S.done(cur); }
#undef PG8_SA
#undef PG8_SB
#undef PG8_STAGE
#undef PG8_LDA
#undef PG8_LDB
#undef PG8_MMA
#undef PG8_WAIT_V
#undef PG8_WAIT_L
#undef PG8_BAR
#undef PG8_SCHED
}
}

#define LAS __attribute__((address_space(3)))
typedef unsigned short bf16;
typedef short bf16x8 __attribute__((ext_vector_type(8)));
typedef float f32x4 __attribute__((ext_vector_type(4)));
typedef float f32x2 __attribute__((ext_vector_type(2)));
typedef float f32x16 __attribute__((ext_vector_type(16)));
typedef unsigned u32x4 __attribute__((ext_vector_type(4)));
typedef unsigned u32x2 __attribute__((ext_vector_type(2)));
using pg8::cvt_pk_bf16;
using pg8::Unit;

constexpr int D = 1024, NB = 8, TP = 2064, MP = NB * TP, NS = 128, M = MP + NS, NMT = M / 256;
constexpr int FF = 4096, NRI = 6144, HV = 2048;
constexpr float EPS = 1e-6f;
static_assert(M % 256 == 0, "rows");

constexpr size_t O_YP = 0, O_YS = 16777216, O_R0P = 16908288, O_R0S = 21102592, O_SHP = 88211456, O_SHS = 88219648,
                 O_WKP = 88350720, O_WKS = 88875008, O_CVP = 97263616, O_CVS = 97280000, O_R3P = 97542144, O_R3S = 101736448, O_END = 168845312;

constexpr size_t al(size_t x) { return (x + 4095) & ~(size_t)4095; }
constexpr size_t WS_RI0 = 4096, WS_RI1 = WS_RI0 + al((size_t)NRI * D * 2), WS_RO0 = WS_RI1 + al((size_t)NRI * D * 2), WS_RO1 = WS_RO0 + al((size_t)D * HV * 2),
                 WS_RW1 = WS_RO1 + al((size_t)D * HV * 2), WS_RW2 = WS_RW1 + al((size_t)3840 * D * 2), WS_RWO = WS_RW2 + al((size_t)3072 * 256 * 2),
                 WS_CIN = WS_RWO + al((size_t)D * D * 2), WS_COUT = WS_CIN + al((size_t)3072 * D * 2), WS_M1 = WS_COUT + al((size_t)D * D * 2),
                 WS_M2 = WS_M1 + 4 * al((size_t)FF * D * 2), WS_ROPE = WS_M2 + 4 * al((size_t)FF * D * 2), WS_H = WS_ROPE + al((size_t)2065 * 128 * 8),
                 WS_XN = WS_H + al((size_t)M * D * 4), WS_B = WS_XN + al((size_t)M * D * 2);
constexpr size_t RB_Q = WS_B, RB_K = RB_Q + al((size_t)M * D * 2), RB_KTD = RB_K + al((size_t)M * D * 2), RB_VT = RB_KTD + al((size_t)32 * 256 * TP * 2),
                 RB_VS = RB_VT + al((size_t)32 * 512 * TP * 2), RB_SG = RB_VS + al((size_t)NS * HV * 4), RB_OB = RB_SG + al((size_t)M * HV * 2),
                 RB_Y = RB_OB + al((size_t)M * HV * 2), RB_END = RB_Y + al((size_t)M * HV * 2);
constexpr size_t WB_XM = WS_B, WB_DAG = WS_B  , WB_RKV = WB_XM + al((size_t)6 * M * D * 2), WB_L1 = WB_RKV + al((size_t)3 * M * D * 4),
                 WB_YR = WB_L1 + al((size_t)3 * M * 256 * 2), WB_Y = WB_YR + al((size_t)M * D * 4), WB_END = WB_Y + al((size_t)M * D * 2);
static_assert((size_t)3 * M * D * 4 <= (size_t)6 * M * D * 2, "DAG fits over XM");
constexpr size_t CB_BC = WS_B, CB_U = CB_BC + al((size_t)M * D * 2), CB_A2 = CB_U + al((size_t)M * D * 4), CB_END = CB_A2 + al((size_t)M * D * 2);
constexpr size_t MB_ACT = WS_B, MB_END = MB_ACT + al((size_t)M * FF * 2);
constexpr size_t cmax(size_t a, size_t b) { return a > b ? a : b; }
constexpr size_t WS_END = cmax(cmax(RB_END, WB_END), cmax(CB_END, MB_END));

constexpr size_t WS_BAR = al(WS_END), WS_TOTAL = WS_BAR + 16384;
constexpr int LDS_BYTES = 147456, LDS_MISC = 131072 + 256;

#define LDS_WAIT() asm volatile("s_waitcnt lgkmcnt(0)" ::: "memory")
__device__ __forceinline__ float bf2f(bf16 x) { return __uint_as_float((unsigned)x << 16); }
__device__ __forceinline__ unsigned f2bf(float f) { unsigned u = __builtin_bit_cast(unsigned, f); return (u + 0x7fffu + ((u >> 16) & 1u)) >> 16; }
__device__ __forceinline__ unsigned pk2(float lo, float hi) { return f2bf(lo) | (f2bf(hi) << 16); }
__device__ __forceinline__ float wave_sum(float v) {
#pragma unroll
    for (int o = 1; o < 64; o <<= 1) v += __shfl_xor(v, o);
    return v;
}
template <int CTRL> __device__ __forceinline__ float dpp_add(float x) {
    const int xi = __builtin_bit_cast(int, x);
    const int yi = __builtin_amdgcn_update_dpp(0, xi, CTRL, 0xF, 0xF, false);
    return x + __builtin_bit_cast(float, yi);
}
__device__ __forceinline__ float sum4(float x) { x = dpp_add<0xB1>(x); x = dpp_add<0x4E>(x); return x; }
__device__ __forceinline__ float sum16(float x) { x = sum4(x); x = dpp_add<0x141>(x); x = dpp_add<0x140>(x); return x; }
__device__ __forceinline__ int crow(int r, int hi) { return (r & 3) + 8 * (r >> 2) + 4 * hi; }
#define MFMA32(a, b, c) __builtin_amdgcn_mfma_f32_32x32x16_bf16((a), (b), (c), 0, 0, 0)

struct StackOrder {
    pg8::StaticOrder base; int mode;
    __device__ __forceinline__ bool next(int i, Unit& u) const {
        if (!base.next(i, u)) return false;
        const int j = mode == 1 ? (u.pn < 12 ? (u.pn >> 2) : u.pn - 9) : (u.pn >> 2);
        u.pm += NMT * j; return true;
    }
    __device__ __forceinline__ void a_ready(const Unit&) const {}
    __device__ __forceinline__ void done(const Unit&) const {}
};

struct TailOrder {
    pg8::StaticOrder base; int nN, nsmall, G, c;
    __device__ __forceinline__ void init(int N, int K, int G_, int c_) { base.init(M - 256, N, G_, c_); nN = N / 256; nsmall = nN * (K / 256); G = G_; c = c_; }
    __device__ __forceinline__ bool next(int i, Unit& u) const {
        const long L = (long)i * G + c;
        if (L < base.nwg) return base.next(i, u);
        const int s = (int)(L - base.nwg); if (s >= nsmall) return false;
        u.pm = NMT - 1; u.pn = s % nN; u.k0 = (s / nN) * 256; u.nt = 4; return true;
    }
    __device__ __forceinline__ void a_ready(const Unit&) const {}
    __device__ __forceinline__ void done(const Unit&) const {}
};

#define EPI_LOOP_ROWS for (int ai = 0; ai < 2; ++ai) for (int m = 0; m < 4; ++m)
#define EPI_LOOP_COLS for (int bj = 0; bj < 2; ++bj) for (int n = 0; n < 2; ++n)

struct EpiResid {
    static constexpr bool PERM = false, AFTER_DRAIN = false;
    float* H; float sgn;
    __device__ __forceinline__ void operator()(const f32x4 (&acc)[2][2][4][2], const Unit& u, int wr, int wc, int fr, int fq) const {
        const int row0 = u.pm * 256 + wr * 64 + fr, col0 = u.pn * 256 + wc * 32 + 4 * fq;
        if (u.nt == 0) {
#pragma unroll
            EPI_LOOP_ROWS { float* rp = H + (size_t)(row0 + ai * 128 + m * 16) * D + col0;
#pragma unroll
                EPI_LOOP_COLS { f32x4* p = (f32x4*)(rp + bj * 128 + n * 16); *p = *p + acc[ai][bj][m][n] * sgn; } }
        } else {
#pragma unroll
            EPI_LOOP_ROWS { float* rp = H + (size_t)(row0 + ai * 128 + m * 16) * D + col0;
#pragma unroll
                EPI_LOOP_COLS { float* p = rp + bj * 128 + n * 16;
#pragma unroll
                    for (int i = 0; i < 4; ++i) __hip_atomic_fetch_add(p + i, acc[ai][bj][m][n][i] * sgn, __ATOMIC_RELAXED, __HIP_MEMORY_SCOPE_AGENT); } }
        }
    }
};

struct EpiRelu2 {
    static constexpr bool PERM = true, AFTER_DRAIN = false;
    bf16* O;
    __device__ __forceinline__ void operator()(const f32x4 (&acc)[2][2][4][2], const Unit& u, int wr, int wc, int fr, int fq) const {
#ifdef SKIP_EPIRELU2
        return;
#endif

        const int row0 = u.pm * 256 + wr * 64 + fr, col0 = u.pn * 256 + wc * 32 + 8 * fq;
#pragma unroll
        EPI_LOOP_ROWS { bf16* rp = O + (size_t)(row0 + ai * 128 + m * 16) * FF + col0;
#pragma unroll
            for (int bj = 0; bj < 2; ++bj) { f32x4 a = acc[ai][bj][m][0], b = acc[ai][bj][m][1];
                a = __builtin_elementwise_max(a, (f32x4){0.f, 0.f, 0.f, 0.f}); b = __builtin_elementwise_max(b, (f32x4){0.f, 0.f, 0.f, 0.f}); a = a * a; b = b * b;
                u32x4 w; w.x = cvt_pk_bf16(a[0], a[1]); w.y = cvt_pk_bf16(a[2], a[3]); w.z = cvt_pk_bf16(b[0], b[1]); w.w = cvt_pk_bf16(b[2], b[3]);
                *(u32x4*)(rp + bj * 128) = w; } }
    }
};

struct EpiRetIn {
    static constexpr bool PERM = false, AFTER_DRAIN = false;
    bf16 *Qb, *Kb, *KTD, *VT, *SG; float* VS; const float* rope;
    __device__ __forceinline__ void operator()(const f32x4 (&acc)[2][2][4][2], const Unit& u, int wr, int wc, int fr, int fq) const {
#ifdef SKIP_EPIRETIN
        return;
#endif

        const int row0 = u.pm * 256 + wr * 64 + fr, cin0 = wc * 32 + 4 * fq, pn = u.pn;
#pragma unroll
        for (int ai = 0; ai < 2; ++ai)
#pragma unroll
            for (int m = 0; m < 4; ++m) {
                const int r = row0 + ai * 128 + m * 16;
                const bool prm = r < MP; const int b = prm ? r / TP : 0; const int t = prm ? r - b * TP : 0; const int pidx = prm ? t : TP;
                if (pn < 8) {
                    const int h = pn & 3; const bool isk = pn >= 4;
                    float kdec = 1.f;
                    if (isk && prm) { const int e = t < 16 ? 15 - t : 127 - ((t - 16) & 127); kdec = __builtin_amdgcn_exp2f((float)e * __log2f(1.f - __builtin_amdgcn_exp2f(-(float)(5 + h)))); }
#pragma unroll
                    EPI_LOOP_COLS { const int d = bj * 128 + n * 16 + cin0; const f32x4 x = acc[ai][bj][m][n];
                        const f32x4 cs = *(const f32x4*)(rope + ((size_t)pidx * 128 + (d >> 1)) * 2);
                        f32x4 o; o[0] = x[0] * cs[0] - x[1] * cs[1]; o[1] = x[0] * cs[1] + x[1] * cs[0]; o[2] = x[2] * cs[2] - x[3] * cs[3]; o[3] = x[2] * cs[3] + x[3] * cs[2];
                        if (isk) o = o * 0.0625f;
                        u32x2 w; w.x = cvt_pk_bf16(o[0], o[1]); w.y = cvt_pk_bf16(o[2], o[3]);
                        *(u32x2*)((isk ? Kb : Qb) + (size_t)r * D + h * 256 + d) = w;
                        if (isk && prm) { bf16* kp = KTD + ((size_t)((b * 4 + h) * 256 + d)) * TP + t;
                            kp[0] = (bf16)f2bf(o[0] * kdec); kp[TP] = (bf16)f2bf(o[1] * kdec); kp[2 * TP] = (bf16)f2bf(o[2] * kdec); kp[3 * TP] = (bf16)f2bf(o[3] * kdec); } }
                } else if (pn < 16) {
                    const int h = (pn - 8) >> 1, e0 = ((pn - 8) & 1) * 256;
#pragma unroll
                    EPI_LOOP_COLS { const int e = e0 + bj * 128 + n * 16 + cin0; const f32x4 x = acc[ai][bj][m][n];
                        if (prm) { bf16* vp = VT + ((size_t)((b * 4 + h) * 512 + e)) * TP + t;
                            vp[0] = (bf16)f2bf(x[0]); vp[TP] = (bf16)f2bf(x[1]); vp[2 * TP] = (bf16)f2bf(x[2]); vp[3 * TP] = (bf16)f2bf(x[3]); }
                        else *(f32x4*)(VS + (size_t)(r - MP) * HV + h * 512 + e) = x; }
                } else {
                    const int c0 = (pn - 16) * 256;
#pragma unroll
                    EPI_LOOP_COLS { const int c = c0 + bj * 128 + n * 16 + cin0; const f32x4 x = acc[ai][bj][m][n]; f32x4 o;
#pragma unroll
                        for (int i = 0; i < 4; ++i) o[i] = x[i] / (1.f + __expf(-x[i]));
                        u32x2 w; w.x = cvt_pk_bf16(o[0], o[1]); w.y = cvt_pk_bf16(o[2], o[3]);
                        *(u32x2*)(SG + (size_t)r * HV + c) = w; }
                }
            }
    }
};

struct EpiRw1 {
    static constexpr bool PERM = false, AFTER_DRAIN = false;
    float* RKV; bf16* L1;
    __device__ __forceinline__ void operator()(const f32x4 (&acc)[2][2][4][2], const Unit& u, int wr, int wc, int fr, int fq) const {
#ifdef SKIP_EPIRW1
        return;
#endif

        const int pmr = u.pm % NMT, row0 = pmr * 256 + wr * 64 + fr, cin0 = wc * 32 + 4 * fq, pn = u.pn;
        if (pn < 12) {
            float* base = RKV + (size_t)(pn >> 2) * M * D + (pn & 3) * 256 + cin0;
#pragma unroll
            EPI_LOOP_ROWS { float* rp = base + (size_t)(row0 + ai * 128 + m * 16) * D;
#pragma unroll
                EPI_LOOP_COLS *(f32x4*)(rp + bj * 128 + n * 16) = acc[ai][bj][m][n]; }
        } else {
            const int j = pn - 12; bf16* base = L1 + (size_t)j * M * 256 + cin0;
#pragma unroll
            for (int ai = 0; ai < 2; ++ai)
#pragma unroll
                for (int m = 0; m < 4; ++m) { bf16* rp = base + (size_t)(row0 + ai * 128 + m * 16) * 256;
#pragma unroll
                    EPI_LOOP_COLS { const f32x4 x = acc[ai][bj][m][n]; f32x4 o;
#pragma unroll
                        for (int i = 0; i < 4; ++i) o[i] = j == 0 ? tanhf(x[i]) : (j == 1 ? x[i] : 1.f / (1.f + __expf(-x[i])));
                        u32x2 w; w.x = cvt_pk_bf16(o[0], o[1]); w.y = cvt_pk_bf16(o[2], o[3]);
                        *(u32x2*)(rp + bj * 128 + n * 16) = w; } }
        }
    }
};

struct EpiRw2 {
    static constexpr bool PERM = false, AFTER_DRAIN = false;
    float* DAG; const float *w0, *a0;
    __device__ __forceinline__ void operator()(const f32x4 (&acc)[2][2][4][2], const Unit& u, int wr, int wc, int fr, int fq) const {
#ifdef SKIP_EPIRW2
        return;
#endif
        const int pmr = u.pm % NMT, row0 = pmr * 256 + wr * 64 + fr, pn = u.pn, j = pn >> 2, col0 = (pn & 3) * 256 + wc * 32 + 4 * fq;
        float* base = DAG + (size_t)j * M * D + (size_t)row0 * D + col0;
        const float* bias = j == 0 ? w0 : a0;
#pragma unroll
        EPI_LOOP_COLS { const int cc = bj * 128 + n * 16;
            f32x4 bb = (f32x4){0.f, 0.f, 0.f, 0.f}; if (j < 2) bb = *(const f32x4*)(bias + col0 + cc);
#pragma unroll
            EPI_LOOP_ROWS { const f32x4 x = acc[ai][bj][m][n] + bb; f32x4 o;
                if (j == 0) {
#pragma unroll
                    for (int i = 0; i < 4; ++i) { const float z = -x[i]; const float sp = fmaxf(z, 0.f) + __logf(1.f + __expf(-fabsf(z))); o[i] = __expf(-__expf(-sp - 0.5f)); } }
                else if (j == 1) {
#pragma unroll
                    for (int i = 0; i < 4; ++i) o[i] = 1.f / (1.f + __expf(-x[i])); }
                else o = x;
                if (j == 2) { u32x2 wv; wv.x = cvt_pk_bf16(o[0], o[1]); wv.y = cvt_pk_bf16(o[2], o[3]); *(u32x2*)((bf16*)(DAG + (size_t)2 * M * D) + (size_t)(row0 + ai * 128 + m * 16) * D + col0 + cc) = wv; }
                else *(f32x4*)(base + (size_t)(ai * 128 + m * 16) * D + cc) = o; }
            asm volatile("" ::: "memory"); }
    }
};

struct EpiConvIn {
    static constexpr bool PERM = false, AFTER_DRAIN = false;
    bf16* BC; float* U;
    __device__ __forceinline__ void operator()(const f32x4 (&acc)[2][2][4][2], const Unit& u, int wr, int wc, int fr, int fq) const {
#ifdef SKIP_EPICONVIN
        return;
#endif

        const int row0 = u.pm * 256 + wr * 64 + fr, cin0 = wc * 32 + 4 * fq, pn = u.pn;
        if (pn < 4) {
#pragma unroll
            EPI_LOOP_ROWS { bf16* rp = BC + (size_t)(row0 + ai * 128 + m * 16) * D + pn * 256 + cin0;
#pragma unroll
                EPI_LOOP_COLS { const f32x4 x = acc[ai][bj][m][n]; u32x2 w; w.x = cvt_pk_bf16(x[0], x[1]); w.y = cvt_pk_bf16(x[2], x[3]); *(u32x2*)(rp + bj * 128 + n * 16) = w; } }
        } else {
#pragma unroll
            EPI_LOOP_ROWS { float* rp = U + (size_t)(row0 + ai * 128 + m * 16) * D + (pn - 4) * 128 + cin0;
#pragma unroll
                for (int n = 0; n < 2; ++n) *(f32x4*)(rp + n * 16) = acc[ai][0][m][n] * acc[ai][1][m][n]; }
        }
    }
};

__device__ __forceinline__ void tr_item(const float* W, int K, int N, bf16* WT, int ldk, int drow0, int k0, int n0, LAS bf16* scr, int lane) {
    f32x4 v[16];
    const int nl = (lane & 15) * 4, kq = lane >> 4, n = n0 + nl;
#pragma unroll
    for (int i = 0; i < 16; ++i) { const int k = k0 + 4 * i + kq; v[i] = (k < K && n < N) ? *(const f32x4*)(W + (size_t)k * N + n) : (f32x4){0.f, 0.f, 0.f, 0.f}; }
#pragma unroll
    for (int i = 0; i < 16; ++i) { const int kl = 4 * i + kq;
#pragma unroll
        for (int j = 0; j < 4; ++j) scr[(nl + j) * 72 + kl] = (bf16)f2bf(v[i][j]); }
    LDS_WAIT(); asm volatile("" ::: "memory");
    const int c = lane & 7;
#pragma unroll
    for (int q = 0; q < 8; ++q) { const int nr = q * 8 + (lane >> 3);
        const u32x4 o = *(const LAS u32x4*)(scr + nr * 72 + 8 * c);
        *(u32x4*)(WT + (size_t)(drow0 + nr) * ldk + k0 + 8 * c) = o; }
    LDS_WAIT(); asm volatile("" ::: "memory");
}
__device__ __forceinline__ int cin_row(int n0) { if (n0 < 1024) return n0; if (n0 < 2048) { const int j = n0 - 1024; return 1024 + (j >> 7) * 256 + (j & 127); } const int j = n0 - 2048; return 1024 + (j >> 7) * 256 + 128 + (j & 127); }

__device__ __forceinline__ void rms_row(const float* xrow, const float* gain, int lane, f32x4 (&v)[4]) {
    const f32x4* xr = (const f32x4*)xrow + lane; const f32x4* gr = (const f32x4*)gain + lane; float s = 0.f;
#pragma unroll
    for (int j = 0; j < 4; ++j) { v[j] = xr[64 * j]; s += (v[j].x * v[j].x + v[j].y * v[j].y) + (v[j].z * v[j].z + v[j].w * v[j].w); }
    const float rstd = 1.0f / sqrtf(wave_sum(s) * (1.f / D) + EPS);
#pragma unroll
    for (int j = 0; j < 4; ++j) v[j] = v[j] * rstd * gr[64 * j];
}
__device__ __forceinline__ void rms_row2(const float* x0, const float* x1, const float* gain, int lane, f32x4 (&v0)[4], f32x4 (&v1)[4]) {
    const f32x4* p0 = (const f32x4*)x0 + lane; const f32x4* p1 = (const f32x4*)x1 + lane; const f32x4* gr = (const f32x4*)gain + lane; float s0 = 0.f, s1 = 0.f;
#pragma unroll
    for (int j = 0; j < 4; ++j) { v0[j] = p0[64 * j]; v1[j] = p1[64 * j]; }
#pragma unroll
    for (int j = 0; j < 4; ++j) { s0 += (v0[j].x * v0[j].x + v0[j].y * v0[j].y) + (v0[j].z * v0[j].z + v0[j].w * v0[j].w); s1 += (v1[j].x * v1[j].x + v1[j].y * v1[j].y) + (v1[j].z * v1[j].z + v1[j].w * v1[j].w); }
#pragma unroll
    for (int o = 1; o < 64; o <<= 1) { s0 += __shfl_xor(s0, o); s1 += __shfl_xor(s1, o); }
    const float r0 = 1.0f / sqrtf(s0 * (1.f / D) + EPS), r1 = 1.0f / sqrtf(s1 * (1.f / D) + EPS);
#pragma unroll
    for (int j = 0; j < 4; ++j) { const f32x4 g = gr[64 * j]; v0[j] = v0[j] * r0 * g; v1[j] = v1[j] * r1 * g; }
}
__device__ __forceinline__ void store_row_bf16(bf16* orow, int lane, const f32x4 (&v)[4]) {
    u32x2* o8 = (u32x2*)orow + lane;
#pragma unroll
    for (int j = 0; j < 4; ++j) { u32x2 w; w.x = pk2(v[j].x, v[j].y); w.y = pk2(v[j].z, v[j].w); o8[64 * j] = w; }
}

#define XB_TMO      128
#define XB_XCNT(j)  (256  + 64 * (j))
#define XB_XSUB(j)  (1280 + 64 * (j))
#define XB_XGEN(j)  (2304 + 64 * (j))
#define XB_TOP      3328
#define XB_TOPGEN   3392
#define XCD_BAR_WORDS 3456
#define XB_SPIN_CAP (1u << 18)

__device__ __forceinline__ unsigned xb_ld(unsigned* p)              { return __hip_atomic_load(p, __ATOMIC_RELAXED, __HIP_MEMORY_SCOPE_AGENT); }
__device__ __forceinline__ unsigned xb_add(unsigned* p, unsigned v) { return __hip_atomic_fetch_add(p, v, __ATOMIC_RELAXED, __HIP_MEMORY_SCOPE_AGENT); }
__device__ __forceinline__ unsigned xb_xcc_id() { return (unsigned)__builtin_amdgcn_s_getreg((3 << 11) | 20) & 0xFu; }
#define XB_SPIN(cond, bar) do { unsigned _sp = 0; while (cond) { __builtin_amdgcn_s_sleep(1); \
    if ((++_sp & 255u) == 0u) { if (xb_ld(&(bar)[XB_TMO])) break; if (_sp > XB_SPIN_CAP) { atomicAdd(&(bar)[XB_TMO], 1u); break; } } } } while (0)

struct XcdBarrier {
    unsigned* bar; unsigned x;
    volatile LAS unsigned* st;
};

__device__ __forceinline__ XcdBarrier xcd_barrier_post(unsigned* bar, volatile LAS unsigned* st) {
    XcdBarrier b; b.bar = bar; b.x = xb_xcc_id(); b.st = st;
    if (threadIdx.x == 0) (void)xb_add(&bar[XB_XCNT(b.x)], 1u);
    return b;
}
__device__ __forceinline__ void xcd_barrier_complete(unsigned* bar, unsigned x, unsigned& nloc, unsigned& nx) {
    const unsigned G = gridDim.x * gridDim.y * gridDim.z;
    unsigned sum, cnt, mine, sp = 0u;
    for (;;) {
        sum = 0u; cnt = 0u; mine = 0u;
#pragma unroll
        for (unsigned j = 0; j < 16; ++j) { const unsigned c = xb_ld(&bar[XB_XCNT(j)]); sum += c; cnt += (c > 0u) ? 1u : 0u; mine = (j == x) ? c : mine; }
        if (sum == G) break;
        __builtin_amdgcn_s_sleep(1);
        if ((++sp & 255u) == 0u) { if (xb_ld(&bar[XB_TMO])) break; if (sp > XB_SPIN_CAP) { atomicAdd(&bar[XB_TMO], 1u); break; } }
    }
    nloc = mine > 0u ? mine : 1u; nx = cnt > 0u ? cnt : 1u;
}

__device__ __forceinline__ void xcd_barrier(const XcdBarrier& b) {
    asm volatile("s_waitcnt vmcnt(0)" ::: "memory");
    __syncthreads();
    if (threadIdx.x == 0) {
        unsigned* bar = b.bar;
        __builtin_amdgcn_s_waitcnt(0);
        unsigned nloc = b.st[0], nx = b.st[1];
        if (nloc == 0u) { xcd_barrier_complete(bar, b.x, nloc, nx); b.st[0] = nloc; b.st[1] = nx; }
        const unsigned old = xb_add(&bar[XB_XSUB(b.x)], 1u);
        const unsigned gen = old / nloc;
        if (old + 1u == (gen + 1u) * nloc) {
            __builtin_amdgcn_fence(__ATOMIC_RELEASE, "agent");
            asm volatile("s_waitcnt vmcnt(0)" ::: "memory");
            const unsigned og = xb_add(&bar[XB_TOP], 1u);
            const unsigned tg = og / nx;
            if (og + 1u == (tg + 1u) * nx) xb_add(&bar[XB_TOPGEN], 1u);
            else XB_SPIN(xb_ld(&bar[XB_TOPGEN]) == tg, bar);
            __builtin_amdgcn_fence(__ATOMIC_ACQUIRE, "agent");
            xb_add(&bar[XB_XGEN(b.x)], 1u);
            asm volatile("s_waitcnt vmcnt(0)" ::: "memory");
        } else {
            XB_SPIN(xb_ld(&bar[XB_XGEN(b.x)]) == gen, bar);
            __builtin_amdgcn_fence(__ATOMIC_ACQUIRE, "agent");
            asm volatile("s_waitcnt vmcnt(0)" ::: "memory");
        }
    }
    __syncthreads();
}

struct KArgs { const float* in[34]; float* out; unsigned char* ws; int ph_lo, ph_hi, coop, pad; int rep[8]; };

__global__ void __launch_bounds__(512, 2) fwd_kernel(KArgs a) {
    extern __shared__ __attribute__((aligned(16))) unsigned char lds_raw[];
    LAS unsigned char* lds = (LAS unsigned char*)lds_raw;
    cg::grid_group grid = cg::this_grid();
    const int tid0 = threadIdx.x, wave = __builtin_amdgcn_readfirstlane(tid0 >> 6);
    const int G = gridDim.x, bid = blockIdx.x, gw = bid * 8 + wave, NGW = G * 8;
    unsigned char* ws = a.ws; float* out = a.out;
    float* H = (float*)(ws + WS_H); bf16* XN = (bf16*)(ws + WS_XN);
    const float* rope = (const float*)(ws + WS_ROPE);
    const int lo = a.ph_lo, hi = a.ph_hi; const bool coop = a.coop != 0;
    volatile LAS unsigned* MISC = (volatile LAS unsigned*)(lds + LDS_MISC);
    if (tid0 == 0) { MISC[0] = 0u; MISC[1] = 0u; }
    __syncthreads();
    XcdBarrier xbar = xcd_barrier_post((unsigned*)(ws + WS_BAR), MISC);
    int pc = 0;
#define PH_BEGIN(cat) if (pc >= lo && pc < hi) { for (int rep_ = 0; rep_ < a.rep[cat]; ++rep_) { int tid = tid0; asm volatile("" : "+v"(tid)); const int lane = tid & 63; (void)lane;
#define PH_END   __syncthreads(); } if (coop && pc + 1 < hi) { if (a.coop == 2) grid.sync();     \
        xcd_barrier(xbar); if (a.rep[5] > 1) xcd_barrier(xbar); } } ++pc;

    PH_BEGIN(0)
    {
        LAS bf16* scr = (LAS bf16*)(lds + wave * 9216);
        for (int it = gw; ; it += NGW) {
            int r = it; bool did = false; const float* jW = nullptr; bf16* jWT = nullptr; int jK = 0, jN = 0, jld = 0, jrow = 0, jk0 = 0, jn0 = 0;
#define TRJOB(Wp, K_, N_, KP_, NP_, WTp, LDK_, ROWEXPR) if (!did) { const int nnb = (NP_) / 64, cnt = ((KP_) / 64) * nnb; \
                if (r < cnt) { const int kb = r / nnb, nb = r - kb * nnb, n0 = nb * 64; jW = (Wp); jK = (K_); jN = (N_); jWT = (WTp); jld = (LDK_); jrow = (ROWEXPR) + n0; jk0 = kb * 64; jn0 = n0; did = true; } else r -= cnt; }
            TRJOB(a.in[11], D, NRI, D, NRI, (bf16*)(ws + WS_RI0), D, 0)
            TRJOB(a.in[11] + (size_t)D * NRI, D, NRI, D, NRI, (bf16*)(ws + WS_RI1), D, 0)
            TRJOB(a.in[12], HV, D, HV, D, (bf16*)(ws + WS_RO0), HV, 0)
            TRJOB(a.in[12] + (size_t)HV * D, HV, D, HV, D, (bf16*)(ws + WS_RO1), HV, 0)
            TRJOB(a.in[14], D, D, D, D, (bf16*)(ws + WS_RW1), D, 0)
            TRJOB(a.in[14] + (size_t)D * D, D, D, D, D, (bf16*)(ws + WS_RW1), D, 1024)
            TRJOB(a.in[14] + (size_t)2 * D * D, D, D, D, D, (bf16*)(ws + WS_RW1), D, 2048)
            TRJOB(a.in[16], D, 64, D, 256, (bf16*)(ws + WS_RW1), D, 3072)
            TRJOB(a.in[19], D, 64, D, 256, (bf16*)(ws + WS_RW1), D, 3328)
            TRJOB(a.in[21], D, 160, D, 256, (bf16*)(ws + WS_RW1), D, 3584)
            TRJOB(a.in[17], 64, D, 256, D, (bf16*)(ws + WS_RW2), 256, 0)
            TRJOB(a.in[20], 64, D, 256, D, (bf16*)(ws + WS_RW2), 256, 1024)
            TRJOB(a.in[22], 160, D, 256, D, (bf16*)(ws + WS_RW2), 256, 2048)
            TRJOB(a.in[28], D, D, D, D, (bf16*)(ws + WS_RWO), D, 0)
            TRJOB(a.in[29], D, 3072, D, 3072, (bf16*)(ws + WS_CIN), D, cin_row(n0) - n0)
            TRJOB(a.in[31], D, D, D, D, (bf16*)(ws + WS_COUT), D, 0)
#pragma unroll 1
            for (int l = 0; l < 4; ++l) {
                TRJOB(a.in[32] + (size_t)l * D * FF, D, FF, D, FF, (bf16*)(ws + WS_M1 + (size_t)l * al((size_t)FF * D * 2)), D, 0)
                TRJOB(a.in[33] + (size_t)l * D * FF, FF, D, FF, D, (bf16*)(ws + WS_M2 + (size_t)l * al((size_t)FF * D * 2)), FF, 0)
            }
#undef TRJOB
            if (!did) break;
            tr_item(jW, jK, jN, jWT, jld, jrow, jk0, jn0, scr, lane);
        }
        for (int e = bid * 512 + tid; e < 2065 * 128; e += G * 512) {
            const int p = e >> 7, i = e & 127;
            const float x = (float)i / 127.0f;
            const float inv = 1.0f / (float)exp((double)x * 9.210340371976184);
            const float ang = (float)(p == TP ? 16384 : p) * inv;
            double rev = (double)ang * 0.15915494309189535; rev -= rint(rev);
            const float fr = (float)rev;
            ((f32x2*)(ws + WS_ROPE))[e] = (f32x2){__builtin_amdgcn_cosf(fr), __builtin_amdgcn_sinf(fr)};
        }
        for (int m = gw; m < M; m += NGW) {
            const float* src;
            if (m < MP) { const int b = m / TP, t = m - b * TP; src = t < 16 ? a.in[7] + (size_t)t * D : a.in[0] + ((size_t)b * 2048 + (t - 16)) * D; }
            else src = a.in[1] + (size_t)(m - MP) * D;
            const f32x4* xr = (const f32x4*)src + lane; f32x4* hr = (f32x4*)(H + (size_t)m * D) + lane;
#pragma unroll
            for (int j = 0; j < 4; ++j) hr[64 * j] = xr[64 * j];
            f32x4 v[4]; rms_row(src, a.in[8], lane, v); store_row_bf16(XN + (size_t)m * D, lane, v);
        }
    }
    PH_END

#pragma unroll 1
    for (int layer = 0; layer < 4; ++layer) {
        const int kind = layer % 3;
        const bf16* outA; const bf16* outB; int outK;
        if (kind == 0) {
            const int jr = layer / 3;
            bf16 *Qb = (bf16*)(ws + RB_Q), *Kb = (bf16*)(ws + RB_K), *KTD = (bf16*)(ws + RB_KTD), *VT = (bf16*)(ws + RB_VT), *SG = (bf16*)(ws + RB_SG), *OB = (bf16*)(ws + RB_OB), *Y = (bf16*)(ws + RB_Y);
            float* VS = (float*)(ws + RB_VS);
            outA = Y; outB = (const bf16*)(ws + (jr ? WS_RO1 : WS_RO0)); outK = HV;
            PH_BEGIN(4)
            {
                pg8::Gemm g{XN, (const bf16*)(ws + (jr ? WS_RI1 : WS_RI0)), M, NRI, D}; pg8::StaticOrder S; S.init(M, NRI, G, bid);
                EpiRetIn E{Qb, Kb, KTD, VT, SG, VS, rope};
                pg8::gemm_phase<EpiRetIn, pg8::StaticOrder, true, true>(lds, g, S, E);
            }
            PH_END
            PH_BEGIN(1)
            {
                const float* S0in = a.in[jr ? 6 : 2];
                float* Sp_out = out + (jr ? O_R3P : O_R0P); float* Ss_out = out + (jr ? O_R3S : O_R0S);
                const int l32 = lane & 31, hi = lane >> 5, w = wave;
                LAS bf16* P = (LAS bf16*)lds;
                LAS bf16* ST = (LAS bf16*)(lds + 34816);
                for (int item = bid; item < 256; item += G) {
                    const int b = item >> 5, h = (item >> 3) & 3, es = item & 7;
                    const float lg2 = __log2f(1.f - __builtin_amdgcn_exp2f(-(float)(5 + h)));
                    const unsigned char* qbytes = (const unsigned char*)(Qb + (size_t)(b * TP) * D + h * 256);
                    const unsigned char* kbytes = (const unsigned char*)(Kb + (size_t)(b * TP) * D + h * 256);
                    const bf16* ktd = KTD + (size_t)((b * 4 + h) * 256) * TP;
                    const bf16* vt = VT + (size_t)((b * 4 + h) * 512 + es * 64) * TP;
                    LAS unsigned char* QH = lds;
                    LAS unsigned char* KH = lds + 34816;
                    LAS unsigned char* STb = lds + 69632;
                    LAS unsigned char* VTs = lds + 103424;
                    f32x16 S2[2];
#pragma unroll
                    for (int i = 0; i < 16; ++i) { S2[0][i] = 0.f; S2[1][i] = 0.f; }
                    for (int i = tid; i < 33792 / 16; i += 512) *(LAS u32x4*)(STb + i * 16) = (u32x4){0u, 0u, 0u, 0u};
                    const u32x4 z4 = {0u, 0u, 0u, 0u};
                    u32x4 rq[4], rk[4], rv[2];
#define RET_T0(cc) ((cc) == 0 ? 0 : 16 + 128 * ((cc) - 1))
#define RET_L(cc)  ((cc) == 0 ? 16 : 128)
#define LOADQK(cc, dh) do { const int t0c_ = RET_T0(cc), Lc_ = RET_L(cc); _Pragma("unroll") for (int i_ = 0; i_ < 4; ++i_) { const int id_ = tidc + 512 * i_, row_ = id_ >> 4, c16_ = id_ & 15; const bool ok_ = row_ < Lc_; \
        const size_t off_ = (size_t)(t0c_ + (ok_ ? row_ : 0)) * 2048 + (dh) * 256 + c16_ * 16; rq[i_] = *(const u32x4*)(qbytes + off_); rk[i_] = *(const u32x4*)(kbytes + off_); if (!ok_) { rq[i_] = z4; rk[i_] = z4; } } } while (0)
#define STOREQK() do { _Pragma("unroll") for (int i_ = 0; i_ < 4; ++i_) { const int id_ = tidc + 512 * i_, row_ = id_ >> 4, c16_ = id_ & 15; *(LAS u32x4*)(QH + row_ * 272 + c16_ * 16) = rq[i_]; *(LAS u32x4*)(KH + row_ * 272 + c16_ * 16) = rk[i_]; } } while (0)
#define LOADV(cc) do { const int t0c_ = RET_T0(cc), Lc_ = RET_L(cc); _Pragma("unroll") for (int i_ = 0; i_ < 2; ++i_) { const int id_ = tidc + 512 * i_, row_ = id_ >> 4, c16_ = id_ & 15; const bool ok_ = c16_ * 8 < Lc_; \
        rv[i_] = *(const u32x4*)(vt + (size_t)row_ * TP + t0c_ + (ok_ ? c16_ * 8 : 0)); if (!ok_) rv[i_] = z4; } } while (0)
#define STOREV() do { _Pragma("unroll") for (int i_ = 0; i_ < 2; ++i_) { const int id_ = tidc + 512 * i_, row_ = id_ >> 4, c16_ = id_ & 15; *(LAS u32x4*)(VTs + row_ * 272 + c16_ * 16) = rv[i_]; } } while (0)
                    { const int tidc = tid; LOADQK(0, 0); LOADV(0); }
                    const int lt = w >> 1, ei = w & 1;
                    LAS float* SQ = (LAS float*)(lds + 120832);
                    const bool il = (item == bid);
                    const int nel = il ? 64 * ((bid < NS * 4 ? 1 : 0) + (bid + G < NS * 4 ? 1 : 0)) : 0;
                    int sn = 0; f32x4 sv = {0.f, 0.f, 0.f, 0.f}, o4 = {0.f, 0.f, 0.f, 0.f};
                    if (il) {
                        for (int it = 0; it * 64 < nel; ++it) { const int si = bid + it * G, ss_ = si >> 2, hh_ = si & 3;
                            SQ[it * 1024 + tid] = bf2f(((tid >> 8) ? Kb : Qb)[(size_t)(MP + ss_) * D + hh_ * 256 + (tid & 255)]);
                            SQ[it * 1024 + 512 + tid] = VS[(size_t)ss_ * HV + hh_ * 512 + tid]; }
                    }
#define RET_PROC(J, VAL) { const int j_ = (J), it_ = j_ >> 6, d_ = dg_ * 64 + (j_ & 63), si_ = bid + it_ * G; \
        LAS float* q_ = SQ + it_ * 1024; const float kd_ = q_[256 + d_], qd_ = q_[d_]; const f32x4 v_ = *(const LAS f32x4*)(q_ + 512 + e4_); \
        const float gam_ = 1.f - __builtin_amdgcn_exp2f(-(float)(5 + (si_ & 3))); \
        const f32x4 n_ = (VAL) * gam_ + v_ * kd_; __builtin_nontemporal_store(n_, (f32x4*)(Ss_out + ((size_t)si_ * 256 + d_) * 512 + e4_)); \
        o4 = o4 + n_ * qd_; \
        if ((j_ & 63) == 63) { const float r0_ = sum4(o4[0]), r1_ = sum4(o4[1]), r2_ = sum4(o4[2]), r3_ = sum4(o4[3]); \
            if (dg_ == 0) { u32x2 w_; w_.x = cvt_pk_bf16(r0_, r1_); w_.y = cvt_pk_bf16(r2_, r3_); *(u32x2*)(OB + (size_t)(MP + (si_ >> 2)) * HV + (si_ & 3) * 512 + e4_) = w_; } \
            o4 = (f32x4){0.f, 0.f, 0.f, 0.f}; } }
#define RET_SRC(J) ((const f32x4*)(S0in + ((size_t)(bid + ((J) >> 6) * G) * 256 + dg_ * 64 + ((J) & 63)) * 512 + e4_))
#define RET_SLOT() do { if (sn <= nel) { int tq_ = tid; asm volatile("" : "+v"(tq_)); const int dg_ = tq_ & 3, e4_ = (tq_ >> 2) * 4; \
        if (sn >= 1) RET_PROC(sn - 1, sv) \
        if (sn < nel) sv = __builtin_nontemporal_load(RET_SRC(sn)); \
        ++sn; } } while (0)
                    __syncthreads();
#pragma unroll 1
                    for (int c = 0; c < 17; ++c) {
                        const int t0 = RET_T0(c), L = RET_L(c);
                        int tl_ = tid; asm volatile("" : "+v"(tl_));
                        const int tidc = tl_, l32 = tidc & 31, hi = (tidc >> 5) & 1, lrow = 32 * lt + l32, erow = 32 * ei + l32;
                        const bool act = 32 * lt < L;
                        f32x16 accP[2], aX;
#pragma unroll
                        for (int i = 0; i < 16; ++i) { accP[0][i] = 0.f; accP[1][i] = 0.f; aX[i] = 0.f; }
#pragma unroll
                        for (int dh = 0; dh < 2; ++dh) {
                            STOREQK(); if (dh == 0) STOREV();
                            if (dh == 0) LOADQK(c, 1); else if (c < 16) { LOADQK(c + 1, 0); LOADV(c + 1); }
                            __syncthreads();
                            RET_SLOT();
                            if (act) {
                                const LAS unsigned char* qrow = QH + lrow * 272 + 16 * hi;
#pragma unroll
                                for (int j = 0; j < 2; ++j) { const int mt = 2 * (w & 1) + j;
                                    if (mt <= lt && 32 * mt < L) { const LAS unsigned char* krow = KH + (32 * mt + l32) * 272 + 16 * hi;
#pragma unroll 4
                                        for (int s = 0; s < 8; ++s) { const bf16x8 kf = *(const LAS bf16x8*)(krow + 32 * s), qf = *(const LAS bf16x8*)(qrow + 32 * s); accP[j] = MFMA32(kf, qf, accP[j]); } } }
                                const LAS unsigned char* srow = STb + erow * 528 + 256 * dh + 16 * hi;
#pragma unroll 4
                                for (int s = 0; s < 8; ++s) { const bf16x8 sf = *(const LAS bf16x8*)(srow + 32 * s), qf = *(const LAS bf16x8*)(qrow + 32 * s); aX = MFMA32(sf, qf, aX); }
                            }
                            __syncthreads();
                            RET_SLOT();
                        }
                        bf16x8 kc[8];
                        { const bf16* kp = ktd + (size_t)(32 * w + l32) * TP + t0 + 8 * hi; const int nkc = L >> 4;
#pragma unroll
                          for (int s = 0; s < 8; ++s) kc[s] = *(const bf16x8*)(kp + (s < nkc ? 16 * s : 0)); }
                        if (act) {
#pragma unroll
                            for (int j = 0; j < 2; ++j) { const int mt = 2 * (w & 1) + j;
                                if (mt <= lt && 32 * mt < L) {
#pragma unroll
                                    for (int gq = 0; gq < 4; ++gq) { float o[4];
#pragma unroll
                                        for (int i = 0; i < 4; ++i) { const int mm = 32 * mt + 8 * gq + 4 * hi + i; const int df = lrow - mm;
                                            o[i] = df >= 0 ? accP[j][gq * 4 + i] * __builtin_amdgcn_exp2f((float)df * lg2) : 0.f; }
                                        u32x2 wv; wv.x = cvt_pk_bf16(o[0], o[1]); wv.y = cvt_pk_bf16(o[2], o[3]);
                                        *(LAS u32x2*)(KH + lrow * 272 + (32 * mt + 8 * gq + 4 * hi) * 2) = wv; } } }
                        }
                        __syncthreads();
                        RET_SLOT();
                        if (act) {
                            f32x16 aI;
#pragma unroll
                            for (int i = 0; i < 16; ++i) aI[i] = 0.f;
                            const int nk = (32 * (lt + 1) < L ? 32 * (lt + 1) : L) >> 4;
#pragma unroll 2
                            for (int s = 0; s < nk; ++s) { const bf16x8 fa = *(const LAS bf16x8*)(VTs + erow * 272 + (16 * s + 8 * hi) * 2), fb = *(const LAS bf16x8*)(KH + lrow * 272 + (16 * s + 8 * hi) * 2); aI = MFMA32(fa, fb, aI); }
                            const float qd = __builtin_amdgcn_exp2f((float)(lrow + 1) * lg2);
                            if (lrow < L) {
                                bf16* op = OB + (size_t)(b * TP + t0 + lrow) * HV + h * 512 + es * 64 + 32 * ei + 4 * hi;
#pragma unroll
                                for (int gq = 0; gq < 4; ++gq) {
                                    u32x2 wv; wv.x = cvt_pk_bf16(aI[gq * 4 + 0] + qd * aX[gq * 4 + 0], aI[gq * 4 + 1] + qd * aX[gq * 4 + 1]);
                                    wv.y = cvt_pk_bf16(aI[gq * 4 + 2] + qd * aX[gq * 4 + 2], aI[gq * 4 + 3] + qd * aX[gq * 4 + 3]);
                                    *(u32x2*)(op + 8 * gq) = wv; }
                            }
                        }
                        {
                            const float gl = __builtin_amdgcn_exp2f((float)L * lg2);
                            S2[0] = S2[0] * gl; S2[1] = S2[1] * gl;
                            const int nkc = L >> 4;
#pragma unroll
                            for (int s = 0; s < 8; ++s) if (s < nkc) {
                                const bf16x8 fb0 = *(const LAS bf16x8*)(VTs + l32 * 272 + (16 * s + 8 * hi) * 2), fb1 = *(const LAS bf16x8*)(VTs + (32 + l32) * 272 + (16 * s + 8 * hi) * 2);
                                S2[0] = MFMA32(kc[s], fb0, S2[0]); S2[1] = MFMA32(kc[s], fb1, S2[1]); }
                        }
                        __syncthreads();
                        RET_SLOT();
                        if (c < 16) {
#pragma unroll
                            for (int e2 = 0; e2 < 2; ++e2)
#pragma unroll
                                for (int gq = 0; gq < 4; ++gq) {
                                    u32x2 wv; wv.x = cvt_pk_bf16(S2[e2][gq * 4 + 0], S2[e2][gq * 4 + 1]); wv.y = cvt_pk_bf16(S2[e2][gq * 4 + 2], S2[e2][gq * 4 + 3]);
                                    *(LAS u32x2*)(STb + (32 * e2 + l32) * 528 + (32 * w + 8 * gq + 4 * hi) * 2) = wv; }
                        }
                    }
#undef LOADQK
#undef STOREQK
#undef LOADV
#undef STOREV
                    if (sn <= nel && nel > 0) { int tq_ = tid; asm volatile("" : "+v"(tq_)); const int dg_ = tq_ & 3, e4_ = (tq_ >> 2) * 4;
                        if (sn >= 1) RET_PROC(sn - 1, sv)
#pragma unroll 1
                        for (int j0 = sn; j0 < nel; j0 += 8) { f32x4 bt[8];
#pragma unroll
                            for (int u_ = 0; u_ < 8; ++u_) { const int jj = j0 + u_ < nel ? j0 + u_ : nel - 1; bt[u_] = __builtin_nontemporal_load(RET_SRC(jj)); }
#pragma unroll
                            for (int u_ = 0; u_ < 8; ++u_) if (j0 + u_ < nel) RET_PROC(j0 + u_, bt[u_])
                        }
                        sn = nel + 1;
                    }
#undef RET_PROC
#undef RET_SRC
#undef RET_SLOT
                    {
                        float* sp = Sp_out + (size_t)((b * 4 + h) * 256) * 512 + es * 64 + l32;
#pragma unroll
                        for (int e2 = 0; e2 < 2; ++e2)
#pragma unroll
                            for (int r = 0; r < 16; ++r) sp[(size_t)(32 * w + crow(r, hi)) * 512 + 32 * e2] = S2[e2][r];
                    }
                    __syncthreads();
                }
                {
                    LAS float* qk = (LAS float*)(lds + 69632);
                    LAS float* ored = (LAS float*)(lds + 69632 + 2048);
                    for (int item = bid + (bid < 256 ? 2 * G : 0); item < NS * 4; item += G) {
                        const int s = item >> 2, h = item & 3;
                        const float gamma = 1.f - __builtin_amdgcn_exp2f(-(float)(5 + h));
                        __syncthreads();
                        { const int which = tid >> 8, dd = tid & 255; qk[tid] = bf2f((which ? Kb : Qb)[(size_t)(MP + s) * D + h * 256 + dd]); }
                        __syncthreads();
                        const int e4 = (tid & 127) * 4, dg = tid >> 7;
                        const f32x4 v4 = *(const f32x4*)(VS + (size_t)s * HV + h * 512 + e4);
                        const float* sin_ = S0in + (size_t)(s * 4 + h) * 256 * 512 + e4; float* sout = Ss_out + (size_t)(s * 4 + h) * 256 * 512 + e4;
                        f32x4 o4 = {0.f, 0.f, 0.f, 0.f};
#pragma unroll 16
                        for (int i = 0; i < 64; ++i) { const int d = dg * 64 + i;
                            const f32x4 sv = __builtin_nontemporal_load((const f32x4*)(sin_ + (size_t)d * 512));
                            const f32x4 sn = sv * gamma + v4 * qk[256 + d];
                            __builtin_nontemporal_store(sn, (f32x4*)(sout + (size_t)d * 512));
                            o4 = o4 + sn * qk[d]; }
                        *(LAS f32x4*)(ored + dg * 512 + e4) = o4;
                        __syncthreads();
                        if (tid < 128) { const f32x4 r = *(LAS f32x4*)(ored + e4) + *(LAS f32x4*)(ored + 512 + e4) + *(LAS f32x4*)(ored + 1024 + e4) + *(LAS f32x4*)(ored + 1536 + e4);
                            u32x2 wv; wv.x = cvt_pk_bf16(r[0], r[1]); wv.y = cvt_pk_bf16(r[2], r[3]);
                            *(u32x2*)(OB + (size_t)(MP + s) * HV + h * 512 + e4) = wv; }
                    }
                }
            }
            PH_END
            PH_BEGIN(3)
            {
                for (int m = gw; m < M; m += 2 * NGW) {
                    const int m1 = (m + NGW < M) ? m + NGW : m;
                    u32x4 ov[2][4]; float ss[2] = {0.f, 0.f};
#pragma unroll
                    for (int q = 0; q < 2; ++q) { const u32x4* op = (const u32x4*)(OB + (size_t)(q ? m1 : m) * HV) + lane * 4;
#pragma unroll
                        for (int j = 0; j < 4; ++j) ov[q][j] = op[j]; }
#pragma unroll
                    for (int q = 0; q < 2; ++q) {
#pragma unroll
                        for (int j = 0; j < 4; ++j)
#pragma unroll
                            for (int i = 0; i < 4; ++i) { const float x0 = __uint_as_float(ov[q][j][i] << 16), x1 = __uint_as_float(ov[q][j][i] & 0xffff0000u); ss[q] += x0 * x0 + x1 * x1; }
                        ss[q] = sum16(ss[q]); }
#pragma unroll
                    for (int q = 0; q < 2; ++q) { if (q == 1 && m1 == m) break;
                        const int mr = q ? m1 : m; const float rs = 1.0f / sqrtf(ss[q] * (1.f / 512.f) + EPS);
                        const u32x4* gp = (const u32x4*)(SG + (size_t)mr * HV) + lane * 4; u32x4* yp = (u32x4*)(Y + (size_t)mr * HV) + lane * 4;
#pragma unroll
                        for (int j = 0; j < 4; ++j) { const u32x4 gv = gp[j]; u32x4 wv;
#pragma unroll
                            for (int i = 0; i < 4; ++i) { const float x0 = __uint_as_float(ov[q][j][i] << 16), x1 = __uint_as_float(ov[q][j][i] & 0xffff0000u);
                                const float g0 = __uint_as_float(gv[i] << 16), g1 = __uint_as_float(gv[i] & 0xffff0000u);
                                wv[i] = cvt_pk_bf16(x0 * rs * g0, x1 * rs * g1); }
                            yp[j] = wv; } }
                }
            }
            PH_END
        } else if (kind == 1) {
            bf16* XM = (bf16*)(ws + WB_XM); float* RKV = (float*)(ws + WB_RKV); bf16* L1 = (bf16*)(ws + WB_L1); float* DAG = (float*)(ws + WB_DAG);
            float* YR = (float*)(ws + WB_YR); bf16* Y = (bf16*)(ws + WB_Y);
            outA = Y; outB = (const bf16*)(ws + WS_RWO); outK = D;
            PH_BEGIN(4)
            {
                pg8::Gemm g{XM, (const bf16*)(ws + WS_RW1), 6 * M, 3840, D}; StackOrder S; S.base.init(M, 3840, G, bid); S.mode = 1;
                EpiRw1 E{RKV, L1};
                pg8::gemm_phase<EpiRw1, StackOrder, true, true>(lds, g, S, E);
            }
            PH_END
            PH_BEGIN(4)
            {
                int K2 = 256; asm volatile("" : "+s"(K2));
                pg8::Gemm g{L1, (const bf16*)(ws + WS_RW2), 3 * M, 3072, K2}; StackOrder S; S.base.init(M, 3072, G, bid); S.mode = 2;
                EpiRw2 E{DAG, a.in[15], a.in[18]};
                pg8::gemm_phase<EpiRw2, StackOrder, true, true>(lds, g, S, E);
            }
            PH_END
            PH_BEGIN(2)
            {
                const float *Rr = RKV, *Kr = RKV + (size_t)M * D, *Vr = RKV + (size_t)2 * M * D, *DEC = DAG, *AAp = DAG + (size_t)M * D;
                const float *k_k = a.in[23], *k_a = a.in[24]; float* RKb = (float*)(ws + WB_L1);
                LAS float* ob = (LAS float*)lds;
                const int pair = (tid >> 4) & 15, p = tid & 15; const bool cw = tid < 256;
                const int st_ld = tid >> 5, kq = tid & 31;
                for (int item = bid; item < 2 * NB * 32; item += G) {
                    const int seq = item >> 5, h = (item >> 1) & 15, half = item & 1;
                    const bool indep = seq >= NB; const int s0 = (seq - NB) * 16;
                    const int T = indep ? 16 : TP; const int rowbase = indep ? MP + s0 : seq * TP;
                    const int vrow = half * 32 + 2 * pair, ch = h * 64;
                    f32x4 Sa = (f32x4){0.f, 0.f, 0.f, 0.f}, Sb = Sa;
                    const float* sin_ = a.in[4] + (size_t)(s0 * 16 + h) * 4096 + vrow * 64 + 4 * p; float* sout_ = out + O_WKS + (size_t)(s0 * 16 + h) * 4096 + vrow * 64 + 4 * p;
                    const f32x2 rk2 = *(const f32x2*)(a.in[25] + ch + 2 * kq);
                    const f32x2 kk2 = *(const f32x2*)(k_k + ch + 2 * kq), ka2 = *(const f32x2*)(k_a + ch + 2 * kq);
                    f32x2 lr, lk, lv, ld, la;
                    { const int t = st_ld; const bool ok = t < T; const size_t off = (size_t)(rowbase + (ok ? t : 0)) * D + ch + 2 * kq;
                      lr = *(const f32x2*)(Rr + off); lk = *(const f32x2*)(Kr + off); lv = *(const f32x2*)(Vr + off); ld = *(const f32x2*)(DEC + off); la = *(const f32x2*)(AAp + off); }
                    const int nch = (T + 15) >> 4;
                    __syncthreads();
#pragma unroll 1
                    for (int cidx = 0; cidx < nch; ++cidx) {
                        LAS float* B = ob + (cidx & 1) * 6144;
                        {
                            f32x2 kkv = lk * kk2; float ssq = kkv.x * kkv.x + kkv.y * kkv.y;
                            ssq = sum16(ssq); { const int si = __builtin_bit_cast(int, ssq); ssq += __builtin_bit_cast(float, __builtin_amdgcn_ds_swizzle(si, 0x401F)); }
                            const float nrm = fmaxf(sqrtf(ssq), 1e-12f); kkv = kkv * (1.f / nrm);
                            const f32x2 km = lk * (1.f + (la - 1.f) * ka2), kav = kkv * la;
                            { float rkp = lr.x * km.x * rk2.x + lr.y * km.y * rk2.y; rkp = sum16(rkp); { const int si = __builtin_bit_cast(int, rkp); rkp += __builtin_bit_cast(float, __builtin_amdgcn_ds_swizzle(si, 0x401F)); }
                              const int tt = cidx * 16 + st_ld; if (kq == 0 && half == 0 && tt < T) RKb[(size_t)(rowbase + tt) * 16 + h] = rkp; }
                            const int o = st_ld * 64 + 2 * kq;
                            *(LAS f32x2*)(B + o) = ld; *(LAS f32x2*)(B + 1024 + o) = kkv; *(LAS f32x2*)(B + 2048 + o) = kav; *(LAS f32x2*)(B + 3072 + o) = km; *(LAS f32x2*)(B + 4096 + o) = lr; *(LAS f32x2*)(B + 5120 + o) = lv;
                        }
                        if (cidx + 1 < nch) { const int t = (cidx + 1) * 16 + st_ld; const bool ok = t < T; const size_t off = (size_t)(rowbase + (ok ? t : 0)) * D + ch + 2 * kq;
                            lr = *(const f32x2*)(Rr + off); lk = *(const f32x2*)(Kr + off); lv = *(const f32x2*)(Vr + off); ld = *(const f32x2*)(DEC + off); la = *(const f32x2*)(AAp + off); }
                        __syncthreads();
                        const int t0 = cidx * 16;
                        f32x2 ykeep = {0.f, 0.f}; f32x4 nSa = Sa, nSb = Sb;
#define SCAN_STEP(st, IND) { if (IND) { Sa = nSa; Sb = nSb; const int sn_ = (st) < 15 ? (st) + 1 : 15; nSa = *(const f32x4*)(sin_ + (size_t)sn_ * 65536); nSb = *(const f32x4*)(sin_ + (size_t)sn_ * 65536 + 64); }     \
                            const LAS float* bs = B + (st) * 64 + 4 * p; \
                            const f32x4 w4 = *(const LAS f32x4*)bs, kk4 = *(const LAS f32x4*)(bs + 1024), ka4 = *(const LAS f32x4*)(bs + 2048), km4 = *(const LAS f32x4*)(bs + 3072), r4 = *(const LAS f32x4*)(bs + 4096); \
                            const f32x2 vv = *(const LAS f32x2*)(B + 5120 + (st) * 64 + vrow); \
                            float sa0 = (Sa.x * kk4.x + Sa.y * kk4.y) + (Sa.z * kk4.z + Sa.w * kk4.w), sa1 = (Sb.x * kk4.x + Sb.y * kk4.y) + (Sb.z * kk4.z + Sb.w * kk4.w); \
                            sa0 = -sum16(sa0); sa1 = -sum16(sa1); \
                            Sa = Sa * w4 + ka4 * sa0 + km4 * vv.x; Sb = Sb * w4 + ka4 * sa1 + km4 * vv.y; \
                            float y0 = (Sa.x * r4.x + Sa.y * r4.y) + (Sa.z * r4.z + Sa.w * r4.w), y1 = (Sb.x * r4.x + Sb.y * r4.y) + (Sb.z * r4.z + Sb.w * r4.w); \
                            y0 = sum16(y0); y1 = sum16(y1); \
                            if (p == (st)) { ykeep.x = y0; ykeep.y = y1; } \
                            if (IND) { *(f32x4*)(sout_ + (size_t)(st) * 65536) = Sa; *(f32x4*)(sout_ + (size_t)(st) * 65536 + 64) = Sb; } }
                        if (cw) {
                            if (!indep) {
#pragma unroll
                                for (int st = 0; st < 16; ++st) SCAN_STEP(st, false)
                            } else {
                                nSa = *(const f32x4*)sin_; nSb = *(const f32x4*)(sin_ + 64);
#pragma unroll 1
                                for (int st = 0; st < 16; ++st) SCAN_STEP(st, true)
                            }
                            *(f32x2*)(YR + (size_t)(rowbase + t0 + p) * D + ch + vrow) = ykeep;
                        }
#undef SCAN_STEP
                    }
                    if (!indep && cw) { float* so = out + O_WKP + (size_t)(seq * 16 + h) * 4096 + vrow * 64 + 4 * p; *(f32x4*)so = Sa; *(f32x4*)(so + 64) = Sb; }
                    __syncthreads();
                }
            }
            PH_END
            PH_BEGIN(3)
            {
                const float *Vr = RKV + (size_t)2 * M * D; const bf16* GB = (const bf16*)(DAG + (size_t)2 * M * D); const float* RKb = (const float*)(ws + WB_L1);
                const float *ln_g = a.in[26], *ln_b = a.in[27];
                for (int m = gw; m < M; m += NGW) {
                    const size_t off = (size_t)m * D + lane * 16; const int c0 = lane * 16;
                    f32x4 y[4]; float s1 = 0.f;
                    const float rk = RKb[(size_t)m * 16 + (lane >> 2)];
                    const u32x4 g0 = *(const u32x4*)(GB + off), g1 = *(const u32x4*)(GB + off + 8);
#pragma unroll
                    for (int j = 0; j < 4; ++j) { y[j] = *(const f32x4*)(YR + off + 4 * j); s1 += (y[j].x + y[j].y) + (y[j].z + y[j].w); }
                    s1 = sum4(s1);
                    const float mu = s1 * (1.f / 64.f); float s2 = 0.f;
#pragma unroll
                    for (int j = 0; j < 4; ++j) { const f32x4 d = y[j] - mu; s2 += (d.x * d.x + d.y * d.y) + (d.z * d.z + d.w * d.w); }
                    s2 = sum4(s2);
                    const float rstd = 1.0f / sqrtf(s2 * (1.f / 64.f) + 64e-5f);
                    u32x4 w0, w1;
#pragma unroll
                    for (int j = 0; j < 4; ++j) { const f32x4 lg = *(const f32x4*)(ln_g + c0 + 4 * j), lb = *(const f32x4*)(ln_b + c0 + 4 * j), v = *(const f32x4*)(Vr + off + 4 * j);
                        const unsigned ga = j == 0 ? g0.x : (j == 1 ? g0.z : (j == 2 ? g1.x : g1.z)), gb = j == 0 ? g0.y : (j == 1 ? g0.w : (j == 2 ? g1.y : g1.w));
                        const f32x4 g = {__uint_as_float(ga << 16), __uint_as_float(ga & 0xffff0000u), __uint_as_float(gb << 16), __uint_as_float(gb & 0xffff0000u)};
                        const f32x4 o = ((y[j] - mu) * rstd * lg + lb + v * rk) * g;
                        const unsigned a0 = cvt_pk_bf16(o[0], o[1]), a1 = cvt_pk_bf16(o[2], o[3]);
                        if (j == 0) { w0.x = a0; w0.y = a1; } else if (j == 1) { w0.z = a0; w0.w = a1; } else if (j == 2) { w1.x = a0; w1.y = a1; } else { w1.z = a0; w1.w = a1; } }
                    u32x4* yp = (u32x4*)(Y + off); yp[0] = w0; yp[1] = w1;
                }
            }
            PH_END
        } else {
            bf16* BC = (bf16*)(ws + CB_BC); float* U = (float*)(ws + CB_U); bf16* A2 = (bf16*)(ws + CB_A2);
            outA = A2; outB = (const bf16*)(ws + WS_COUT); outK = D;
            PH_BEGIN(4)
            {
                pg8::Gemm g{XN, (const bf16*)(ws + WS_CIN), M, 3072, D}; pg8::StaticOrder S; S.init(M, 3072, G, bid);
                EpiConvIn E{BC, U};
                pg8::gemm_phase<EpiConvIn, pg8::StaticOrder, true, true>(lds, g, S, E);
            }
            PH_END
            PH_BEGIN(3)
            {
                const float* cw = a.in[30]; const float* cst = a.in[5];
                for (size_t e = (size_t)bid * 512 + tid; e < (size_t)M * 256; e += (size_t)G * 512) {
                    const int m = (int)(e >> 8), c = (int)(e & 255) * 4;
                    const f32x4 w0 = *(const f32x4*)(cw + c), w1 = *(const f32x4*)(cw + D + c), w2 = *(const f32x4*)(cw + 2 * D + c);
                    const f32x4 u2 = *(const f32x4*)(U + (size_t)m * D + c); f32x4 u1, u0;
                    if (m < MP) { const int b = m / TP, t = m - b * TP;
                        u1 = t >= 1 ? *(const f32x4*)(U + (size_t)(m - 1) * D + c) : (f32x4){0.f, 0.f, 0.f, 0.f};
                        u0 = t >= 2 ? *(const f32x4*)(U + (size_t)(m - 2) * D + c) : (f32x4){0.f, 0.f, 0.f, 0.f};
                        if (t >= TP - 2) *(f32x4*)(out + O_CVP + ((size_t)b * 2 + (t - (TP - 2))) * D + c) = u2;
                    } else { const int s = m - MP;
                        u0 = *(const f32x4*)(cst + ((size_t)s * 2) * D + c); u1 = *(const f32x4*)(cst + ((size_t)s * 2 + 1) * D + c);
                        *(f32x4*)(out + O_CVS + ((size_t)s * 2) * D + c) = u1; *(f32x4*)(out + O_CVS + ((size_t)s * 2 + 1) * D + c) = u2; }
                    const f32x4 yv = w0 * u0 + w1 * u1 + w2 * u2;
                    const u32x2 bb = *(const u32x2*)(BC + (size_t)m * D + c);
                    const float b0 = __uint_as_float(bb.x << 16), b1 = __uint_as_float(bb.x & 0xffff0000u), b2 = __uint_as_float(bb.y << 16), b3 = __uint_as_float(bb.y & 0xffff0000u);
                    u32x2 wv; wv.x = cvt_pk_bf16(b0 * yv[0], b1 * yv[1]); wv.y = cvt_pk_bf16(b2 * yv[2], b3 * yv[3]);
                    *(u32x2*)(A2 + (size_t)m * D + c) = wv;
                }
            }
            PH_END
        }
        PH_BEGIN(7)
        {
            pg8::Gemm g{outA, outB, M, D, outK}; TailOrder S; S.init(D, outK, G, bid);
            EpiResid E{H, (rep_ & 1) ? -1.f : 1.f};
            pg8::gemm_phase<EpiResid, TailOrder, true, true>(lds, g, S, E);
        }
        PH_END
        PH_BEGIN(3)
        {
            const float* gain = a.in[9] + (size_t)layer * D;
            for (int m = gw; m < M; m += 2 * NGW) { const int m1 = m + NGW; const bool has1 = m1 < M; f32x4 v0[4], v1[4]; rms_row2(H + (size_t)m * D, H + (size_t)(has1 ? m1 : m) * D, gain, lane, v0, v1); store_row_bf16(XN + (size_t)m * D, lane, v0); if (has1) store_row_bf16(XN + (size_t)m1 * D, lane, v1); }
        }
        PH_END
        bf16* ACT = (bf16*)(ws + MB_ACT);
        PH_BEGIN(4)
        {
            pg8::Gemm g{XN, (const bf16*)(ws + WS_M1 + (size_t)layer * al((size_t)FF * D * 2)), M, FF, D}; pg8::StaticOrder S; S.init(M, FF, G, bid);
            EpiRelu2 E{ACT};
            pg8::gemm_phase<EpiRelu2, pg8::StaticOrder, true, true>(lds, g, S, E);
        }
        PH_END
        PH_BEGIN(7)
        {
            pg8::Gemm g{ACT, (const bf16*)(ws + WS_M2 + (size_t)layer * al((size_t)FF * D * 2)), M, D, FF}; TailOrder S; S.init(D, FF, G, bid);
            EpiResid E{H, (rep_ & 1) ? -1.f : 1.f};
            pg8::gemm_phase<EpiResid, TailOrder, true, true>(lds, g, S, E);
        }
        PH_END
        PH_BEGIN(3)
        {
            if (layer == 3) {
                for (int m = gw; m < M; m += NGW) {
                    float* dst;
                    if (m < MP) { const int b = m / TP, t = m - b * TP; if (t < 16) continue; dst = out + O_YP + ((size_t)b * 2048 + (t - 16)) * D; }
                    else dst = out + O_YS + (size_t)(m - MP) * D;
                    f32x4 v[4]; rms_row(H + (size_t)m * D, a.in[10], lane, v);
                    f32x4* o = (f32x4*)dst + lane;
#pragma unroll
                    for (int j = 0; j < 4; ++j) o[64 * j] = v[j];
                }
            } else if ((layer + 1) % 3 == 1) {
                const float* gain = a.in[8] + (size_t)(layer + 1) * D; const float* mix = a.in[13];
                bf16* XM = (bf16*)(ws + WB_XM);
                f32x4 mrow[6][4];
#pragma unroll
                for (int q = 0; q < 6; ++q)
#pragma unroll
                    for (int j = 0; j < 4; ++j) mrow[q][j] = ((const f32x4*)(mix + (size_t)q * D) + lane)[64 * j];
                for (int m = gw; m < M; m += NGW) {
                    f32x4 xn[4], xp[4];
                    rms_row(H + (size_t)m * D, gain, lane, xn);
                    int b = 0, t = 0;
                    if (m < MP) { b = m / TP; t = m - b * TP;
                        if (t > 0) rms_row(H + (size_t)(m - 1) * D, gain, lane, xp);
                        else {
#pragma unroll
                            for (int j = 0; j < 4; ++j) xp[j] = (f32x4){0.f, 0.f, 0.f, 0.f}; }
                        if (t == TP - 1) { f32x4* o = (f32x4*)(out + O_SHP + (size_t)b * D) + lane;
#pragma unroll
                            for (int j = 0; j < 4; ++j) o[64 * j] = xn[j]; }
                    } else { const int s = m - MP; const f32x4* sp = (const f32x4*)(a.in[3] + (size_t)s * D) + lane; f32x4* o = (f32x4*)(out + O_SHS + (size_t)s * D) + lane;
#pragma unroll
                        for (int j = 0; j < 4; ++j) { xp[j] = sp[64 * j]; o[64 * j] = xn[j]; } }
#pragma unroll
                    for (int j = 0; j < 4; ++j) xp[j] = xp[j] - xn[j];
#pragma unroll
                    for (int q = 0; q < 6; ++q) { f32x4 v[4];
#pragma unroll
                        for (int j = 0; j < 4; ++j) v[j] = xn[j] + xp[j] * mrow[q][j];
                        store_row_bf16(XM + ((size_t)q * M + m) * D, lane, v); }
                }
            } else {
                const float* gain = a.in[8] + (size_t)(layer + 1) * D;
                for (int m = gw; m < M; m += 2 * NGW) { const int m1 = m + NGW; const bool has1 = m1 < M; f32x4 v0[4], v1[4]; rms_row2(H + (size_t)m * D, H + (size_t)(has1 ? m1 : m) * D, gain, lane, v0, v1); store_row_bf16(XN + (size_t)m * D, lane, v0); if (has1) store_row_bf16(XN + (size_t)m1 * D, lane, v1); }
            }
        }
        PH_END
    }
#undef PH_BEGIN
#undef PH_END
}

constexpr int N_PHASES = 33;

#ifndef REP0
#define REP0 1
#define REP1 1
#define REP2 1
#define REP3 1
#define REP4 1
#endif
#ifndef REP5
#define REP5 1
#endif
#ifndef REP7
#define REP7 1
#endif
#ifndef MK_MULTI
#define MK_MULTI 0
#endif

extern "C" void kernel_launch(void* const* d_in, const int* in_sizes, int n_in, void* d_out, int out_size, void* d_ws, size_t ws_size, hipStream_t stream) {
    static int grid = 0;
    if (grid == 0) {
        if (n_in != 34 || (size_t)out_size != O_END || ws_size < WS_TOTAL) { fprintf(stderr, "kernel_launch: unexpected shapes: n_in %d out %d ws %zu (need %zu)\n", n_in, out_size, ws_size, (size_t)WS_TOTAL); grid = -1; return; }
        int dev = 0, cus = 0, per_cu = 0;
        hipGetDevice(&dev); hipDeviceGetAttribute(&cus, hipDeviceAttributeMultiprocessorCount, dev);
        if (hipFuncSetAttribute((const void*)fwd_kernel, hipFuncAttributeMaxDynamicSharedMemorySize, LDS_BYTES) != hipSuccess) { fprintf(stderr, "kernel_launch: hipFuncSetAttribute failed\n"); grid = -1; return; }
        if (hipOccupancyMaxActiveBlocksPerMultiprocessor(&per_cu, (const void*)fwd_kernel, 512, LDS_BYTES) != hipSuccess || per_cu < 1) { fprintf(stderr, "kernel_launch: occupancy query says %d\n", per_cu); (void)hipGetLastError(); grid = -1; return; }
        grid = cus * 1;
    }
    if (grid < 0) return;
    if (hipMemsetAsync((char*)d_ws + WS_BAR, 0, 16384, stream) != hipSuccess) { fprintf(stderr, "kernel_launch: memset failed\n"); return; }
    KArgs a{};
    for (int i = 0; i < 34; ++i) a.in[i] = (const float*)d_in[i];
    a.out = (float*)d_out; a.ws = (unsigned char*)d_ws;
    { const int reps[8] = {REP0, REP1, REP2, REP3, REP4, REP5, 1, REP7}; for (int i = 0; i < 8; ++i) a.rep[i] = reps[i]; }
#if MK_MULTI
    for (int p = 0; p < N_PHASES; ++p) { a.ph_lo = p; a.ph_hi = p + 1; a.coop = 0; hipLaunchKernelGGL(fwd_kernel, dim3(grid), dim3(512), LDS_BYTES, stream, a); }
#else
    a.ph_lo = 0; a.ph_hi = N_PHASES; a.coop = 1;
    void* args[] = {&a};
    hipError_t e = hipLaunchCooperativeKernel((const void*)fwd_kernel, dim3(grid), dim3(512), args, LDS_BYTES, stream);
    if (e != hipSuccess) fprintf(stderr, "cooperative launch failed: %s (grid %d)\n", hipGetErrorString(e), grid);
#endif
}
```

```cpp
#include <hip/hip_runtime.h>
#include <hip/hip_cooperative_groups.h>
#include <cstdio>
#include <cstdint>
namespace cg = cooperative_groups;
namespace pg8 {
#define PG8_LAS __attribute__((address_space(3)))
typedef unsigned short bf16_t;
typedef short bf16x8 __attribute__((ext_vector_type(8)));
typedef float f32x4 __attribute__((ext_vector_type(4)));
typedef unsigned u32x4 __attribute__((ext_vector_type(4)));
constexpr int BM = 256, BK = 64, HALF = 128, HTB = HALF * BK * 2  , STAGE_BYTES = 8 * HTB, NXCD = 8, WGM = 8;

__host__ __device__ __forceinline__ int lds_byte(int r, int c) { const int st = (r >> 4) * 2 + (c >> 5), rr = r & 15, cc = c & 31, ob = rr * 64 + cc * 2; return st * 1024 + (ob ^ (((ob >> 9) & 1) << 5)); }
__host__ __device__ __forceinline__ void stage_rc(int b, int& R, int& C) { const int st = b / 1024, sb = b % 1024, swz = sb ^ (((sb >> 9) & 1) << 5); R = (st >> 1) * 16 + swz / 64; C = (st & 1) * 32 + (swz % 64) / 2; }
__host__ __device__ __forceinline__ int perm32(int rho) { const int n = rho >> 4, i = rho & 15; return 8 * (i >> 2) + 4 * n + (i & 3); }

struct Unit { int pm, pn, k0, nt; };
struct Gemm { const bf16_t* A; const bf16_t* Bt; int M, N, K; };

struct StaticOrder {
    int nM, nN, nwg, G, c;
    __host__ __device__ void init(int M, int N, int G_, int c_) { nM = M / BM; nN = N / BM; nwg = nM * nN; G = G_; c = c_; }
    __host__ __device__ __forceinline__ bool next(int i, Unit& u) const {
        const long L = (long)i * G + c; if (L >= nwg) return false;
        int wgid = (int)L; { const int q = nwg / NXCD, r = nwg % NXCD, xcd = wgid % NXCD, off = wgid / NXCD; wgid = (xcd < r ? xcd * (q + 1) : r * (q + 1) + (xcd - r) * q) + off; }
        const int nig = WGM * nN, gid = wgid / nig, fm = gid * WGM, gsz = (nM - fm) < WGM ? (nM - fm) : WGM;
        u.pm = fm + ((wgid % nig) % gsz); u.pn = (wgid % nig) / gsz; u.k0 = 0; u.nt = 0; return true;
    }
    __device__ __forceinline__ void a_ready(const Unit&) const {}
    __device__ __forceinline__ void done(const Unit&) const {}
};

__device__ __forceinline__ unsigned cvt_pk_bf16(float lo, float hi) { unsigned r; asm volatile("v_cvt_pk_bf16_f32 %0, %1, %2" : "=v"(r) : "v"(lo), "v"(hi)); return r; }
template <class Epi, class Sched, bool ALIGN_EPI = false, bool SP2 = false>
__device__ __forceinline__ void gemm_phase(PG8_LAS unsigned char* lds, const Gemm g, const Sched& S, const Epi& E) {
    int tid_ = threadIdx.x; asm volatile("" : "+v"(tid_));
    const int tid = tid_, wid = __builtin_amdgcn_readfirstlane(tid >> 6), lane = tid & 63, wr = wid >> 2, wc = wid & 3, fr = lane & 15, fq = lane >> 4;
    const int K = g.K, nt = K / BK;
    unsigned voffA[2], voffB[2];
#pragma unroll
    for (int i = 0; i < 2; ++i) { int R, C; stage_rc(tid * 16 + i * 8192, R, C); const int Rb = Epi::PERM ? ((R & ~31) + perm32(R & 31)) : R;
        voffA[i] = (unsigned)(R * K + C) * 2u; voffB[i] = (unsigned)(Rb * K + C) * 2u; }
    const size_t kstep = (size_t)(BK * 2);
    const size_t hstep = (size_t)HALF * K * 2;
    const size_t tstep = 2 * hstep;
    const unsigned ldsw = (unsigned)wid * 1024u;
    const int aoff = lds_byte(wr * 64 + fr, fq * 8), boff = lds_byte(wc * 32 + fr, fq * 8);
#define PG8_SA(b, h) (((b) * 2 + (h)) * HTB)
#define PG8_SB(b, h) ((4 + (b) * 2 + (h)) * HTB)
#define PG8_STAGE(bufoff, gbase, voff) do { _Pragma("unroll") for (int _i = 0; _i < 2; ++_i) \
        __builtin_amdgcn_global_load_lds((const unsigned*)((const char*)(gbase) + (voff)[_i]), (PG8_LAS unsigned*)(lds + (bufoff) + ldsw + _i * 8192), 16, 0, 0); } while (0)
#define PG8_LDA(dst, b, h) do { _Pragma("unroll") for (int m = 0; m < 4; ++m) _Pragma("unroll") for (int k = 0; k < 2; ++k) dst[m][k] = *(const PG8_LAS bf16x8*)(lds + PG8_SA(b, h) + aoff + m * 2048 + k * 1024); } while (0)
#define PG8_LDB(dst, b, h) do { _Pragma("unroll") for (int n = 0; n < 2; ++n) _Pragma("unroll") for (int k = 0; k < 2; ++k) dst[n][k] = *(const PG8_LAS bf16x8*)(lds + PG8_SB(b, h) + boff + n * 2048 + k * 1024); } while (0)
#define PG8_MMA(ai, bj, At, Bt) do { __builtin_amdgcn_s_setprio(1); _Pragma("unroll") for (int m = 0; m < 4; ++m) _Pragma("unroll") for (int n = 0; n < 2; ++n) _Pragma("unroll") for (int k = 0; k < 2; ++k) \
        acc[ai][bj][m][n] = __builtin_amdgcn_mfma_f32_16x16x32_bf16(Bt[n][k], At[m][k], acc[ai][bj][m][n], 0, 0, 0); __builtin_amdgcn_s_setprio(0); } while (0)
#define PG8_WAIT_V(n) asm volatile("s_waitcnt vmcnt(" #n ")" ::: "memory")
#define PG8_WAIT_L(n) asm volatile("s_waitcnt lgkmcnt(" #n ")" ::: "memory")
#define PG8_BAR __builtin_amdgcn_s_barrier()
#define PG8_SCHED __builtin_amdgcn_sched_barrier(0)
    Unit cur, nxt; int ui = 0;
    if (!S.next(0, cur)) return;
    f32x4 acc[2][2][4][2];
#pragma unroll
    for (int a = 0; a < 2; ++a)
#pragma unroll
        for (int b = 0; b < 2; ++b)
#pragma unroll
            for (int m = 0; m < 4; ++m)
#pragma unroll
                for (int n = 0; n < 2; ++n) acc[a][b][m][n] = (f32x4){0.f, 0.f, 0.f, 0.f};
    bf16x8 At[4][2], B0[2][2], B1[2][2];
    const char* cA = (const char*)g.A + (size_t)cur.pm * tstep + (size_t)cur.k0 * 2; const char* cB = (const char*)g.Bt + (size_t)cur.pn * tstep + (size_t)cur.k0 * 2;
    S.a_ready(cur);
    if constexpr (SP2) {
        PG8_STAGE(PG8_SB(0, 0), cB, voffB); PG8_STAGE(PG8_SB(0, 1), cB + hstep, voffB); PG8_STAGE(PG8_SA(0, 0), cA, voffA); PG8_STAGE(PG8_SA(0, 1), cA + hstep, voffA);
        if (wr == 1) PG8_BAR;
        PG8_WAIT_V(2); PG8_BAR;
        PG8_STAGE(PG8_SB(1, 0), cB + kstep, voffB); PG8_STAGE(PG8_SA(1, 0), cA + kstep, voffA); PG8_STAGE(PG8_SB(1, 1), cB + hstep + kstep, voffB);
        PG8_WAIT_V(6); PG8_BAR;
    } else {
        PG8_STAGE(PG8_SB(0, 0), cB, voffB); PG8_STAGE(PG8_SA(0, 0), cA, voffA); PG8_STAGE(PG8_SB(0, 1), cB + hstep, voffB); PG8_STAGE(PG8_SA(0, 1), cA + hstep, voffA);
        if (wr == 1) PG8_BAR;
        PG8_WAIT_V(4); PG8_BAR;
        PG8_STAGE(PG8_SB(1, 0), cB + kstep, voffB); PG8_STAGE(PG8_SA(1, 0), cA + kstep, voffA); PG8_STAGE(PG8_SB(1, 1), cB + hstep + kstep, voffB);
        PG8_WAIT_V(6); PG8_BAR;
    }
    for (;;) {
        const bool has_next = S.next(ui + 1, nxt);
        const char* nA = has_next ? (const char*)g.A + (size_t)nxt.pm * tstep + (size_t)nxt.k0 * 2 : cA; const char* nB = has_next ? (const char*)g.Bt + (size_t)nxt.pn * tstep + (size_t)nxt.k0 * 2 : cB;
        const int ntc = cur.nt ? cur.nt : nt;
        for (int t = 0; t < ntc; t += 2) {
            const bool last = (t == ntc - 2);
            const char* a1 = cA + (size_t)(t + 1) * kstep;
            const char* a2 = last ? nA : cA + (size_t)(t + 2) * kstep; const char* b2 = last ? nB : cB + (size_t)(t + 2) * kstep;
            const char* a3 = a2 + kstep; const char* b3 = b2 + kstep;
            if (last && has_next) S.a_ready(nxt);
            if constexpr (SP2) {
            PG8_LDB(B0, 0, 0); PG8_LDB(B1, 0, 1); PG8_SCHED; PG8_LDA(At, 0, 0); PG8_STAGE(PG8_SA(1, 1), a1 + hstep, voffA);
            PG8_WAIT_V(8); PG8_WAIT_L(0); PG8_BAR; PG8_MMA(0, 0, At, B0); PG8_MMA(0, 1, At, B1); PG8_BAR; PG8_SCHED;
            PG8_LDA(At, 0, 1); PG8_STAGE(PG8_SB(0, 0), b2, voffB); PG8_STAGE(PG8_SB(0, 1), b2 + hstep, voffB); PG8_STAGE(PG8_SA(0, 0), a2, voffA);
            PG8_WAIT_V(8); PG8_WAIT_L(0); PG8_BAR; PG8_MMA(1, 0, At, B0); PG8_MMA(1, 1, At, B1); PG8_BAR; PG8_SCHED;
            PG8_LDB(B0, 1, 0); PG8_LDB(B1, 1, 1); PG8_SCHED; PG8_LDA(At, 1, 0); PG8_STAGE(PG8_SA(0, 1), a2 + hstep, voffA);
            PG8_WAIT_V(8); PG8_WAIT_L(0); PG8_BAR; PG8_MMA(0, 0, At, B0); PG8_MMA(0, 1, At, B1); PG8_BAR; PG8_SCHED;
            PG8_LDA(At, 1, 1); PG8_STAGE(PG8_SB(1, 0), b3, voffB); PG8_STAGE(PG8_SB(1, 1), b3 + hstep, voffB); PG8_STAGE(PG8_SA(1, 0), a3, voffA);
            PG8_WAIT_V(8); PG8_WAIT_L(0); PG8_BAR; PG8_MMA(1, 0, At, B0); PG8_MMA(1, 1, At, B1); PG8_BAR; PG8_SCHED;
            } else {
            PG8_LDB(B0, 0, 0); PG8_SCHED; PG8_LDA(At, 0, 0); PG8_STAGE(PG8_SA(1, 1), a1 + hstep, voffA);
            PG8_WAIT_L(8); PG8_BAR; PG8_WAIT_L(0); PG8_MMA(0, 0, At, B0); PG8_BAR; PG8_SCHED;
            PG8_LDB(B1, 0, 1); PG8_STAGE(PG8_SB(0, 0), b2, voffB);
            PG8_BAR; PG8_WAIT_L(0); PG8_MMA(0, 1, At, B1); PG8_BAR;
            PG8_LDA(At, 0, 1); PG8_STAGE(PG8_SA(0, 0), a2, voffA);
            PG8_BAR; PG8_WAIT_L(0); PG8_MMA(1, 0, At, B0); PG8_BAR; PG8_SCHED;
            PG8_STAGE(PG8_SB(0, 1), b2 + hstep, voffB);
            PG8_WAIT_V(6); PG8_BAR; PG8_MMA(1, 1, At, B1); PG8_BAR;
            PG8_LDB(B0, 1, 0); PG8_SCHED; PG8_LDA(At, 1, 0); PG8_STAGE(PG8_SA(0, 1), a2 + hstep, voffA);
            PG8_WAIT_L(8); PG8_BAR; PG8_WAIT_L(0); PG8_MMA(0, 0, At, B0); PG8_BAR; PG8_SCHED;
            PG8_LDB(B1, 1, 1); PG8_STAGE(PG8_SB(1, 0), b3, voffB);
            PG8_BAR; PG8_WAIT_L(0); PG8_MMA(0, 1, At, B1); PG8_BAR;
            PG8_LDA(At, 1, 1); PG8_STAGE(PG8_SA(1, 0), a3, voffA);
            PG8_BAR; PG8_WAIT_L(0); PG8_MMA(1, 0, At, B0); PG8_BAR; PG8_SCHED;
            PG8_STAGE(PG8_SB(1, 1), b3 + hstep, voffB);
            PG8_WAIT_V(6); PG8_BAR; PG8_MMA(1, 1, At, B1); PG8_BAR;
            }
        }
        if constexpr (ALIGN_EPI) { if (wr == 0) PG8_BAR; }
        if constexpr (!Epi::AFTER_DRAIN) { E(acc, cur, wr, wc, fr, fq); S.done(cur); }
        if (!has_next) break;
#pragma unroll
        for (int a = 0; a < 2; ++a)
#pragma unroll
            for (int b = 0; b < 2; ++b)
#pragma unroll
                for (int m = 0; m < 4; ++m)
#pragma unroll
                    for (int n = 0; n < 2; ++n) acc[a][b][m][n] = (f32x4){0.f, 0.f, 0.f, 0.f};
        cur = nxt; cA = nA; cB = nB; ++ui;
        if constexpr (ALIGN_EPI) { if (wr == 1) PG8_BAR; }
    }
    PG8_WAIT_V(0);
    if constexpr (!ALIGN_EPI) { if (wr == 0) PG8_BAR; }
    PG8_BAR;
    if constexpr (Epi::AFTER_DRAIN) { E.fused(acc, cur, wr, wc, fr, fq, lds, wid, lane); S.done(cur); }
#undef PG8_SA
#undef PG8_SB
#undef PG8_STAGE
#undef PG8_LDA
#undef PG8_LDB
#undef PG8_MMA
#undef PG8_WAIT_V
#undef PG8_WAIT_L
#undef PG8_BAR
#undef PG8_SCHED
}
}

#define LAS __attribute__((address_space(3)))
typedef unsigned short bf16;
typedef short bf16x8 __attribute__((ext_vector_type(8)));
typedef float f32x4 __attribute__((ext_vector_type(4)));
typedef float f32x2 __attribute__((ext_vector_type(2)));
typedef float f32x16 __attribute__((ext_vector_type(16)));
typedef unsigned u32x4 __attribute__((ext_vector_type(4)));
typedef unsigned u32x2 __attribute__((ext_vector_type(2)));
using pg8::cvt_pk_bf16;
using pg8::Unit;

constexpr int D = 1024, NB = 8, TP = 2064, MP = NB * TP, NS = 128, M = MP + NS, NMT = M / 256;
constexpr int FF = 4096, NRI = 6144, HV = 2048;
constexpr float EPS = 1e-6f;
static_assert(M % 256 == 0, "rows");

constexpr size_t O_YP = 0, O_YS = 16777216, O_R0P = 16908288, O_R0S = 21102592, O_SHP = 88211456, O_SHS = 88219648,
                 O_WKP = 88350720, O_WKS = 88875008, O_CVP = 97263616, O_CVS = 97280000, O_R3P = 97542144, O_R3S = 101736448, O_END = 168845312;

constexpr size_t al(size_t x) { return (x + 4095) & ~(size_t)4095; }
constexpr size_t WS_RI0 = 4096, WS_RI1 = WS_RI0 + al((size_t)NRI * D * 2), WS_RO0 = WS_RI1 + al((size_t)NRI * D * 2), WS_RO1 = WS_RO0 + al((size_t)D * HV * 2),
                 WS_RW1 = WS_RO1 + al((size_t)D * HV * 2), WS_RW2 = WS_RW1 + al((size_t)3840 * D * 2), WS_RWO = WS_RW2 + al((size_t)3072 * 256 * 2),
                 WS_CIN = WS_RWO + al((size_t)D * D * 2), WS_COUT = WS_CIN + al((size_t)3072 * D * 2), WS_M1 = WS_COUT + al((size_t)D * D * 2),
                 WS_M2 = WS_M1 + 4 * al((size_t)FF * D * 2), WS_ROPE = WS_M2 + 4 * al((size_t)FF * D * 2), WS_H = WS_ROPE + al((size_t)2065 * 128 * 8),
                 WS_XN = WS_H + al((size_t)M * D * 4), WS_B = WS_XN + al((size_t)M * D * 2);
constexpr size_t RB_Q = WS_B, RB_K = RB_Q + al((size_t)M * D * 2), RB_KTD = RB_K + al((size_t)M * D * 2), RB_VT = RB_KTD + al((size_t)32 * 256 * TP * 2),
                 RB_VS = RB_VT + al((size_t)32 * 512 * TP * 2), RB_SG = RB_VS + al((size_t)NS * HV * 4), RB_OB = RB_SG + al((size_t)M * HV * 2),
                 RB_Y = RB_OB + al((size_t)M * HV * 2), RB_END = RB_Y + al((size_t)M * HV * 2);
constexpr size_t WB_XM = WS_B, WB_DAG = WS_B  , WB_RKV = WB_XM + al((size_t)6 * M * D * 2), WB_L1 = WB_RKV + al((size_t)3 * M * D * 4),
                 WB_YR = WB_L1 + al((size_t)3 * M * 256 * 2), WB_Y = WB_YR + al((size_t)M * D * 4), WB_END = WB_Y + al((size_t)M * D * 2);
static_assert((size_t)3 * M * D * 4 <= (size_t)6 * M * D * 2, "DAG fits over XM");
constexpr size_t CB_BC = WS_B, CB_U = CB_BC + al((size_t)M * D * 2), CB_A2 = CB_U + al((size_t)M * D * 4), CB_END = CB_A2 + al((size_t)M * D * 2);
constexpr size_t MB_ACT = WS_B, MB_END = MB_ACT + al((size_t)M * FF * 2);
constexpr size_t cmax(size_t a, size_t b) { return a > b ? a : b; }
constexpr size_t WS_END = cmax(cmax(RB_END, WB_END), cmax(CB_END, MB_END));

constexpr size_t WS_BAR = al(WS_END), WS_TOTAL = WS_BAR + 16384;
constexpr int LDS_BYTES = 147456, LDS_MISC = 131072 + 256;

#define LDS_WAIT() asm volatile("s_waitcnt lgkmcnt(0)" ::: "memory")
__device__ __forceinline__ float bf2f(bf16 x) { return __uint_as_float((unsigned)x << 16); }
__device__ __forceinline__ unsigned f2bf(float f) { unsigned u = __builtin_bit_cast(unsigned, f); return (u + 0x7fffu + ((u >> 16) & 1u)) >> 16; }
__device__ __forceinline__ unsigned pk2(float lo, float hi) { return f2bf(lo) | (f2bf(hi) << 16); }
__device__ __forceinline__ float wave_sum(float v) {
#pragma unroll
    for (int o = 1; o < 64; o <<= 1) v += __shfl_xor(v, o);
    return v;
}
template <int CTRL> __device__ __forceinline__ float dpp_add(float x) {
    const int xi = __builtin_bit_cast(int, x);
    const int yi = __builtin_amdgcn_update_dpp(0, xi, CTRL, 0xF, 0xF, false);
    return x + __builtin_bit_cast(float, yi);
}
__device__ __forceinline__ float sum4(float x) { x = dpp_add<0xB1>(x); x = dpp_add<0x4E>(x); return x; }
__device__ __forceinline__ float sum16(float x) { x = sum4(x); x = dpp_add<0x141>(x); x = dpp_add<0x140>(x); return x; }
__device__ __forceinline__ int crow(int r, int hi) { return (r & 3) + 8 * (r >> 2) + 4 * hi; }
#define MFMA32(a, b, c) __builtin_amdgcn_mfma_f32_32x32x16_bf16((a), (b), (c), 0, 0, 0)

struct StackOrder {
    pg8::StaticOrder base; int mode;
    __device__ __forceinline__ bool next(int i, Unit& u) const {
        if (!base.next(i, u)) return false;
        const int j = mode == 1 ? (u.pn < 12 ? (u.pn >> 2) : u.pn - 9) : (u.pn >> 2);
        u.pm += NMT * j; return true;
    }
    __device__ __forceinline__ void a_ready(const Unit&) const {}
    __device__ __forceinline__ void done(const Unit&) const {}
};

struct TailOrder {
    pg8::StaticOrder base; int nN, nsmall, G, c;
    __device__ __forceinline__ void init(int N, int K, int G_, int c_) { base.init(M - 256, N, G_, c_); nN = N / 256; nsmall = nN * (K / 256); G = G_; c = c_; }
    __device__ __forceinline__ bool next(int i, Unit& u) const {
        const long L = (long)i * G + c;
        if (L < base.nwg) return base.next(i, u);
        const int s = (int)(L - base.nwg); if (s >= nsmall) return false;
        u.pm = NMT - 1; u.pn = s % nN; u.k0 = (s / nN) * 256; u.nt = 4; return true;
    }
    __device__ __forceinline__ void a_ready(const Unit&) const {}
    __device__ __forceinline__ void done(const Unit&) const {}
};

#define EPI_LOOP_ROWS for (int ai = 0; ai < 2; ++ai) for (int m = 0; m < 4; ++m)
#define EPI_LOOP_COLS for (int bj = 0; bj < 2; ++bj) for (int n = 0; n < 2; ++n)

struct EpiResid {
    static constexpr bool PERM = false, AFTER_DRAIN = false;
    float* H; float sgn;
    __device__ __forceinline__ void operator()(const f32x4 (&acc)[2][2][4][2], const Unit& u, int wr, int wc, int fr, int fq) const {
        const int row0 = u.pm * 256 + wr * 64 + fr, col0 = u.pn * 256 + wc * 32 + 4 * fq;
        if (u.nt == 0) {
#pragma unroll
            EPI_LOOP_ROWS { float* rp = H + (size_t)(row0 + ai * 128 + m * 16) * D + col0;
#pragma unroll
                EPI_LOOP_COLS { f32x4* p = (f32x4*)(rp + bj * 128 + n * 16); *p = *p + acc[ai][bj][m][n] * sgn; } }
        } else {
#pragma unroll
            EPI_LOOP_ROWS { float* rp = H + (size_t)(row0 + ai * 128 + m * 16) * D + col0;
#pragma unroll
                EPI_LOOP_COLS { float* p = rp + bj * 128 + n * 16;
#pragma unroll
                    for (int i = 0; i < 4; ++i) __hip_atomic_fetch_add(p + i, acc[ai][bj][m][n][i] * sgn, __ATOMIC_RELAXED, __HIP_MEMORY_SCOPE_AGENT); } }
        }
    }
};

struct EpiRelu2 {
    static constexpr bool PERM = true, AFTER_DRAIN = false;
    bf16* O;
    __device__ __forceinline__ void operator()(const f32x4 (&acc)[2][2][4][2], const Unit& u, int wr, int wc, int fr, int fq) const {
#ifdef SKIP_EPIRELU2
        return;
#endif

        const int row0 = u.pm * 256 + wr * 64 + fr, col0 = u.pn * 256 + wc * 32 + 8 * fq;
#pragma unroll
        EPI_LOOP_ROWS { bf16* rp = O + (size_t)(row0 + ai * 128 + m * 16) * FF + col0;
#pragma unroll
            for (int bj = 0; bj < 2; ++bj) { f32x4 a = acc[ai][bj][m][0], b = acc[ai][bj][m][1];
                a = __builtin_elementwise_max(a, (f32x4){0.f, 0.f, 0.f, 0.f}); b = __builtin_elementwise_max(b, (f32x4){0.f, 0.f, 0.f, 0.f}); a = a * a; b = b * b;
                u32x4 w; w.x = cvt_pk_bf16(a[0], a[1]); w.y = cvt_pk_bf16(a[2], a[3]); w.z = cvt_pk_bf16(b[0], b[1]); w.w = cvt_pk_bf16(b[2], b[3]);
                *(u32x4*)(rp + bj * 128) = w; } }
    }
};

struct EpiRetIn {
    static constexpr bool PERM = false, AFTER_DRAIN = false;
    bf16 *Qb, *Kb, *KTD, *VT, *SG; float* VS; const float* rope;
    __device__ __forceinline__ void operator()(const f32x4 (&acc)[2][2][4][2], const Unit& u, int wr, int wc, int fr, int fq) const {
#ifdef SKIP_EPIRETIN
        return;
#endif

        const int row0 = u.pm * 256 + wr * 64 + fr, cin0 = wc * 32 + 4 * fq, pn = u.pn;
#pragma unroll
        for (int ai = 0; ai < 2; ++ai)
#pragma unroll
            for (int m = 0; m < 4; ++m) {
                const int r = row0 + ai * 128 + m * 16;
                const bool prm = r < MP; const int b = prm ? r / TP : 0; const int t = prm ? r - b * TP : 0; const int pidx = prm ? t : TP;
                if (pn < 8) {
                    const int h = pn & 3; const bool isk = pn >= 4;
                    float kdec = 1.f;
                    if (isk && prm) { const int e = t < 16 ? 15 - t : 127 - ((t - 16) & 127); kdec = __builtin_amdgcn_exp2f((float)e * __log2f(1.f - __builtin_amdgcn_exp2f(-(float)(5 + h)))); }
#pragma unroll
                    EPI_LOOP_COLS { const int d = bj * 128 + n * 16 + cin0; const f32x4 x = acc[ai][bj][m][n];
                        const f32x4 cs = *(const f32x4*)(rope + ((size_t)pidx * 128 + (d >> 1)) * 2);
                        f32x4 o; o[0] = x[0] * cs[0] - x[1] * cs[1]; o[1] = x[0] * cs[1] + x[1] * cs[0]; o[2] = x[2] * cs[2] - x[3] * cs[3]; o[3] = x[2] * cs[3] + x[3] * cs[2];
                        if (isk) o = o * 0.0625f;
                        u32x2 w; w.x = cvt_pk_bf16(o[0], o[1]); w.y = cvt_pk_bf16(o[2], o[3]);
                        *(u32x2*)((isk ? Kb : Qb) + (size_t)r * D + h * 256 + d) = w;
                        if (isk && prm) { bf16* kp = KTD + ((size_t)((b * 4 + h) * 256 + d)) * TP + t;
                            kp[0] = (bf16)f2bf(o[0] * kdec); kp[TP] = (bf16)f2bf(o[1] * kdec); kp[2 * TP] = (bf16)f2bf(o[2] * kdec); kp[3 * TP] = (bf16)f2bf(o[3] * kdec); } }
                } else if (pn < 16) {
                    const int h = (pn - 8) >> 1, e0 = ((pn - 8) & 1) * 256;
#pragma unroll
                    EPI_LOOP_COLS { const int e = e0 + bj * 128 + n * 16 + cin0; const f32x4 x = acc[ai][bj][m][n];
                        if (prm) { bf16* vp = VT + ((size_t)((b * 4 + h) * 512 + e)) * TP + t;
                            vp[0] = (bf16)f2bf(x[0]); vp[TP] = (bf16)f2bf(x[1]); vp[2 * TP] = (bf16)f2bf(x[2]); vp[3 * TP] = (bf16)f2bf(x[3]); }
                        else *(f32x4*)(VS + (size_t)(r - MP) * HV + h * 512 + e) = x; }
                } else {
                    const int c0 = (pn - 16) * 256;
#pragma unroll
                    EPI_LOOP_COLS { const int c = c0 + bj * 128 + n * 16 + cin0; const f32x4 x = acc[ai][bj][m][n]; f32x4 o;
#pragma unroll
                        for (int i = 0; i < 4; ++i) o[i] = x[i] / (1.f + __expf(-x[i]));
                        u32x2 w; w.x = cvt_pk_bf16(o[0], o[1]); w.y = cvt_pk_bf16(o[2], o[3]);
                        *(u32x2*)(SG + (size_t)r * HV + c) = w; }
                }
            }
    }
};

struct EpiRw1 {
    static constexpr bool PERM = false, AFTER_DRAIN = false;
    float* RKV; bf16* L1;
    __device__ __forceinline__ void operator()(const f32x4 (&acc)[2][2][4][2], const Unit& u, int wr, int wc, int fr, int fq) const {
#ifdef SKIP_EPIRW1
        return;
#endif

        const int pmr = u.pm % NMT, row0 = pmr * 256 + wr * 64 + fr, cin0 = wc * 32 + 4 * fq, pn = u.pn;
        if (pn < 12) {
            float* base = RKV + (size_t)(pn >> 2) * M * D + (pn & 3) * 256 + cin0;
#pragma unroll
            EPI_LOOP_ROWS { float* rp = base + (size_t)(row0 + ai * 128 + m * 16) * D;
#pragma unroll
                EPI_LOOP_COLS *(f32x4*)(rp + bj * 128 + n * 16) = acc[ai][bj][m][n]; }
        } else {
            const int j = pn - 12; bf16* base = L1 + (size_t)j * M * 256 + cin0;
#pragma unroll
            for (int ai = 0; ai < 2; ++ai)
#pragma unroll
                for (int m = 0; m < 4; ++m) { bf16* rp = base + (size_t)(row0 + ai * 128 + m * 16) * 256;
#pragma unroll
                    EPI_LOOP_COLS { const f32x4 x = acc[ai][bj][m][n]; f32x4 o;
#pragma unroll
                        for (int i = 0; i < 4; ++i) o[i] = j == 0 ? tanhf(x[i]) : (j == 1 ? x[i] : 1.f / (1.f + __expf(-x[i])));
                        u32x2 w; w.x = cvt_pk_bf16(o[0], o[1]); w.y = cvt_pk_bf16(o[2], o[3]);
                        *(u32x2*)(rp + bj * 128 + n * 16) = w; } }
        }
    }
};

struct EpiRw2 {
    static constexpr bool PERM = false, AFTER_DRAIN = false;
    float* DAG; const float *w0, *a0;
    __device__ __forceinline__ void operator()(const f32x4 (&acc)[2][2][4][2], const Unit& u, int wr, int wc, int fr, int fq) const {
#ifdef SKIP_EPIRW2
        return;
#endif
        const int pmr = u.pm % NMT, row0 = pmr * 256 + wr * 64 + fr, pn = u.pn, j = pn >> 2, col0 = (pn & 3) * 256 + wc * 32 + 4 * fq;
        float* base = DAG + (size_t)j * M * D + (size_t)row0 * D + col0;
        const float* bias = j == 0 ? w0 : a0;
#pragma unroll
        EPI_LOOP_COLS { const int cc = bj * 128 + n * 16;
            f32x4 bb = (f32x4){0.f, 0.f, 0.f, 0.f}; if (j < 2) bb = *(const f32x4*)(bias + col0 + cc);
#pragma unroll
            EPI_LOOP_ROWS { const f32x4 x = acc[ai][bj][m][n] + bb; f32x4 o;
                if (j == 0) {
#pragma unroll
                    for (int i = 0; i < 4; ++i) { const float z = -x[i]; const float sp = fmaxf(z, 0.f) + __logf(1.f + __expf(-fabsf(z))); o[i] = __expf(-__expf(-sp - 0.5f)); } }
                else if (j == 1) {
#pragma unroll
                    for (int i = 0; i < 4; ++i) o[i] = 1.f / (1.f + __expf(-x[i])); }
                else o = x;
                if (j == 2) { u32x2 wv; wv.x = cvt_pk_bf16(o[0], o[1]); wv.y = cvt_pk_bf16(o[2], o[3]); *(u32x2*)((bf16*)(DAG + (size_t)2 * M * D) + (size_t)(row0 + ai * 128 + m * 16) * D + col0 + cc) = wv; }
                else *(f32x4*)(base + (size_t)(ai * 128 + m * 16) * D + cc) = o; }
            asm volatile("" ::: "memory"); }
    }
};

struct EpiConvIn {
    static constexpr bool PERM = false, AFTER_DRAIN = false;
    bf16* BC; float* U;
    __device__ __forceinline__ void operator()(const f32x4 (&acc)[2][2][4][2], const Unit& u, int wr, int wc, int fr, int fq) const {
#ifdef SKIP_EPICONVIN
        return;
#endif

        const int row0 = u.pm * 256 + wr * 64 + fr, cin0 = wc * 32 + 4 * fq, pn = u.pn;
        if (pn < 4) {
#pragma unroll
            EPI_LOOP_ROWS { bf16* rp = BC + (size_t)(row0 + ai * 128 + m * 16) * D + pn * 256 + cin0;
#pragma unroll
                EPI_LOOP_COLS { const f32x4 x = acc[ai][bj][m][n]; u32x2 w; w.x = cvt_pk_bf16(x[0], x[1]); w.y = cvt_pk_bf16(x[2], x[3]); *(u32x2*)(rp + bj * 128 + n * 16) = w; } }
        } else {
#pragma unroll
            EPI_LOOP_ROWS { float* rp = U + (size_t)(row0 + ai * 128 + m * 16) * D + (pn - 4) * 128 + cin0;
#pragma unroll
                for (int n = 0; n < 2; ++n) *(f32x4*)(rp + n * 16) = acc[ai][0][m][n] * acc[ai][1][m][n]; }
        }
    }
};

__device__ __forceinline__ void tr_item(const float* W, int K, int N, bf16* WT, int ldk, int drow0, int k0, int n0, LAS bf16* scr, int lane) {
    f32x4 v[16];
    const int nl = (lane & 15) * 4, kq = lane >> 4, n = n0 + nl;
#pragma unroll
    for (int i = 0; i < 16; ++i) { const int k = k0 + 4 * i + kq; v[i] = (k < K && n < N) ? *(const f32x4*)(W + (size_t)k * N + n) : (f32x4){0.f, 0.f, 0.f, 0.f}; }
#pragma unroll
    for (int i = 0; i < 16; ++i) { const int kl = 4 * i + kq;
#pragma unroll
        for (int j = 0; j < 4; ++j) scr[(nl + j) * 72 + kl] = (bf16)f2bf(v[i][j]); }
    LDS_WAIT(); asm volatile("" ::: "memory");
    const int c = lane & 7;
#pragma unroll
    for (int q = 0; q < 8; ++q) { const int nr = q * 8 + (lane >> 3);
        const u32x4 o = *(const LAS u32x4*)(scr + nr * 72 + 8 * c);
        *(u32x4*)(WT + (size_t)(drow0 + nr) * ldk + k0 + 8 * c) = o; }
    LDS_WAIT(); asm volatile("" ::: "memory");
}
__device__ __forceinline__ int cin_row(int n0) { if (n0 < 1024) return n0; if (n0 < 2048) { const int j = n0 - 1024; return 1024 + (j >> 7) * 256 + (j & 127); } const int j = n0 - 2048; return 1024 + (j >> 7) * 256 + 128 + (j & 127); }

__device__ __forceinline__ void rms_row(const float* xrow, const float* gain, int lane, f32x4 (&v)[4]) {
    const f32x4* xr = (const f32x4*)xrow + lane; const f32x4* gr = (const f32x4*)gain + lane; float s = 0.f;
#pragma unroll
    for (int j = 0; j < 4; ++j) { v[j] = xr[64 * j]; s += (v[j].x * v[j].x + v[j].y * v[j].y) + (v[j].z * v[j].z + v[j].w * v[j].w); }
    const float rstd = 1.0f / sqrtf(wave_sum(s) * (1.f / D) + EPS);
#pragma unroll
    for (int j = 0; j < 4; ++j) v[j] = v[j] * rstd * gr[64 * j];
}
__device__ __forceinline__ void rms_row2(const float* x0, const float* x1, const float* gain, int lane, f32x4 (&v0)[4], f32x4 (&v1)[4]) {
    const f32x4* p0 = (const f32x4*)x0 + lane; const f32x4* p1 = (const f32x4*)x1 + lane; const f32x4* gr = (const f32x4*)gain + lane; float s0 = 0.f, s1 = 0.f;
#pragma unroll
    for (int j = 0; j < 4; ++j) { v0[j] = p0[64 * j]; v1[j] = p1[64 * j]; }
#pragma unroll
    for (int j = 0; j < 4; ++j) { s0 += (v0[j].x * v0[j].x + v0[j].y * v0[j].y) + (v0[j].z * v0[j].z + v0[j].w * v0[j].w); s1 += (v1[j].x * v1[j].x + v1[j].y * v1[j].y) + (v1[j].z * v1[j].z + v1[j].w * v1[j].w); }
#pragma unroll
    for (int o = 1; o < 64; o <<= 1) { s0 += __shfl_xor(s0, o); s1 += __shfl_xor(s1, o); }
    const float r0 = 1.0f / sqrtf(s0 * (1.f / D) + EPS), r1 = 1.0f / sqrtf(s1 * (1.f / D) + EPS);
#pragma unroll
    for (int j = 0; j < 4; ++j) { const f32x4 g = gr[64 * j]; v0[j] = v0[j] * r0 * g; v1[j] = v1[j] * r1 * g; }
}
__device__ __forceinline__ void store_row_bf16(bf16* orow, int lane, const f32x4 (&v)[4]) {
    u32x2* o8 = (u32x2*)orow + lane;
#pragma unroll
    for (int j = 0; j < 4; ++j) { u32x2 w; w.x = pk2(v[j].x, v[j].y); w.y = pk2(v[j].z, v[j].w); o8[64 * j] = w; }
}

#define XB_TMO      128
#define XB_XCNT(j)  (256  + 64 * (j))
#define XB_XSUB(j)  (1280 + 64 * (j))
#define XB_XGEN(j)  (2304 + 64 * (j))
#define XB_TOP      3328
#define XB_TOPGEN   3392
#define XCD_BAR_WORDS 3456
#define XB_SPIN_CAP (1u << 18)

__device__ __forceinline__ unsigned xb_ld(unsigned* p)              { return __hip_atomic_load(p, __ATOMIC_RELAXED, __HIP_MEMORY_SCOPE_AGENT); }
__device__ __forceinline__ unsigned xb_add(unsigned* p, unsigned v) { return __hip_atomic_fetch_add(p, v, __ATOMIC_RELAXED, __HIP_MEMORY_SCOPE_AGENT); }
__device__ __forceinline__ unsigned xb_xcc_id() { return (unsigned)__builtin_amdgcn_s_getreg((3 << 11) | 20) & 0xFu; }
#define XB_SPIN(cond, bar) do { unsigned _sp = 0; while (cond) { __builtin_amdgcn_s_sleep(1); \
    if ((++_sp & 255u) == 0u) { if (xb_ld(&(bar)[XB_TMO])) break; if (_sp > XB_SPIN_CAP) { atomicAdd(&(bar)[XB_TMO], 1u); break; } } } } while (0)

struct XcdBarrier {
    unsigned* bar; unsigned x;
    volatile LAS unsigned* st;
};

__device__ __forceinline__ XcdBarrier xcd_barrier_post(unsigned* bar, volatile LAS unsigned* st) {
    XcdBarrier b; b.bar = bar; b.x = xb_xcc_id(); b.st = st;
    if (threadIdx.x == 0) (void)xb_add(&bar[XB_XCNT(b.x)], 1u);
    return b;
}
__device__ __forceinline__ void xcd_barrier_complete(unsigned* bar, unsigned x, unsigned& nloc, unsigned& nx) {
    const unsigned G = gridDim.x * gridDim.y * gridDim.z;
    unsigned sum, cnt, mine, sp = 0u;
    for (;;) {
        sum = 0u; cnt = 0u; mine = 0u;
#pragma unroll
        for (unsigned j = 0; j < 16; ++j) { const unsigned c = xb_ld(&bar[XB_XCNT(j)]); sum += c; cnt += (c > 0u) ? 1u : 0u; mine = (j == x) ? c : mine; }
        if (sum == G) break;
        __builtin_amdgcn_s_sleep(1);
        if ((++sp & 255u) == 0u) { if (xb_ld(&bar[XB_TMO])) break; if (sp > XB_SPIN_CAP) { atomicAdd(&bar[XB_TMO], 1u); break; } }
    }
    nloc = mine > 0u ? mine : 1u; nx = cnt > 0u ? cnt : 1u;
}

__device__ __forceinline__ void xcd_barrier(const XcdBarrier& b) {
    asm volatile("s_waitcnt vmcnt(0)" ::: "memory");
    __syncthreads();
    if (threadIdx.x == 0) {
        unsigned* bar = b.bar;
        __builtin_amdgcn_s_waitcnt(0);
        unsigned nloc = b.st[0], nx = b.st[1];
        if (nloc == 0u) { xcd_barrier_complete(bar, b.x, nloc, nx); b.st[0] = nloc; b.st[1] = nx; }
        const unsigned old = xb_add(&bar[XB_XSUB(b.x)], 1u);
        const unsigned gen = old / nloc;
        if (old + 1u == (gen + 1u) * nloc) {
            __builtin_amdgcn_fence(__ATOMIC_RELEASE, "agent");
            asm volatile("s_waitcnt vmcnt(0)" ::: "memory");
            const unsigned og = xb_add(&bar[XB_TOP], 1u);
            const unsigned tg = og / nx;
            if (og + 1u == (tg + 1u) * nx) xb_add(&bar[XB_TOPGEN], 1u);
            else XB_SPIN(xb_ld(&bar[XB_TOPGEN]) == tg, bar);
            __builtin_amdgcn_fence(__ATOMIC_ACQUIRE, "agent");
            xb_add(&bar[XB_XGEN(b.x)], 1u);
            asm volatile("s_waitcnt vmcnt(0)" ::: "memory");
        } else {
            XB_SPIN(xb_ld(&bar[XB_XGEN(b.x)]) == gen, bar);
            __builtin_amdgcn_fence(__ATOMIC_ACQUIRE, "agent");
            asm volatile("s_waitcnt vmcnt(0)" ::: "memory");
        }
    }
    __syncthreads();
}

struct KArgs { const float* in[34]; float* out; unsigned char* ws; int ph_lo, ph_hi, coop, pad; int rep[8]; };

__global__ void __launch_bounds__(512, 2) fwd_kernel(KArgs a) {
    extern __shared__ __attribute__((aligned(16))) unsigned char lds_raw[];
    LAS unsigned char* lds = (LAS unsigned char*)lds_raw;
    cg::grid_group grid = cg::this_grid();
    const int tid0 = threadIdx.x, wave = __builtin_amdgcn_readfirstlane(tid0 >> 6);
    const int G = gridDim.x, bid = blockIdx.x, gw = bid * 8 + wave, NGW = G * 8;
    unsigned char* ws = a.ws; float* out = a.out;
    float* H = (float*)(ws + WS_H); bf16* XN = (bf16*)(ws + WS_XN);
    const float* rope = (const float*)(ws + WS_ROPE);
    const int lo = a.ph_lo, hi = a.ph_hi; const bool coop = a.coop != 0;
    volatile LAS unsigned* MISC = (volatile LAS unsigned*)(lds + LDS_MISC);
    if (tid0 == 0) { MISC[0] = 0u; MISC[1] = 0u; }
    __syncthreads();
    XcdBarrier xbar = xcd_barrier_post((unsigned*)(ws + WS_BAR), MISC);
    int pc = 0;
#define PH_BEGIN(cat) if (pc >= lo && pc < hi) { for (int rep_ = 0; rep_ < a.rep[cat]; ++rep_) { int tid = tid0; asm volatile("" : "+v"(tid)); const int lane = tid & 63; (void)lane;
#define PH_END   __syncthreads(); } if (coop && pc + 1 < hi) { if (a.coop == 2) grid.sync();     \
        xcd_barrier(xbar); if (a.rep[5] > 1) xcd_barrier(xbar); } } ++pc;

    PH_BEGIN(0)
    {
        LAS bf16* scr = (LAS bf16*)(lds + wave * 9216);
        for (int it = gw; ; it += NGW) {
            int r = it; bool did = false; const float* jW = nullptr; bf16* jWT = nullptr; int jK = 0, jN = 0, jld = 0, jrow = 0, jk0 = 0, jn0 = 0;
#define TRJOB(Wp, K_, N_, KP_, NP_, WTp, LDK_, ROWEXPR) if (!did) { const int nnb = (NP_) / 64, cnt = ((KP_) / 64) * nnb; \
                if (r < cnt) { const int kb = r / nnb, nb = r - kb * nnb, n0 = nb * 64; jW = (Wp); jK = (K_); jN = (N_); jWT = (WTp); jld = (LDK_); jrow = (ROWEXPR) + n0; jk0 = kb * 64; jn0 = n0; did = true; } else r -= cnt; }
            TRJOB(a.in[11], D, NRI, D, NRI, (bf16*)(ws + WS_RI0), D, 0)
            TRJOB(a.in[11] + (size_t)D * NRI, D, NRI, D, NRI, (bf16*)(ws + WS_RI1), D, 0)
            TRJOB(a.in[12], HV, D, HV, D, (bf16*)(ws + WS_RO0), HV, 0)
            TRJOB(a.in[12] + (size_t)HV * D, HV, D, HV, D, (bf16*)(ws + WS_RO1), HV, 0)
            TRJOB(a.in[14], D, D, D, D, (bf16*)(ws + WS_RW1), D, 0)
            TRJOB(a.in[14] + (size_t)D * D, D, D, D, D, (bf16*)(ws + WS_RW1), D, 1024)
            TRJOB(a.in[14] + (size_t)2 * D * D, D, D, D, D, (bf16*)(ws + WS_RW1), D, 2048)
            TRJOB(a.in[16], D, 64, D, 256, (bf16*)(ws + WS_RW1), D, 3072)
            TRJOB(a.in[19], D, 64, D, 256, (bf16*)(ws + WS_RW1), D, 3328)
            TRJOB(a.in[21], D, 160, D, 256, (bf16*)(ws + WS_RW1), D, 3584)
            TRJOB(a.in[17], 64, D, 256, D, (bf16*)(ws + WS_RW2), 256, 0)
            TRJOB(a.in[20], 64, D, 256, D, (bf16*)(ws + WS_RW2), 256, 1024)
            TRJOB(a.in[22], 160, D, 256, D, (bf16*)(ws + WS_RW2), 256, 2048)
            TRJOB(a.in[28], D, D, D, D, (bf16*)(ws + WS_RWO), D, 0)
            TRJOB(a.in[29], D, 3072, D, 3072, (bf16*)(ws + WS_CIN), D, cin_row(n0) - n0)
            TRJOB(a.in[31], D, D, D, D, (bf16*)(ws + WS_COUT), D, 0)
#pragma unroll 1
            for (int l = 0; l < 4; ++l) {
                TRJOB(a.in[32] + (size_t)l * D * FF, D, FF, D, FF, (bf16*)(ws + WS_M1 + (size_t)l * al((size_t)FF * D * 2)), D, 0)
                TRJOB(a.in[33] + (size_t)l * D * FF, FF, D, FF, D, (bf16*)(ws + WS_M2 + (size_t)l * al((size_t)FF * D * 2)), FF, 0)
            }
#undef TRJOB
            if (!did) break;
            tr_item(jW, jK, jN, jWT, jld, jrow, jk0, jn0, scr, lane);
        }
        for (int e = bid * 512 + tid; e < 2065 * 128; e += G * 512) {
            const int p = e >> 7, i = e & 127;
            const float x = (float)i / 127.0f;
            const float inv = 1.0f / (float)exp((double)x * 9.210340371976184);
            const float ang = (float)(p == TP ? 16384 : p) * inv;
            double rev = (double)ang * 0.15915494309189535; rev -= rint(rev);
            const float fr = (float)rev;
            ((f32x2*)(ws + WS_ROPE))[e] = (f32x2){__builtin_amdgcn_cosf(fr), __builtin_amdgcn_sinf(fr)};
        }
        for (int m = gw; m < M; m += NGW) {
            const float* src;
            if (m < MP) { const int b = m / TP, t = m - b * TP; src = t < 16 ? a.in[7] + (size_t)t * D : a.in[0] + ((size_t)b * 2048 + (t - 16)) * D; }
            else src = a.in[1] + (size_t)(m - MP) * D;
            const f32x4* xr = (const f32x4*)src + lane; f32x4* hr = (f32x4*)(H + (size_t)m * D) + lane;
#pragma unroll
            for (int j = 0; j < 4; ++j) hr[64 * j] = xr[64 * j];
            f32x4 v[4]; rms_row(src, a.in[8], lane, v); store_row_bf16(XN + (size_t)m * D, lane, v);
        }
    }
    PH_END

#pragma unroll 1
    for (int layer = 0; layer < 4; ++layer) {
        const int kind = layer % 3;
        const bf16* outA; const bf16* outB; int outK;
        if (kind == 0) {
            const int jr = layer / 3;
            bf16 *Qb = (bf16*)(ws + RB_Q), *Kb = (bf16*)(ws + RB_K), *KTD = (bf16*)(ws + RB_KTD), *VT = (bf16*)(ws + RB_VT), *SG = (bf16*)(ws + RB_SG), *OB = (bf16*)(ws + RB_OB), *Y = (bf16*)(ws + RB_Y);
            float* VS = (float*)(ws + RB_VS);
            outA = Y; outB = (const bf16*)(ws + (jr ? WS_RO1 : WS_RO0)); outK = HV;
            PH_BEGIN(4)
            {
                pg8::Gemm g{XN, (const bf16*)(ws + (jr ? WS_RI1 : WS_RI0)), M, NRI, D}; pg8::StaticOrder S; S.init(M, NRI, G, bid);
                EpiRetIn E{Qb, Kb, KTD, VT, SG, VS, rope};
                pg8::gemm_phase<EpiRetIn, pg8::StaticOrder, true, true>(lds, g, S, E);
            }
            PH_END
            PH_BEGIN(1)
            {
                const float* S0in = a.in[jr ? 6 : 2];
                float* Sp_out = out + (jr ? O_R3P : O_R0P); float* Ss_out = out + (jr ? O_R3S : O_R0S);
                const int l32 = lane & 31, hi = lane >> 5, w = wave;
                LAS bf16* P = (LAS bf16*)lds;
                LAS bf16* ST = (LAS bf16*)(lds + 34816);
                for (int item = bid; item < 256; item += G) {
                    const int itm = (G == 256) ? (((((item & 7) << 2) + (item >> 6)) << 3) | ((item >> 3) & 7)) : item;
                    const int b = itm >> 5, h = (itm >> 3) & 3, es = itm & 7;
                    const float lg2 = __log2f(1.f - __builtin_amdgcn_exp2f(-(float)(5 + h)));
                    const unsigned char* qbytes = (const unsigned char*)(Qb + (size_t)(b * TP) * D + h * 256);
                    const unsigned char* kbytes = (const unsigned char*)(Kb + (size_t)(b * TP) * D + h * 256);
                    const bf16* ktd = KTD + (size_t)((b * 4 + h) * 256) * TP;
                    const bf16* vt = VT + (size_t)((b * 4 + h) * 512 + es * 64) * TP;
                    LAS unsigned char* QH = lds;
                    LAS unsigned char* KH = lds + 34816;
                    LAS unsigned char* STb = lds + 69632;
                    LAS unsigned char* VTs = lds + 103424;
                    f32x16 S2[2];
#pragma unroll
                    for (int i = 0; i < 16; ++i) { S2[0][i] = 0.f; S2[1][i] = 0.f; }
                    for (int i = tid; i < 33792 / 16; i += 512) *(LAS u32x4*)(STb + i * 16) = (u32x4){0u, 0u, 0u, 0u};
                    const u32x4 z4 = {0u, 0u, 0u, 0u};
                    u32x4 rq[4], rk[4], rv[2];
#define RET_T0(cc) ((cc) == 0 ? 0 : 16 + 128 * ((cc) - 1))
#define RET_L(cc)  ((cc) == 0 ? 16 : 128)
#define LOADQK(cc, dh) do { const int t0c_ = RET_T0(cc), Lc_ = RET_L(cc); _Pragma("unroll") for (int i_ = 0; i_ < 4; ++i_) { const int id_ = tidc + 512 * i_, row_ = id_ >> 4, c16_ = id_ & 15; const bool ok_ = row_ < Lc_; \
        const size_t off_ = (size_t)(t0c_ + (ok_ ? row_ : 0)) * 2048 + (dh) * 256 + c16_ * 16; rq[i_] = *(const u32x4*)(qbytes + off_); rk[i_] = *(const u32x4*)(kbytes + off_); if (!ok_) { rq[i_] = z4; rk[i_] = z4; } } } while (0)
#define STOREQK() do { _Pragma("unroll") for (int i_ = 0; i_ < 4; ++i_) { const int id_ = tidc + 512 * i_, row_ = id_ >> 4, c16_ = id_ & 15; *(LAS u32x4*)(QH + row_ * 272 + c16_ * 16) = rq[i_]; *(LAS u32x4*)(KH + row_ * 272 + c16_ * 16) = rk[i_]; } } while (0)
#define LOADV(cc) do { const int t0c_ = RET_T0(cc), Lc_ = RET_L(cc); _Pragma("unroll") for (int i_ = 0; i_ < 2; ++i_) { const int id_ = tidc + 512 * i_, row_ = id_ >> 4, c16_ = id_ & 15; const bool ok_ = c16_ * 8 < Lc_; \
        rv[i_] = *(const u32x4*)(vt + (size_t)row_ * TP + t0c_ + (ok_ ? c16_ * 8 : 0)); if (!ok_) rv[i_] = z4; } } while (0)
#define STOREV() do { _Pragma("unroll") for (int i_ = 0; i_ < 2; ++i_) { const int id_ = tidc + 512 * i_, row_ = id_ >> 4, c16_ = id_ & 15; *(LAS u32x4*)(VTs + row_ * 272 + c16_ * 16) = rv[i_]; } } while (0)
                    { const int tidc = tid; LOADQK(0, 0); LOADV(0); }
                    const int lt = w >> 1, ei = w & 1;
                    LAS float* SQ = (LAS float*)(lds + 120832);
                    const bool il = (item == bid);
                    const int nel = il ? 64 * ((bid < NS * 4 ? 1 : 0) + (bid + G < NS * 4 ? 1 : 0)) : 0;
                    int sn = 0; f32x4 sv = {0.f, 0.f, 0.f, 0.f}, o4 = {0.f, 0.f, 0.f, 0.f};
                    if (il) {
                        for (int it = 0; it * 64 < nel; ++it) { const int si = bid + it * G, ss_ = si >> 2, hh_ = si & 3;
                            SQ[it * 1024 + tid] = bf2f(((tid >> 8) ? Kb : Qb)[(size_t)(MP + ss_) * D + hh_ * 256 + (tid & 255)]);
                            SQ[it * 1024 + 512 + tid] = VS[(size_t)ss_ * HV + hh_ * 512 + tid]; }
                    }
#define RET_PROC(J, VAL) { const int j_ = (J), it_ = j_ >> 6, d_ = dg_ * 64 + (j_ & 63), si_ = bid + it_ * G; \
        LAS float* q_ = SQ + it_ * 1024; const float kd_ = q_[256 + d_], qd_ = q_[d_]; const f32x4 v_ = *(const LAS f32x4*)(q_ + 512 + e4_); \
        const float gam_ = 1.f - __builtin_amdgcn_exp2f(-(float)(5 + (si_ & 3))); \
        const f32x4 n_ = (VAL) * gam_ + v_ * kd_; __builtin_nontemporal_store(n_, (f32x4*)(Ss_out + ((size_t)si_ * 256 + d_) * 512 + e4_)); \
        o4 = o4 + n_ * qd_; \
        if ((j_ & 63) == 63) { const float r0_ = sum4(o4[0]), r1_ = sum4(o4[1]), r2_ = sum4(o4[2]), r3_ = sum4(o4[3]); \
            if (dg_ == 0) { u32x2 w_; w_.x = cvt_pk_bf16(r0_, r1_); w_.y = cvt_pk_bf16(r2_, r3_); *(u32x2*)(OB + (size_t)(MP + (si_ >> 2)) * HV + (si_ & 3) * 512 + e4_) = w_; } \
            o4 = (f32x4){0.f, 0.f, 0.f, 0.f}; } }
#define RET_SRC(J) ((const f32x4*)(S0in + ((size_t)(bid + ((J) >> 6) * G) * 256 + dg_ * 64 + ((J) & 63)) * 512 + e4_))
#define RET_SLOT() do { if (sn <= nel) { int tq_ = tid; asm volatile("" : "+v"(tq_)); const int dg_ = tq_ & 3, e4_ = (tq_ >> 2) * 4; \
        if (sn >= 1) RET_PROC(sn - 1, sv) \
        if (sn < nel) sv = __builtin_nontemporal_load(RET_SRC(sn)); \
        ++sn; } } while (0)
                    __syncthreads();
#pragma unroll 1
                    for (int c = 0; c < 17; ++c) {
                        const int t0 = RET_T0(c), L = RET_L(c);
                        int tl_ = tid; asm volatile("" : "+v"(tl_));
                        const int tidc = tl_, l32 = tidc & 31, hi = (tidc >> 5) & 1, lrow = 32 * lt + l32, erow = 32 * ei + l32;
                        const bool act = 32 * lt < L;
                        f32x16 accP[2], aX;
#pragma unroll
                        for (int i = 0; i < 16; ++i) { accP[0][i] = 0.f; accP[1][i] = 0.f; aX[i] = 0.f; }
#pragma unroll
                        for (int dh = 0; dh < 2; ++dh) {
                            STOREQK(); if (dh == 0) STOREV();
                            if (dh == 0) LOADQK(c, 1); else if (c < 16) { LOADQK(c + 1, 0); LOADV(c + 1); }
                            __syncthreads();
                            RET_SLOT();
                            if (act) {
                                const LAS unsigned char* qrow = QH + lrow * 272 + 16 * hi;
#pragma unroll
                                for (int j = 0; j < 2; ++j) { const int mt = 2 * (w & 1) + j;
                                    if (mt <= lt && 32 * mt < L) { const LAS unsigned char* krow = KH + (32 * mt + l32) * 272 + 16 * hi;
#pragma unroll 4
                                        for (int s = 0; s < 8; ++s) { const bf16x8 kf = *(const LAS bf16x8*)(krow + 32 * s), qf = *(const LAS bf16x8*)(qrow + 32 * s); accP[j] = MFMA32(kf, qf, accP[j]); } } }
                                const LAS unsigned char* srow = STb + erow * 528 + 256 * dh + 16 * hi;
#pragma unroll 4
                                for (int s = 0; s < 8; ++s) { const bf16x8 sf = *(const LAS bf16x8*)(srow + 32 * s), qf = *(const LAS bf16x8*)(qrow + 32 * s); aX = MFMA32(sf, qf, aX); }
                            }
                            __syncthreads();
                            RET_SLOT();
                        }
                        bf16x8 kc[8];
                        { const bf16* kp = ktd + (size_t)(32 * w + l32) * TP + t0 + 8 * hi; const int nkc = L >> 4;
#pragma unroll
                          for (int s = 0; s < 8; ++s) kc[s] = *(const bf16x8*)(kp + (s < nkc ? 16 * s : 0)); }
                        if (act) {
#pragma unroll
                            for (int j = 0; j < 2; ++j) { const int mt = 2 * (w & 1) + j;
                                if (mt <= lt && 32 * mt < L) {
#pragma unroll
                                    for (int gq = 0; gq < 4; ++gq) { float o[4];
#pragma unroll
                                        for (int i = 0; i < 4; ++i) { const int mm = 32 * mt + 8 * gq + 4 * hi + i; const int df = lrow - mm;
                                            o[i] = df >= 0 ? accP[j][gq * 4 + i] * __builtin_amdgcn_exp2f((float)df * lg2) : 0.f; }
                                        u32x2 wv; wv.x = cvt_pk_bf16(o[0], o[1]); wv.y = cvt_pk_bf16(o[2], o[3]);
                                        *(LAS u32x2*)(KH + lrow * 272 + (32 * mt + 8 * gq + 4 * hi) * 2) = wv; } } }
                        }
                        __syncthreads();
                        RET_SLOT();
                        if (act) {
                            f32x16 aI;
#pragma unroll
                            for (int i = 0; i < 16; ++i) aI[i] = 0.f;
                            const int nk = (32 * (lt + 1) < L ? 32 * (lt + 1) : L) >> 4;
#pragma unroll 2
                            for (int s = 0; s < nk; ++s) { const bf16x8 fa = *(const LAS bf16x8*)(VTs + erow * 272 + (16 * s + 8 * hi) * 2), fb = *(const LAS bf16x8*)(KH + lrow * 272 + (16 * s + 8 * hi) * 2); aI = MFMA32(fa, fb, aI); }
                            const float qd = __builtin_amdgcn_exp2f((float)(lrow + 1) * lg2);
                            if (lrow < L) {
                                bf16* op = OB + (size_t)(b * TP + t0 + lrow) * HV + h * 512 + es * 64 + 32 * ei + 4 * hi;
#pragma unroll
                                for (int gq = 0; gq < 4; ++gq) {
                                    u32x2 wv; wv.x = cvt_pk_bf16(aI[gq * 4 + 0] + qd * aX[gq * 4 + 0], aI[gq * 4 + 1] + qd * aX[gq * 4 + 1]);
                                    wv.y = cvt_pk_bf16(aI[gq * 4 + 2] + qd * aX[gq * 4 + 2], aI[gq * 4 + 3] + qd * aX[gq * 4 + 3]);
                                    *(u32x2*)(op + 8 * gq) = wv; }
                            }
                        }
                        {
                            const float gl = __builtin_amdgcn_exp2f((float)L * lg2);
                            S2[0] = S2[0] * gl; S2[1] = S2[1] * gl;
                            const int nkc = L >> 4;
#pragma unroll
                            for (int s = 0; s < 8; ++s) if (s < nkc) {
                                const bf16x8 fb0 = *(const LAS bf16x8*)(VTs + l32 * 272 + (16 * s + 8 * hi) * 2), fb1 = *(const LAS bf16x8*)(VTs + (32 + l32) * 272 + (16 * s + 8 * hi) * 2);
                                S2[0] = MFMA32(kc[s], fb0, S2[0]); S2[1] = MFMA32(kc[s], fb1, S2[1]); }
                        }
                        __syncthreads();
                        RET_SLOT();
                        if (c < 16) {
#pragma unroll
                            for (int e2 = 0; e2 < 2; ++e2)
#pragma unroll
                                for (int gq = 0; gq < 4; ++gq) {
                                    u32x2 wv; wv.x = cvt_pk_bf16(S2[e2][gq * 4 + 0], S2[e2][gq * 4 + 1]); wv.y = cvt_pk_bf16(S2[e2][gq * 4 + 2], S2[e2][gq * 4 + 3]);
                                    *(LAS u32x2*)(STb + (32 * e2 + l32) * 528 + (32 * w + 8 * gq + 4 * hi) * 2) = wv; }
                        }
                    }
#undef LOADQK
#undef STOREQK
#undef LOADV
#undef STOREV
                    if (sn <= nel && nel > 0) { int tq_ = tid; asm volatile("" : "+v"(tq_)); const int dg_ = tq_ & 3, e4_ = (tq_ >> 2) * 4;
                        if (sn >= 1) RET_PROC(sn - 1, sv)
#pragma unroll 1
                        for (int j0 = sn; j0 < nel; j0 += 8) { f32x4 bt[8];
#pragma unroll
                            for (int u_ = 0; u_ < 8; ++u_) { const int jj = j0 + u_ < nel ? j0 + u_ : nel - 1; bt[u_] = __builtin_nontemporal_load(RET_SRC(jj)); }
#pragma unroll
                            for (int u_ = 0; u_ < 8; ++u_) if (j0 + u_ < nel) RET_PROC(j0 + u_, bt[u_])
                        }
                        sn = nel + 1;
                    }
#undef RET_PROC
#undef RET_SRC
#undef RET_SLOT
                    {
                        float* sp = Sp_out + (size_t)((b * 4 + h) * 256) * 512 + es * 64 + l32;
#pragma unroll
                        for (int e2 = 0; e2 < 2; ++e2)
#pragma unroll
                            for (int r = 0; r < 16; ++r) sp[(size_t)(32 * w + crow(r, hi)) * 512 + 32 * e2] = S2[e2][r];
                    }
                    __syncthreads();
                }
                {
                    LAS float* qk = (LAS float*)(lds + 69632);
                    LAS float* ored = (LAS float*)(lds + 69632 + 2048);
                    for (int item = bid + (bid < 256 ? 2 * G : 0); item < NS * 4; item += G) {
                        const int s = item >> 2, h = item & 3;
                        const float gamma = 1.f - __builtin_amdgcn_exp2f(-(float)(5 + h));
                        __syncthreads();
                        { const int which = tid >> 8, dd = tid & 255; qk[tid] = bf2f((which ? Kb : Qb)[(size_t)(MP + s) * D + h * 256 + dd]); }
                        __syncthreads();
                        const int e4 = (tid & 127) * 4, dg = tid >> 7;
                        const f32x4 v4 = *(const f32x4*)(VS + (size_t)s * HV + h * 512 + e4);
                        const float* sin_ = S0in + (size_t)(s * 4 + h) * 256 * 512 + e4; float* sout = Ss_out + (size_t)(s * 4 + h) * 256 * 512 + e4;
                        f32x4 o4 = {0.f, 0.f, 0.f, 0.f};
#pragma unroll 16
                        for (int i = 0; i < 64; ++i) { const int d = dg * 64 + i;
                            const f32x4 sv = __builtin_nontemporal_load((const f32x4*)(sin_ + (size_t)d * 512));
                            const f32x4 sn = sv * gamma + v4 * qk[256 + d];
                            __builtin_nontemporal_store(sn, (f32x4*)(sout + (size_t)d * 512));
                            o4 = o4 + sn * qk[d]; }
                        *(LAS f32x4*)(ored + dg * 512 + e4) = o4;
                        __syncthreads();
                        if (tid < 128) { const f32x4 r = *(LAS f32x4*)(ored + e4) + *(LAS f32x4*)(ored + 512 + e4) + *(LAS f32x4*)(ored + 1024 + e4) + *(LAS f32x4*)(ored + 1536 + e4);
                            u32x2 wv; wv.x = cvt_pk_bf16(r[0], r[1]); wv.y = cvt_pk_bf16(r[2], r[3]);
                            *(u32x2*)(OB + (size_t)(MP + s) * HV + h * 512 + e4) = wv; }
                    }
                }
            }
            PH_END
            PH_BEGIN(3)
            {
                for (int m = gw; m < M; m += 2 * NGW) {
                    const int m1 = (m + NGW < M) ? m + NGW : m;
                    u32x4 ov[2][4]; float ss[2] = {0.f, 0.f};
#pragma unroll
                    for (int q = 0; q < 2; ++q) { const u32x4* op = (const u32x4*)(OB + (size_t)(q ? m1 : m) * HV) + lane * 4;
#pragma unroll
                        for (int j = 0; j < 4; ++j) ov[q][j] = op[j]; }
#pragma unroll
                    for (int q = 0; q < 2; ++q) {
#pragma unroll
                        for (int j = 0; j < 4; ++j)
#pragma unroll
                            for (int i = 0; i < 4; ++i) { const float x0 = __uint_as_float(ov[q][j][i] << 16), x1 = __uint_as_float(ov[q][j][i] & 0xffff0000u); ss[q] += x0 * x0 + x1 * x1; }
                        ss[q] = sum16(ss[q]); }
#pragma unroll
                    for (int q = 0; q < 2; ++q) { if (q == 1 && m1 == m) break;
                        const int mr = q ? m1 : m; const float rs = 1.0f / sqrtf(ss[q] * (1.f / 512.f) + EPS);
                        const u32x4* gp = (const u32x4*)(SG + (size_t)mr * HV) + lane * 4; u32x4* yp = (u32x4*)(Y + (size_t)mr * HV) + lane * 4;
#pragma unroll
                        for (int j = 0; j < 4; ++j) { const u32x4 gv = gp[j]; u32x4 wv;
#pragma unroll
                            for (int i = 0; i < 4; ++i) { const float x0 = __uint_as_float(ov[q][j][i] << 16), x1 = __uint_as_float(ov[q][j][i] & 0xffff0000u);
                                const float g0 = __uint_as_float(gv[i] << 16), g1 = __uint_as_float(gv[i] & 0xffff0000u);
                                wv[i] = cvt_pk_bf16(x0 * rs * g0, x1 * rs * g1); }
                            yp[j] = wv; } }
                }
            }
            PH_END
        } else if (kind == 1) {
            bf16* XM = (bf16*)(ws + WB_XM); float* RKV = (float*)(ws + WB_RKV); bf16* L1 = (bf16*)(ws + WB_L1); float* DAG = (float*)(ws + WB_DAG);
            float* YR = (float*)(ws + WB_YR); bf16* Y = (bf16*)(ws + WB_Y);
            outA = Y; outB = (const bf16*)(ws + WS_RWO); outK = D;
            PH_BEGIN(4)
            {
                pg8::Gemm g{XM, (const bf16*)(ws + WS_RW1), 6 * M, 3840, D}; StackOrder S; S.base.init(M, 3840, G, bid); S.mode = 1;
                EpiRw1 E{RKV, L1};
                pg8::gemm_phase<EpiRw1, StackOrder, true, true>(lds, g, S, E);
            }
            PH_END
            PH_BEGIN(4)
            {
                int K2 = 256; asm volatile("" : "+s"(K2));
                pg8::Gemm g{L1, (const bf16*)(ws + WS_RW2), 3 * M, 3072, K2}; StackOrder S; S.base.init(M, 3072, G, bid); S.mode = 2;
                EpiRw2 E{DAG, a.in[15], a.in[18]};
                pg8::gemm_phase<EpiRw2, StackOrder, true, true>(lds, g, S, E);
            }
            PH_END
            PH_BEGIN(2)
            {
                const float *Rr = RKV, *Kr = RKV + (size_t)M * D, *Vr = RKV + (size_t)2 * M * D, *DEC = DAG, *AAp = DAG + (size_t)M * D;
                const float *k_k = a.in[23], *k_a = a.in[24]; float* RKb = (float*)(ws + WB_L1);
                LAS float* ob = (LAS float*)lds;
                const int pair = (tid >> 4) & 15, p = tid & 15; const bool cw = tid < 256;
                const int st_ld = tid >> 5, kq = tid & 31;
                for (int item = bid; item < 2 * NB * 32; item += G) {
                    const int il_ = item & 255, itm = (G == 256) ? ((item & 256) | ((((il_ & 7) << 4) + (il_ >> 4)) << 1) | ((il_ >> 3) & 1)) : item;
                    const int seq = itm >> 5, h = (itm >> 1) & 15, half = itm & 1;
                    const bool indep = seq >= NB; const int s0 = (seq - NB) * 16;
                    const int T = indep ? 16 : TP; const int rowbase = indep ? MP + s0 : seq * TP;
                    const int vrow = half * 32 + 2 * pair, ch = h * 64;
                    f32x4 Sa = (f32x4){0.f, 0.f, 0.f, 0.f}, Sb = Sa;
                    const float* sin_ = a.in[4] + (size_t)(s0 * 16 + h) * 4096 + vrow * 64 + 4 * p; float* sout_ = out + O_WKS + (size_t)(s0 * 16 + h) * 4096 + vrow * 64 + 4 * p;
                    const f32x2 rk2 = *(const f32x2*)(a.in[25] + ch + 2 * kq);
                    const f32x2 kk2 = *(const f32x2*)(k_k + ch + 2 * kq), ka2 = *(const f32x2*)(k_a + ch + 2 * kq);
                    f32x2 lr, lk, lv, ld, la;
                    { const int t = st_ld; const bool ok = t < T; const size_t off = (size_t)(rowbase + (ok ? t : 0)) * D + ch + 2 * kq;
                      lr = *(const f32x2*)(Rr + off); lk = *(const f32x2*)(Kr + off); lv = *(const f32x2*)(Vr + off); ld = *(const f32x2*)(DEC + off); la = *(const f32x2*)(AAp + off); }
                    const int nch = (T + 15) >> 4;
                    __syncthreads();
#pragma unroll 1
                    for (int cidx = 0; cidx < nch; ++cidx) {
                        LAS float* B = ob + (cidx & 1) * 6144;
                        {
                            f32x2 kkv = lk * kk2; float ssq = kkv.x * kkv.x + kkv.y * kkv.y;
                            ssq = sum16(ssq); { const int si = __builtin_bit_cast(int, ssq); ssq += __builtin_bit_cast(float, __builtin_amdgcn_ds_swizzle(si, 0x401F)); }
                            const float nrm = fmaxf(sqrtf(ssq), 1e-12f); kkv = kkv * (1.f / nrm);
                            const f32x2 km = lk * (1.f + (la - 1.f) * ka2), kav = kkv * la;
                            { float rkp = lr.x * km.x * rk2.x + lr.y * km.y * rk2.y; rkp = sum16(rkp); { const int si = __builtin_bit_cast(int, rkp); rkp += __builtin_bit_cast(float, __builtin_amdgcn_ds_swizzle(si, 0x401F)); }
                              const int tt = cidx * 16 + st_ld; if (kq == 0 && half == 0 && tt < T) RKb[(size_t)(rowbase + tt) * 16 + h] = rkp; }
                            const int o = st_ld * 64 + 2 * kq;
                            *(LAS f32x2*)(B + o) = ld; *(LAS f32x2*)(B + 1024 + o) = kkv; *(LAS f32x2*)(B + 2048 + o) = kav; *(LAS f32x2*)(B + 3072 + o) = km; *(LAS f32x2*)(B + 4096 + o) = lr; *(LAS f32x2*)(B + 5120 + o) = lv;
                        }
                        if (cidx + 1 < nch) { const int t = (cidx + 1) * 16 + st_ld; const bool ok = t < T; const size_t off = (size_t)(rowbase + (ok ? t : 0)) * D + ch + 2 * kq;
                            lr = *(const f32x2*)(Rr + off); lk = *(const f32x2*)(Kr + off); lv = *(const f32x2*)(Vr + off); ld = *(const f32x2*)(DEC + off); la = *(const f32x2*)(AAp + off); }
                        __syncthreads();
                        const int t0 = cidx * 16;
                        f32x2 ykeep = {0.f, 0.f}; f32x4 nSa = Sa, nSb = Sb;
#define SCAN_STEP(st, IND) { if (IND) { Sa = nSa; Sb = nSb; const int sn_ = (st) < 15 ? (st) + 1 : 15; nSa = *(const f32x4*)(sin_ + (size_t)sn_ * 65536); nSb = *(const f32x4*)(sin_ + (size_t)sn_ * 65536 + 64); }     \
                            const LAS float* bs = B + (st) * 64 + 4 * p; \
                            const f32x4 w4 = *(const LAS f32x4*)bs, kk4 = *(const LAS f32x4*)(bs + 1024), ka4 = *(const LAS f32x4*)(bs + 2048), km4 = *(const LAS f32x4*)(bs + 3072), r4 = *(const LAS f32x4*)(bs + 4096); \
                            const f32x2 vv = *(const LAS f32x2*)(B + 5120 + (st) * 64 + vrow); \
                            float sa0 = (Sa.x * kk4.x + Sa.y * kk4.y) + (Sa.z * kk4.z + Sa.w * kk4.w), sa1 = (Sb.x * kk4.x + Sb.y * kk4.y) + (Sb.z * kk4.z + Sb.w * kk4.w); \
                            sa0 = -sum16(sa0); sa1 = -sum16(sa1); \
                            Sa = Sa * w4 + ka4 * sa0 + km4 * vv.x; Sb = Sb * w4 + ka4 * sa1 + km4 * vv.y; \
                            float y0 = (Sa.x * r4.x + Sa.y * r4.y) + (Sa.z * r4.z + Sa.w * r4.w), y1 = (Sb.x * r4.x + Sb.y * r4.y) + (Sb.z * r4.z + Sb.w * r4.w); \
                            y0 = sum16(y0); y1 = sum16(y1); \
                            if (p == (st)) { ykeep.x = y0; ykeep.y = y1; } \
                            if (IND) { *(f32x4*)(sout_ + (size_t)(st) * 65536) = Sa; *(f32x4*)(sout_ + (size_t)(st) * 65536 + 64) = Sb; } }
                        if (cw) {
                            if (!indep) {
#pragma unroll
                                for (int st = 0; st < 16; ++st) SCAN_STEP(st, false)
                            } else {
                                nSa = *(const f32x4*)sin_; nSb = *(const f32x4*)(sin_ + 64);
#pragma unroll 1
                                for (int st = 0; st < 16; ++st) SCAN_STEP(st, true)
                            }
                            *(f32x2*)(YR + (size_t)(rowbase + t0 + p) * D + ch + vrow) = ykeep;
                        }
#undef SCAN_STEP
                    }
                    if (!indep && cw) { float* so = out + O_WKP + (size_t)(seq * 16 + h) * 4096 + vrow * 64 + 4 * p; *(f32x4*)so = Sa; *(f32x4*)(so + 64) = Sb; }
                    __syncthreads();
                }
            }
            PH_END
            PH_BEGIN(3)
            {
                const float *Vr = RKV + (size_t)2 * M * D; const bf16* GB = (const bf16*)(DAG + (size_t)2 * M * D); const float* RKb = (const float*)(ws + WB_L1);
                const float *ln_g = a.in[26], *ln_b = a.in[27];
                for (int m = gw; m < M; m += NGW) {
                    const size_t off = (size_t)m * D + lane * 16; const int c0 = lane * 16;
                    f32x4 y[4]; float s1 = 0.f;
                    const float rk = RKb[(size_t)m * 16 + (lane >> 2)];
                    const u32x4 g0 = *(const u32x4*)(GB + off), g1 = *(const u32x4*)(GB + off + 8);
#pragma unroll
                    for (int j = 0; j < 4; ++j) { y[j] = *(const f32x4*)(YR + off + 4 * j); s1 += (y[j].x + y[j].y) + (y[j].z + y[j].w); }
                    s1 = sum4(s1);
                    const float mu = s1 * (1.f / 64.f); float s2 = 0.f;
#pragma unroll
                    for (int j = 0; j < 4; ++j) { const f32x4 d = y[j] - mu; s2 += (d.x * d.x + d.y * d.y) + (d.z * d.z + d.w * d.w); }
                    s2 = sum4(s2);
                    const float rstd = 1.0f / sqrtf(s2 * (1.f / 64.f) + 64e-5f);
                    u32x4 w0, w1;
#pragma unroll
                    for (int j = 0; j < 4; ++j) { const f32x4 lg = *(const f32x4*)(ln_g + c0 + 4 * j), lb = *(const f32x4*)(ln_b + c0 + 4 * j), v = *(const f32x4*)(Vr + off + 4 * j);
                        const unsigned ga = j == 0 ? g0.x : (j == 1 ? g0.z : (j == 2 ? g1.x : g1.z)), gb = j == 0 ? g0.y : (j == 1 ? g0.w : (j == 2 ? g1.y : g1.w));
                        const f32x4 g = {__uint_as_float(ga << 16), __uint_as_float(ga & 0xffff0000u), __uint_as_float(gb << 16), __uint_as_float(gb & 0xffff0000u)};
                        const f32x4 o = ((y[j] - mu) * rstd * lg + lb + v * rk) * g;
                        const unsigned a0 = cvt_pk_bf16(o[0], o[1]), a1 = cvt_pk_bf16(o[2], o[3]);
                        if (j == 0) { w0.x = a0; w0.y = a1; } else if (j == 1) { w0.z = a0; w0.w = a1; } else if (j == 2) { w1.x = a0; w1.y = a1; } else { w1.z = a0; w1.w = a1; } }
                    u32x4* yp = (u32x4*)(Y + off); yp[0] = w0; yp[1] = w1;
                }
            }
            PH_END
        } else {
            bf16* BC = (bf16*)(ws + CB_BC); float* U = (float*)(ws + CB_U); bf16* A2 = (bf16*)(ws + CB_A2);
            outA = A2; outB = (const bf16*)(ws + WS_COUT); outK = D;
            PH_BEGIN(4)
            {
                pg8::Gemm g{XN, (const bf16*)(ws + WS_CIN), M, 3072, D}; pg8::StaticOrder S; S.init(M, 3072, G, bid);
                EpiConvIn E{BC, U};
                pg8::gemm_phase<EpiConvIn, pg8::StaticOrder, true, true>(lds, g, S, E);
            }
            PH_END
            PH_BEGIN(3)
            {
                const float* cw = a.in[30]; const float* cst = a.in[5];
                for (size_t e = (size_t)bid * 512 + tid; e < (size_t)M * 256; e += (size_t)G * 512) {
                    const int m = (int)(e >> 8), c = (int)(e & 255) * 4;
                    const f32x4 w0 = *(const f32x4*)(cw + c), w1 = *(const f32x4*)(cw + D + c), w2 = *(const f32x4*)(cw + 2 * D + c);
                    const f32x4 u2 = *(const f32x4*)(U + (size_t)m * D + c); f32x4 u1, u0;
                    if (m < MP) { const int b = m / TP, t = m - b * TP;
                        u1 = t >= 1 ? *(const f32x4*)(U + (size_t)(m - 1) * D + c) : (f32x4){0.f, 0.f, 0.f, 0.f};
                        u0 = t >= 2 ? *(const f32x4*)(U + (size_t)(m - 2) * D + c) : (f32x4){0.f, 0.f, 0.f, 0.f};
                        if (t >= TP - 2) *(f32x4*)(out + O_CVP + ((size_t)b * 2 + (t - (TP - 2))) * D + c) = u2;
                    } else { const int s = m - MP;
                        u0 = *(const f32x4*)(cst + ((size_t)s * 2) * D + c); u1 = *(const f32x4*)(cst + ((size_t)s * 2 + 1) * D + c);
                        *(f32x4*)(out + O_CVS + ((size_t)s * 2) * D + c) = u1; *(f32x4*)(out + O_CVS + ((size_t)s * 2 + 1) * D + c) = u2; }
                    const f32x4 yv = w0 * u0 + w1 * u1 + w2 * u2;
                    const u32x2 bb = *(const u32x2*)(BC + (size_t)m * D + c);
                    const float b0 = __uint_as_float(bb.x << 16), b1 = __uint_as_float(bb.x & 0xffff0000u), b2 = __uint_as_float(bb.y << 16), b3 = __uint_as_float(bb.y & 0xffff0000u);
                    u32x2 wv; wv.x = cvt_pk_bf16(b0 * yv[0], b1 * yv[1]); wv.y = cvt_pk_bf16(b2 * yv[2], b3 * yv[3]);
                    *(u32x2*)(A2 + (size_t)m * D + c) = wv;
                }
            }
            PH_END
        }
        PH_BEGIN(7)
        {
            pg8::Gemm g{outA, outB, M, D, outK}; TailOrder S; S.init(D, outK, G, bid);
            EpiResid E{H, (rep_ & 1) ? -1.f : 1.f};
            pg8::gemm_phase<EpiResid, TailOrder, true, true>(lds, g, S, E);
        }
        PH_END
        PH_BEGIN(3)
        {
            const float* gain = a.in[9] + (size_t)layer * D;
            for (int m = gw; m < M; m += 2 * NGW) { const int m1 = m + NGW; const bool has1 = m1 < M; f32x4 v0[4], v1[4]; rms_row2(H + (size_t)m * D, H + (size_t)(has1 ? m1 : m) * D, gain, lane, v0, v1); store_row_bf16(XN + (size_t)m * D, lane, v0); if (has1) store_row_bf16(XN + (size_t)m1 * D, lane, v1); }
        }
        PH_END
        bf16* ACT = (bf16*)(ws + MB_ACT);
        PH_BEGIN(4)
        {
            pg8::Gemm g{XN, (const bf16*)(ws + WS_M1 + (size_t)layer * al((size_t)FF * D * 2)), M, FF, D}; pg8::StaticOrder S; S.init(M, FF, G, bid);
            EpiRelu2 E{ACT};
            pg8::gemm_phase<EpiRelu2, pg8::StaticOrder, true, true>(lds, g, S, E);
        }
        PH_END
        PH_BEGIN(7)
        {
            pg8::Gemm g{ACT, (const bf16*)(ws + WS_M2 + (size_t)layer * al((size_t)FF * D * 2)), M, D, FF}; TailOrder S; S.init(D, FF, G, bid);
            EpiResid E{H, (rep_ & 1) ? -1.f : 1.f};
            pg8::gemm_phase<EpiResid, TailOrder, true, true>(lds, g, S, E);
        }
        PH_END
        PH_BEGIN(3)
        {
            if (layer == 3) {
                for (int m = gw; m < M; m += NGW) {
                    float* dst;
                    if (m < MP) { const int b = m / TP, t = m - b * TP; if (t < 16) continue; dst = out + O_YP + ((size_t)b * 2048 + (t - 16)) * D; }
                    else dst = out + O_YS + (size_t)(m - MP) * D;
                    f32x4 v[4]; rms_row(H + (size_t)m * D, a.in[10], lane, v);
                    f32x4* o = (f32x4*)dst + lane;
#pragma unroll
                    for (int j = 0; j < 4; ++j) o[64 * j] = v[j];
                }
            } else if ((layer + 1) % 3 == 1) {
                const float* gain = a.in[8] + (size_t)(layer + 1) * D; const float* mix = a.in[13];
                bf16* XM = (bf16*)(ws + WB_XM);
                f32x4 mrow[6][4];
#pragma unroll
                for (int q = 0; q < 6; ++q)
#pragma unroll
                    for (int j = 0; j < 4; ++j) mrow[q][j] = ((const f32x4*)(mix + (size_t)q * D) + lane)[64 * j];
                for (int m = gw; m < M; m += NGW) {
                    f32x4 xn[4], xp[4];
                    rms_row(H + (size_t)m * D, gain, lane, xn);
                    int b = 0, t = 0;
                    if (m < MP) { b = m / TP; t = m - b * TP;
                        if (t > 0) rms_row(H + (size_t)(m - 1) * D, gain, lane, xp);
                        else {
#pragma unroll
                            for (int j = 0; j < 4; ++j) xp[j] = (f32x4){0.f, 0.f, 0.f, 0.f}; }
                        if (t == TP - 1) { f32x4* o = (f32x4*)(out + O_SHP + (size_t)b * D) + lane;
#pragma unroll
                            for (int j = 0; j < 4; ++j) o[64 * j] = xn[j]; }
                    } else { const int s = m - MP; const f32x4* sp = (const f32x4*)(a.in[3] + (size_t)s * D) + lane; f32x4* o = (f32x4*)(out + O_SHS + (size_t)s * D) + lane;
#pragma unroll
                        for (int j = 0; j < 4; ++j) { xp[j] = sp[64 * j]; o[64 * j] = xn[j]; } }
#pragma unroll
                    for (int j = 0; j < 4; ++j) xp[j] = xp[j] - xn[j];
#pragma unroll
                    for (int q = 0; q < 6; ++q) { f32x4 v[4];
#pragma unroll
                        for (int j = 0; j < 4; ++j) v[j] = xn[j] + xp[j] * mrow[q][j];
                        store_row_bf16(XM + ((size_t)q * M + m) * D, lane, v); }
                }
            } else {
                const float* gain = a.in[8] + (size_t)(layer + 1) * D;
                for (int m = gw; m < M; m += 2 * NGW) { const int m1 = m + NGW; const bool has1 = m1 < M; f32x4 v0[4], v1[4]; rms_row2(H + (size_t)m * D, H + (size_t)(has1 ? m1 : m) * D, gain, lane, v0, v1); store_row_bf16(XN + (size_t)m * D, lane, v0); if (has1) store_row_bf16(XN + (size_t)m1 * D, lane, v1); }
            }
        }
        PH_END
    }
#undef PH_BEGIN
#undef PH_END
}

constexpr int N_PHASES = 33;

#ifndef REP0
#define REP0 1
#define REP1 1
#define REP2 1
#define REP3 1
#define REP4 1
#endif
#ifndef REP5
#define REP5 1
#endif
#ifndef REP7
#define REP7 1
#endif
#ifndef MK_MULTI
#define MK_MULTI 0
#endif

extern "C" void kernel_launch(void* const* d_in, const int* in_sizes, int n_in, void* d_out, int out_size, void* d_ws, size_t ws_size, hipStream_t stream) {
    static int grid = 0;
    if (grid == 0) {
        if (n_in != 34 || (size_t)out_size != O_END || ws_size < WS_TOTAL) { fprintf(stderr, "kernel_launch: unexpected shapes: n_in %d out %d ws %zu (need %zu)\n", n_in, out_size, ws_size, (size_t)WS_TOTAL); grid = -1; return; }
        int dev = 0, cus = 0, per_cu = 0;
        hipGetDevice(&dev); hipDeviceGetAttribute(&cus, hipDeviceAttributeMultiprocessorCount, dev);
        if (hipFuncSetAttribute((const void*)fwd_kernel, hipFuncAttributeMaxDynamicSharedMemorySize, LDS_BYTES) != hipSuccess) { fprintf(stderr, "kernel_launch: hipFuncSetAttribute failed\n"); grid = -1; return; }
        if (hipOccupancyMaxActiveBlocksPerMultiprocessor(&per_cu, (const void*)fwd_kernel, 512, LDS_BYTES) != hipSuccess || per_cu < 1) { fprintf(stderr, "kernel_launch: occupancy query says %d\n", per_cu); (void)hipGetLastError(); grid = -1; return; }
        grid = cus * 1;
    }
    if (grid < 0) return;
    if (hipMemsetAsync((char*)d_ws + WS_BAR, 0, 16384, stream) != hipSuccess) { fprintf(stderr, "kernel_launch: memset failed\n"); return; }
    KArgs a{};
    for (int i = 0; i < 34; ++i) a.in[i] = (const float*)d_in[i];
    a.out = (float*)d_out; a.ws = (unsigned char*)d_ws;
    { const int reps[8] = {REP0, REP1, REP2, REP3, REP4, REP5, 1, REP7}; for (int i = 0; i < 8; ++i) a.rep[i] = reps[i]; }
#if MK_MULTI
    for (int p = 0; p < N_PHASES; ++p) { a.ph_lo = p; a.ph_hi = p + 1; a.coop = 0; hipLaunchKernelGGL(fwd_kernel, dim3(grid), dim3(512), LDS_BYTES, stream, a); }
#else
    a.ph_lo = 0; a.ph_hi = N_PHASES; a.coop = 1;
    void* args[] = {&a};
    hipError_t e = hipLaunchCooperativeKernel((const void*)fwd_kernel, dim3(grid), dim3(512), args, LDS_BYTES, stream);
    if (e != hipSuccess) fprintf(stderr, "cooperative launch failed: %s (grid %d)\n", hipGetErrorString(e), grid);
#endif
}
```

```cpp
#include <hip/hip_runtime.h>
#include <hip/hip_cooperative_groups.h>
#include <cstdio>
#include <cstdint>
namespace cg = cooperative_groups;
namespace pg8 {
#define PG8_LAS __attribute__((address_space(3)))
typedef unsigned short bf16_t;
typedef short bf16x8 __attribute__((ext_vector_type(8)));
typedef float f32x4 __attribute__((ext_vector_type(4)));
typedef unsigned u32x4 __attribute__((ext_vector_type(4)));
constexpr int BM = 256, BK = 64, HALF = 128, HTB = HALF * BK * 2  , STAGE_BYTES = 8 * HTB, NXCD = 8, WGM = 8;

__host__ __device__ __forceinline__ int lds_byte(int r, int c) { const int st = (r >> 4) * 2 + (c >> 5), rr = r & 15, cc = c & 31, ob = rr * 64 + cc * 2; return st * 1024 + (ob ^ (((ob >> 9) & 1) << 5)); }
__host__ __device__ __forceinline__ void stage_rc(int b, int& R, int& C) { const int st = b / 1024, sb = b % 1024, swz = sb ^ (((sb >> 9) & 1) << 5); R = (st >> 1) * 16 + swz / 64; C = (st & 1) * 32 + (swz % 64) / 2; }
__host__ __device__ __forceinline__ int perm32(int rho) { const int n = rho >> 4, i = rho & 15; return 8 * (i >> 2) + 4 * n + (i & 3); }

struct Unit { int pm, pn, k0, nt; };
struct Gemm { const bf16_t* A; const bf16_t* Bt; int M, N, K; };

struct StaticOrder {
    int nM, nN, nwg, G, c;
    __host__ __device__ void init(int M, int N, int G_, int c_) { nM = M / BM; nN = N / BM; nwg = nM * nN; G = G_; c = c_; }
    __host__ __device__ __forceinline__ bool next(int i, Unit& u) const {
        const long L = (long)i * G + c; if (L >= nwg) return false;
        int wgid = (int)L; { const int q = nwg / NXCD, r = nwg % NXCD, xcd = wgid % NXCD, off = wgid / NXCD; wgid = (xcd < r ? xcd * (q + 1) : r * (q + 1) + (xcd - r) * q) + off; }
        const int nig = WGM * nN, gid = wgid / nig, fm = gid * WGM, gsz = (nM - fm) < WGM ? (nM - fm) : WGM;
        u.pm = fm + ((wgid % nig) % gsz); u.pn = (wgid % nig) / gsz; u.k0 = 0; u.nt = 0; return true;
    }
    __device__ __forceinline__ void a_ready(const Unit&) const {}
    __device__ __forceinline__ void done(const Unit&) const {}
};

__device__ __forceinline__ unsigned cvt_pk_bf16(float lo, float hi) { unsigned r; asm volatile("v_cvt_pk_bf16_f32 %0, %1, %2" : "=v"(r) : "v"(lo), "v"(hi)); return r; }
template <class Epi, class Sched, bool ALIGN_EPI = false, bool SP2 = false>
__device__ __forceinline__ void gemm_phase(PG8_LAS unsigned char* lds, const Gemm g, const Sched& S, const Epi& E) {
    int tid_ = threadIdx.x; asm volatile("" : "+v"(tid_));
    const int tid = tid_, wid = __builtin_amdgcn_readfirstlane(tid >> 6), lane = tid & 63, wr = wid >> 2, wc = wid & 3, fr = lane & 15, fq = lane >> 4;
    const int K = g.K, nt = K / BK;
    unsigned voffA[2], voffB[2];
#pragma unroll
    for (int i = 0; i < 2; ++i) { int R, C; stage_rc(tid * 16 + i * 8192, R, C); const int Rb = Epi::PERM ? ((R & ~31) + perm32(R & 31)) : R;
        voffA[i] = (unsigned)(R * K + C) * 2u; voffB[i] = (unsigned)(Rb * K + C) * 2u; }
    const size_t kstep = (size_t)(BK * 2);
    const size_t hstep = (size_t)HALF * K * 2;
    const size_t tstep = 2 * hstep;
    const unsigned ldsw = (unsigned)wid * 1024u;
    const int aoff = lds_byte(wr * 64 + fr, fq * 8), boff = lds_byte(wc * 32 + fr, fq * 8);
#define PG8_SA(b, h) (((b) * 2 + (h)) * HTB)
#define PG8_SB(b, h) ((4 + (b) * 2 + (h)) * HTB)
#define PG8_STAGE(bufoff, gbase, voff) do { _Pragma("unroll") for (int _i = 0; _i < 2; ++_i) \
        __builtin_amdgcn_global_load_lds((const unsigned*)((const char*)(gbase) + (voff)[_i]), (PG8_LAS unsigned*)(lds + (bufoff) + ldsw + _i * 8192), 16, 0, 0); } while (0)
#define PG8_LDA(dst, b, h) do { _Pragma("unroll") for (int m = 0; m < 4; ++m) _Pragma("unroll") for (int k = 0; k < 2; ++k) dst[m][k] = *(const PG8_LAS bf16x8*)(lds + PG8_SA(b, h) + aoff + m * 2048 + k * 1024); } while (0)
#define PG8_LDB(dst, b, h) do { _Pragma("unroll") for (int n = 0; n < 2; ++n) _Pragma("unroll") for (int k = 0; k < 2; ++k) dst[n][k] = *(const PG8_LAS bf16x8*)(lds + PG8_SB(b, h) + boff + n * 2048 + k * 1024); } while (0)
#define PG8_MMA(ai, bj, At, Bt) do { __builtin_amdgcn_s_setprio(1); _Pragma("unroll") for (int m = 0; m < 4; ++m) _Pragma("unroll") for (int n = 0; n < 2; ++n) _Pragma("unroll") for (int k = 0; k < 2; ++k) \
        acc[ai][bj][m][n] = __builtin_amdgcn_mfma_f32_16x16x32_bf16(Bt[n][k], At[m][k], acc[ai][bj][m][n], 0, 0, 0); __builtin_amdgcn_s_setprio(0); } while (0)
#define PG8_WAIT_V(n) asm volatile("s_waitcnt vmcnt(" #n ")" ::: "memory")
#define PG8_WAIT_L(n) asm volatile("s_waitcnt lgkmcnt(" #n ")" ::: "memory")
#define PG8_BAR __builtin_amdgcn_s_barrier()
#define PG8_SCHED __builtin_amdgcn_sched_barrier(0)
    Unit cur, nxt; int ui = 0;
    if (!S.next(0, cur)) return;
    f32x4 acc[2][2][4][2];
#pragma unroll
    for (int a = 0; a < 2; ++a)
#pragma unroll
        for (int b = 0; b < 2; ++b)
#pragma unroll
            for (int m = 0; m < 4; ++m)
#pragma unroll
                for (int n = 0; n < 2; ++n) acc[a][b][m][n] = (f32x4){0.f, 0.f, 0.f, 0.f};
    bf16x8 At[4][2], B0[2][2], B1[2][2];
    const char* cA = (const char*)g.A + (size_t)cur.pm * tstep + (size_t)cur.k0 * 2; const char* cB = (const char*)g.Bt + (size_t)cur.pn * tstep + (size_t)cur.k0 * 2;
    S.a_ready(cur);
    if constexpr (SP2) {
        PG8_STAGE(PG8_SB(0, 0), cB, voffB); PG8_STAGE(PG8_SB(0, 1), cB + hstep, voffB); PG8_STAGE(PG8_SA(0, 0), cA, voffA); PG8_STAGE(PG8_SA(0, 1), cA + hstep, voffA);
        if (wr == 1) PG8_BAR;
        PG8_WAIT_V(2); PG8_BAR;
        PG8_STAGE(PG8_SB(1, 0), cB + kstep, voffB); PG8_STAGE(PG8_SA(1, 0), cA + kstep, voffA); PG8_STAGE(PG8_SB(1, 1), cB + hstep + kstep, voffB);
        PG8_WAIT_V(6); PG8_BAR;
    } else {
        PG8_STAGE(PG8_SB(0, 0), cB, voffB); PG8_STAGE(PG8_SA(0, 0), cA, voffA); PG8_STAGE(PG8_SB(0, 1), cB + hstep, voffB); PG8_STAGE(PG8_SA(0, 1), cA + hstep, voffA);
        if (wr == 1) PG8_BAR;
        PG8_WAIT_V(4); PG8_BAR;
        PG8_STAGE(PG8_SB(1, 0), cB + kstep, voffB); PG8_STAGE(PG8_SA(1, 0), cA + kstep, voffA); PG8_STAGE(PG8_SB(1, 1), cB + hstep + kstep, voffB);
        PG8_WAIT_V(6); PG8_BAR;
    }
    for (;;) {
        const bool has_next = S.next(ui + 1, nxt);
        const char* nA = has_next ? (const char*)g.A + (size_t)nxt.pm * tstep + (size_t)nxt.k0 * 2 : cA; const char* nB = has_next ? (const char*)g.Bt + (size_t)nxt.pn * tstep + (size_t)nxt.k0 * 2 : cB;
        const int ntc = cur.nt ? cur.nt : nt;
        for (int t = 0; t < ntc; t += 2) {
            const bool last = (t == ntc - 2);
            const char* a1 = cA + (size_t)(t + 1) * kstep;
            const char* a2 = last ? nA : cA + (size_t)(t + 2) * kstep; const char* b2 = last ? nB : cB + (size_t)(t + 2) * kstep;
            const char* a3 = a2 + kstep; const char* b3 = b2 + kstep;
            if (last && has_next) S.a_ready(nxt);
            if constexpr (SP2) {
            PG8_LDB(B0, 0, 0); PG8_LDB(B1, 0, 1); PG8_SCHED; PG8_LDA(At, 0, 0); PG8_STAGE(PG8_SA(1, 1), a1 + hstep, voffA);
            PG8_WAIT_V(8); PG8_WAIT_L(0); PG8_BAR; PG8_MMA(0, 0, At, B0); PG8_MMA(0, 1, At, B1); PG8_BAR; PG8_SCHED;
            PG8_LDA(At, 0, 1); PG8_STAGE(PG8_SB(0, 0), b2, voffB); PG8_STAGE(PG8_SB(0, 1), b2 + hstep, voffB); PG8_STAGE(PG8_SA(0, 0), a2, voffA);
            PG8_WAIT_V(8); PG8_WAIT_L(0); PG8_BAR; PG8_MMA(1, 0, At, B0); PG8_MMA(1, 1, At, B1); PG8_BAR; PG8_SCHED;
            PG8_LDB(B0, 1, 0); PG8_LDB(B1, 1, 1); PG8_SCHED; PG8_LDA(At, 1, 0); PG8_STAGE(PG8_SA(0, 1), a2 + hstep, voffA);
            PG8_WAIT_V(8); PG8_WAIT_L(0); PG8_BAR; PG8_MMA(0, 0, At, B0); PG8_MMA(0, 1, At, B1); PG8_BAR; PG8_SCHED;
            PG8_LDA(At, 1, 1); PG8_STAGE(PG8_SB(1, 0), b3, voffB); PG8_STAGE(PG8_SB(1, 1), b3 + hstep, voffB); PG8_STAGE(PG8_SA(1, 0), a3, voffA);
            PG8_WAIT_V(8); PG8_WAIT_L(0); PG8_BAR; PG8_MMA(1, 0, At, B0); PG8_MMA(1, 1, At, B1); PG8_BAR; PG8_SCHED;
            } else {
            PG8_LDB(B0, 0, 0); PG8_SCHED; PG8_LDA(At, 0, 0); PG8_STAGE(PG8_SA(1, 1), a1 + hstep, voffA);
            PG8_WAIT_L(8); PG8_BAR; PG8_WAIT_L(0); PG8_MMA(0, 0, At, B0); PG8_BAR; PG8_SCHED;
            PG8_LDB(B1, 0, 1); PG8_STAGE(PG8_SB(0, 0), b2, voffB);
            PG8_BAR; PG8_WAIT_L(0); PG8_MMA(0, 1, At, B1); PG8_BAR;
            PG8_LDA(At, 0, 1); PG8_STAGE(PG8_SA(0, 0), a2, voffA);
            PG8_BAR; PG8_WAIT_L(0); PG8_MMA(1, 0, At, B0); PG8_BAR; PG8_SCHED;
            PG8_STAGE(PG8_SB(0, 1), b2 + hstep, voffB);
            PG8_WAIT_V(6); PG8_BAR; PG8_MMA(1, 1, At, B1); PG8_BAR;
            PG8_LDB(B0, 1, 0); PG8_SCHED; PG8_LDA(At, 1, 0); PG8_STAGE(PG8_SA(0, 1), a2 + hstep, voffA);
            PG8_WAIT_L(8); PG8_BAR; PG8_WAIT_L(0); PG8_MMA(0, 0, At, B0); PG8_BAR; PG8_SCHED;
            PG8_LDB(B1, 1, 1); PG8_STAGE(PG8_SB(1, 0), b3, voffB);
            PG8_BAR; PG8_WAIT_L(0); PG8_MMA(0, 1, At, B1); PG8_BAR;
            PG8_LDA(At, 1, 1); PG8_STAGE(PG8_SA(1, 0), a3, voffA);
            PG8_BAR; PG8_WAIT_L(0); PG8_MMA(1, 0, At, B0); PG8_BAR; PG8_SCHED;
            PG8_STAGE(PG8_SB(1, 1), b3 + hstep, voffB);
            PG8_WAIT_V(6); PG8_BAR; PG8_MMA(1, 1, At, B1); PG8_BAR;
            }
        }
        if constexpr (ALIGN_EPI) { if (wr == 0) PG8_BAR; }
        if constexpr (!Epi::AFTER_DRAIN) { E(acc, cur, wr, wc, fr, fq); S.done(cur); }
        if (!has_next) break;
#pragma unroll
        for (int a = 0; a < 2; ++a)
#pragma unroll
            for (int b = 0; b < 2; ++b)
#pragma unroll
                for (int m = 0; m < 4; ++m)
#pragma unroll
                    for (int n = 0; n < 2; ++n) acc[a][b][m][n] = (f32x4){0.f, 0.f, 0.f, 0.f};
        cur = nxt; cA = nA; cB = nB; ++ui;
        if constexpr (ALIGN_EPI) { if (wr == 1) PG8_BAR; }
    }
    PG8_WAIT_V(0);
    if constexpr (!ALIGN_EPI) { if (wr == 0) PG8_BAR; }
    PG8_BAR;
    if constexpr (Epi::AFTER_DRAIN) { E.fused(acc, cur, wr, wc, fr, fq, lds, wid, lane); S.done(cur); }
#undef PG8_SA
#undef PG8_SB
#undef PG8_STAGE
#undef PG8_LDA
#undef PG8_LDB
#undef PG8_MMA
#undef PG8_WAIT_V
#undef PG8_WAIT_L
#undef PG8_BAR
#undef PG8_SCHED
}
}

#define LAS __attribute__((address_space(3)))
typedef unsigned short bf16;
typedef short bf16x8 __attribute__((ext_vector_type(8)));
typedef float f32x4 __attribute__((ext_vector_type(4)));
typedef float f32x2 __attribute__((ext_vector_type(2)));
typedef float f32x16 __attribute__((ext_vector_type(16)));
typedef unsigned u32x4 __attribute__((ext_vector_type(4)));
typedef unsigned u32x2 __attribute__((ext_vector_type(2)));
using pg8::cvt_pk_bf16;
using pg8::Unit;

constexpr int D = 1024, NB = 8, TP = 2064, MP = NB * TP, NS = 128, M = MP + NS, NMT = M / 256;
constexpr int FF = 4096, NRI = 6144, HV = 2048;
constexpr float EPS = 1e-6f;
static_assert(M % 256 == 0, "rows");

constexpr size_t O_YP = 0, O_YS = 16777216, O_R0P = 16908288, O_R0S = 21102592, O_SHP = 88211456, O_SHS = 88219648,
                 O_WKP = 88350720, O_WKS = 88875008, O_CVP = 97263616, O_CVS = 97280000, O_R3P = 97542144, O_R3S = 101736448, O_END = 168845312;

constexpr size_t al(size_t x) { return (x + 4095) & ~(size_t)4095; }
constexpr size_t WS_RI0 = 4096, WS_RI1 = WS_RI0 + al((size_t)NRI * D * 2), WS_RO0 = WS_RI1 + al((size_t)NRI * D * 2), WS_RO1 = WS_RO0 + al((size_t)D * HV * 2),
                 WS_RW1 = WS_RO1 + al((size_t)D * HV * 2), WS_RW2 = WS_RW1 + al((size_t)3840 * D * 2), WS_RWO = WS_RW2 + al((size_t)3072 * 256 * 2),
                 WS_CIN = WS_RWO + al((size_t)D * D * 2), WS_COUT = WS_CIN + al((size_t)3072 * D * 2), WS_M1 = WS_COUT + al((size_t)D * D * 2),
                 WS_M2 = WS_M1 + 4 * al((size_t)FF * D * 2), WS_ROPE = WS_M2 + 4 * al((size_t)FF * D * 2), WS_H = WS_ROPE + al((size_t)2065 * 128 * 8),
                 WS_XN = WS_H + al((size_t)M * D * 4), WS_B = WS_XN + al((size_t)M * D * 2);
constexpr size_t RB_Q = WS_B, RB_K = RB_Q + al((size_t)M * D * 2), RB_KTD = RB_K + al((size_t)M * D * 2), RB_VT = RB_KTD + al((size_t)32 * 256 * TP * 2),
                 RB_VS = RB_VT + al((size_t)32 * 512 * TP * 2), RB_SG = RB_VS + al((size_t)NS * HV * 4), RB_OB = RB_SG + al((size_t)M * HV * 2),
                 RB_Y = RB_OB + al((size_t)M * HV * 2), RB_END = RB_Y + al((size_t)M * HV * 2);
constexpr size_t WB_XM = WS_B, WB_DAG = WS_B  , WB_RKV = WB_XM + al((size_t)6 * M * D * 2), WB_L1 = WB_RKV + al((size_t)3 * M * D * 4),
                 WB_YR = WB_L1 + al((size_t)3 * M * 256 * 2), WB_Y = WB_YR + al((size_t)M * D * 4), WB_END = WB_Y + al((size_t)M * D * 2);
static_assert((size_t)3 * M * D * 4 <= (size_t)6 * M * D * 2, "DAG fits over XM");
constexpr size_t CB_BC = WS_B, CB_U = CB_BC + al((size_t)M * D * 2), CB_A2 = CB_U + al((size_t)M * D * 4), CB_END = CB_A2 + al((size_t)M * D * 2);
constexpr size_t MB_ACT = WS_B, MB_END = MB_ACT + al((size_t)M * FF * 2);
constexpr size_t cmax(size_t a, size_t b) { return a > b ? a : b; }
constexpr size_t WS_END = cmax(cmax(RB_END, WB_END), cmax(CB_END, MB_END));

constexpr size_t WS_BAR = al(WS_END), WS_TOTAL = WS_BAR + 16384;
constexpr int LDS_BYTES = 147456, LDS_MISC = 131072 + 256;

#define LDS_WAIT() asm volatile("s_waitcnt lgkmcnt(0)" ::: "memory")
__device__ __forceinline__ float bf2f(bf16 x) { return __uint_as_float((unsigned)x << 16); }
__device__ __forceinline__ unsigned f2bf(float f) { unsigned u = __builtin_bit_cast(unsigned, f); return (u + 0x7fffu + ((u >> 16) & 1u)) >> 16; }
__device__ __forceinline__ unsigned pk2(float lo, float hi) { return f2bf(lo) | (f2bf(hi) << 16); }
__device__ __forceinline__ float wave_sum(float v) {
#pragma unroll
    for (int o = 1; o < 64; o <<= 1) v += __shfl_xor(v, o);
    return v;
}
template <int CTRL> __device__ __forceinline__ float dpp_add(float x) {
    const int xi = __builtin_bit_cast(int, x);
    const int yi = __builtin_amdgcn_update_dpp(0, xi, CTRL, 0xF, 0xF, false);
    return x + __builtin_bit_cast(float, yi);
}
__device__ __forceinline__ float sum4(float x) { x = dpp_add<0xB1>(x); x = dpp_add<0x4E>(x); return x; }
__device__ __forceinline__ float sum16(float x) { x = sum4(x); x = dpp_add<0x141>(x); x = dpp_add<0x140>(x); return x; }
__device__ __forceinline__ int crow(int r, int hi) { return (r & 3) + 8 * (r >> 2) + 4 * hi; }
#define MFMA32(a, b, c) __builtin_amdgcn_mfma_f32_32x32x16_bf16((a), (b), (c), 0, 0, 0)

struct StackOrder {
    pg8::StaticOrder base; int mode;
    __device__ __forceinline__ bool next(int i, Unit& u) const {
        if (!base.next(i, u)) return false;
        const int j = mode == 1 ? (u.pn < 12 ? (u.pn >> 2) : u.pn - 9) : (u.pn >> 2);
        u.pm += NMT * j; return true;
    }
    __device__ __forceinline__ void a_ready(const Unit&) const {}
    __device__ __forceinline__ void done(const Unit&) const {}
};

struct TailOrder {
    pg8::StaticOrder base; int nN, nsmall, G, c;
    __device__ __forceinline__ void init(int N, int K, int G_, int c_) { base.init(M - 256, N, G_, c_); nN = N / 256; nsmall = nN * (K / 256); G = G_; c = c_; }
    __device__ __forceinline__ bool next(int i, Unit& u) const {
        const long L = (long)i * G + c;
        if (L < base.nwg) return base.next(i, u);
        const int s = (int)(L - base.nwg); if (s >= nsmall) return false;
        u.pm = NMT - 1; u.pn = s % nN; u.k0 = (s / nN) * 256; u.nt = 4; return true;
    }
    __device__ __forceinline__ void a_ready(const Unit&) const {}
    __device__ __forceinline__ void done(const Unit&) const {}
};

#define EPI_LOOP_ROWS for (int ai = 0; ai < 2; ++ai) for (int m = 0; m < 4; ++m)
#define EPI_LOOP_COLS for (int bj = 0; bj < 2; ++bj) for (int n = 0; n < 2; ++n)

struct EpiResid {
    static constexpr bool PERM = false, AFTER_DRAIN = false;
    float* H; float sgn;
    __device__ __forceinline__ void operator()(const f32x4 (&acc)[2][2][4][2], const Unit& u, int wr, int wc, int fr, int fq) const {
        const int row0 = u.pm * 256 + wr * 64 + fr, col0 = u.pn * 256 + wc * 32 + 4 * fq;
        if (u.nt == 0) {
#pragma unroll
            EPI_LOOP_ROWS { float* rp = H + (size_t)(row0 + ai * 128 + m * 16) * D + col0;
#pragma unroll
                EPI_LOOP_COLS { f32x4* p = (f32x4*)(rp + bj * 128 + n * 16); *p = *p + acc[ai][bj][m][n] * sgn; } }
        } else {
#pragma unroll
            EPI_LOOP_ROWS { float* rp = H + (size_t)(row0 + ai * 128 + m * 16) * D + col0;
#pragma unroll
                EPI_LOOP_COLS { float* p = rp + bj * 128 + n * 16;
#pragma unroll
                    for (int i = 0; i < 4; ++i) __hip_atomic_fetch_add(p + i, acc[ai][bj][m][n][i] * sgn, __ATOMIC_RELAXED, __HIP_MEMORY_SCOPE_AGENT); } }
        }
    }
};

struct EpiRelu2 {
    static constexpr bool PERM = true, AFTER_DRAIN = false;
    bf16* O;
    __device__ __forceinline__ void operator()(const f32x4 (&acc)[2][2][4][2], const Unit& u, int wr, int wc, int fr, int fq) const {
#ifdef SKIP_EPIRELU2
        return;
#endif

        const int row0 = u.pm * 256 + wr * 64 + fr, col0 = u.pn * 256 + wc * 32 + 8 * fq;
#pragma unroll
        EPI_LOOP_ROWS { bf16* rp = O + (size_t)(row0 + ai * 128 + m * 16) * FF + col0;
#pragma unroll
            for (int bj = 0; bj < 2; ++bj) { f32x4 a = acc[ai][bj][m][0], b = acc[ai][bj][m][1];
                a = __builtin_elementwise_max(a, (f32x4){0.f, 0.f, 0.f, 0.f}); b = __builtin_elementwise_max(b, (f32x4){0.f, 0.f, 0.f, 0.f}); a = a * a; b = b * b;
                u32x4 w; w.x = cvt_pk_bf16(a[0], a[1]); w.y = cvt_pk_bf16(a[2], a[3]); w.z = cvt_pk_bf16(b[0], b[1]); w.w = cvt_pk_bf16(b[2], b[3]);
                *(u32x4*)(rp + bj * 128) = w; } }
    }
};

struct EpiRetIn {
    static constexpr bool PERM = false, AFTER_DRAIN = false;
    bf16 *Qb, *Kb, *KTD, *VT, *SG; float* VS; const float* rope;
    __device__ __forceinline__ void operator()(const f32x4 (&acc)[2][2][4][2], const Unit& u, int wr, int wc, int fr, int fq) const {
#ifdef SKIP_EPIRETIN
        return;
#endif

        const int row0 = u.pm * 256 + wr * 64 + fr, cin0 = wc * 32 + 4 * fq, pn = u.pn;
#pragma unroll
        for (int ai = 0; ai < 2; ++ai)
#pragma unroll
            for (int m = 0; m < 4; ++m) {
                const int r = row0 + ai * 128 + m * 16;
                const bool prm = r < MP; const int b = prm ? r / TP : 0; const int t = prm ? r - b * TP : 0; const int pidx = prm ? t : TP;
                if (pn < 8) {
                    const int h = pn & 3; const bool isk = pn >= 4;
                    float kdec = 1.f;
                    if (isk && prm) { const int e = t < 16 ? 15 - t : 127 - ((t - 16) & 127); kdec = __builtin_amdgcn_exp2f((float)e * __log2f(1.f - __builtin_amdgcn_exp2f(-(float)(5 + h)))); }
#pragma unroll
                    EPI_LOOP_COLS { const int d = bj * 128 + n * 16 + cin0; const f32x4 x = acc[ai][bj][m][n];
                        const f32x4 cs = *(const f32x4*)(rope + ((size_t)pidx * 128 + (d >> 1)) * 2);
                        f32x4 o; o[0] = x[0] * cs[0] - x[1] * cs[1]; o[1] = x[0] * cs[1] + x[1] * cs[0]; o[2] = x[2] * cs[2] - x[3] * cs[3]; o[3] = x[2] * cs[3] + x[3] * cs[2];
                        if (isk) o = o * 0.0625f;
                        u32x2 w; w.x = cvt_pk_bf16(o[0], o[1]); w.y = cvt_pk_bf16(o[2], o[3]);
                        *(u32x2*)((isk ? Kb : Qb) + (size_t)r * D + h * 256 + d) = w;
                        if (isk && prm) { bf16* kp = KTD + ((size_t)((b * 4 + h) * 256 + d)) * TP + t;
                            kp[0] = (bf16)f2bf(o[0] * kdec); kp[TP] = (bf16)f2bf(o[1] * kdec); kp[2 * TP] = (bf16)f2bf(o[2] * kdec); kp[3 * TP] = (bf16)f2bf(o[3] * kdec); } }
                } else if (pn < 16) {
                    const int h = (pn - 8) >> 1, e0 = ((pn - 8) & 1) * 256;
#pragma unroll
                    EPI_LOOP_COLS { const int e = e0 + bj * 128 + n * 16 + cin0; const f32x4 x = acc[ai][bj][m][n];
                        if (prm) { bf16* vp = VT + ((size_t)((b * 4 + h) * 512 + e)) * TP + t;
                            vp[0] = (bf16)f2bf(x[0]); vp[TP] = (bf16)f2bf(x[1]); vp[2 * TP] = (bf16)f2bf(x[2]); vp[3 * TP] = (bf16)f2bf(x[3]); }
                        else *(f32x4*)(VS + (size_t)(r - MP) * HV + h * 512 + e) = x; }
                } else {
                    const int c0 = (pn - 16) * 256;
#pragma unroll
                    EPI_LOOP_COLS { const int c = c0 + bj * 128 + n * 16 + cin0; const f32x4 x = acc[ai][bj][m][n]; f32x4 o;
#pragma unroll
                        for (int i = 0; i < 4; ++i) o[i] = x[i] / (1.f + __expf(-x[i]));
                        u32x2 w; w.x = cvt_pk_bf16(o[0], o[1]); w.y = cvt_pk_bf16(o[2], o[3]);
                        *(u32x2*)(SG + (size_t)r * HV + c) = w; }
                }
            }
    }
};

struct EpiRw1 {
    static constexpr bool PERM = false, AFTER_DRAIN = false;
    float* RKV; bf16* L1;
    __device__ __forceinline__ void operator()(const f32x4 (&acc)[2][2][4][2], const Unit& u, int wr, int wc, int fr, int fq) const {
#ifdef SKIP_EPIRW1
        return;
#endif

        const int pmr = u.pm % NMT, row0 = pmr * 256 + wr * 64 + fr, cin0 = wc * 32 + 4 * fq, pn = u.pn;
        if (pn < 12) {
            float* base = RKV + (size_t)(pn >> 2) * M * D + (pn & 3) * 256 + cin0;
#pragma unroll
            EPI_LOOP_ROWS { float* rp = base + (size_t)(row0 + ai * 128 + m * 16) * D;
#pragma unroll
                EPI_LOOP_COLS *(f32x4*)(rp + bj * 128 + n * 16) = acc[ai][bj][m][n]; }
        } else {
            const int j = pn - 12; bf16* base = L1 + (size_t)j * M * 256 + cin0;
#pragma unroll
            for (int ai = 0; ai < 2; ++ai)
#pragma unroll
                for (int m = 0; m < 4; ++m) { bf16* rp = base + (size_t)(row0 + ai * 128 + m * 16) * 256;
#pragma unroll
                    EPI_LOOP_COLS { const f32x4 x = acc[ai][bj][m][n]; f32x4 o;
#pragma unroll
                        for (int i = 0; i < 4; ++i) o[i] = j == 0 ? tanhf(x[i]) : (j == 1 ? x[i] : 1.f / (1.f + __expf(-x[i])));
                        u32x2 w; w.x = cvt_pk_bf16(o[0], o[1]); w.y = cvt_pk_bf16(o[2], o[3]);
                        *(u32x2*)(rp + bj * 128 + n * 16) = w; } }
        }
    }
};

struct EpiRw2 {
    static constexpr bool PERM = false, AFTER_DRAIN = false;
    float* DAG; const float *w0, *a0;
    __device__ __forceinline__ void operator()(const f32x4 (&acc)[2][2][4][2], const Unit& u, int wr, int wc, int fr, int fq) const {
#ifdef SKIP_EPIRW2
        return;
#endif
        const int pmr = u.pm % NMT, row0 = pmr * 256 + wr * 64 + fr, pn = u.pn, j = pn >> 2, col0 = (pn & 3) * 256 + wc * 32 + 4 * fq;
        float* base = DAG + (size_t)j * M * D + (size_t)row0 * D + col0;
        const float* bias = j == 0 ? w0 : a0;
#pragma unroll
        EPI_LOOP_COLS { const int cc = bj * 128 + n * 16;
            f32x4 bb = (f32x4){0.f, 0.f, 0.f, 0.f}; if (j < 2) bb = *(const f32x4*)(bias + col0 + cc);
#pragma unroll
            EPI_LOOP_ROWS { const f32x4 x = acc[ai][bj][m][n] + bb; f32x4 o;
                if (j == 0) {
#pragma unroll
                    for (int i = 0; i < 4; ++i) { const float z = -x[i]; const float sp = fmaxf(z, 0.f) + __logf(1.f + __expf(-fabsf(z))); o[i] = __expf(-__expf(-sp - 0.5f)); } }
                else if (j == 1) {
#pragma unroll
                    for (int i = 0; i < 4; ++i) o[i] = 1.f / (1.f + __expf(-x[i])); }
                else o = x;
                if (j == 2) { u32x2 wv; wv.x = cvt_pk_bf16(o[0], o[1]); wv.y = cvt_pk_bf16(o[2], o[3]); *(u32x2*)((bf16*)(DAG + (size_t)2 * M * D) + (size_t)(row0 + ai * 128 + m * 16) * D + col0 + cc) = wv; }
                else *(f32x4*)(base + (size_t)(ai * 128 + m * 16) * D + cc) = o; }
            asm volatile("" ::: "memory"); }
    }
};

struct EpiConvIn {
    static constexpr bool PERM = false, AFTER_DRAIN = false;
    bf16* BC; float* U;
    __device__ __forceinline__ void operator()(const f32x4 (&acc)[2][2][4][2], const Unit& u, int wr, int wc, int fr, int fq) const {
#ifdef SKIP_EPICONVIN
        return;
#endif

        const int row0 = u.pm * 256 + wr * 64 + fr, cin0 = wc * 32 + 4 * fq, pn = u.pn;
        if (pn < 4) {
#pragma unroll
            EPI_LOOP_ROWS { bf16* rp = BC + (size_t)(row0 + ai * 128 + m * 16) * D + pn * 256 + cin0;
#pragma unroll
                EPI_LOOP_COLS { const f32x4 x = acc[ai][bj][m][n]; u32x2 w; w.x = cvt_pk_bf16(x[0], x[1]); w.y = cvt_pk_bf16(x[2], x[3]); *(u32x2*)(rp + bj * 128 + n * 16) = w; } }
        } else {
#pragma unroll
            EPI_LOOP_ROWS { float* rp = U + (size_t)(row0 + ai * 128 + m * 16) * D + (pn - 4) * 128 + cin0;
#pragma unroll
                for (int n = 0; n < 2; ++n) *(f32x4*)(rp + n * 16) = acc[ai][0][m][n] * acc[ai][1][m][n]; }
        }
    }
};

__device__ __forceinline__ void tr_item(const float* W, int K, int N, bf16* WT, int ldk, int drow0, int k0, int n0, LAS bf16* scr, int lane) {
    f32x4 v[16];
    const int nl = (lane & 15) * 4, kq = lane >> 4, n = n0 + nl;
#pragma unroll
    for (int i = 0; i < 16; ++i) { const int k = k0 + 4 * i + kq; v[i] = (k < K && n < N) ? *(const f32x4*)(W + (size_t)k * N + n) : (f32x4){0.f, 0.f, 0.f, 0.f}; }
#pragma unroll
    for (int i = 0; i < 16; ++i) { const int kl = 4 * i + kq;
#pragma unroll
        for (int j = 0; j < 4; ++j) scr[(nl + j) * 72 + kl] = (bf16)f2bf(v[i][j]); }
    LDS_WAIT(); asm volatile("" ::: "memory");
    const int c = lane & 7;
#pragma unroll
    for (int q = 0; q < 8; ++q) { const int nr = q * 8 + (lane >> 3);
        const u32x4 o = *(const LAS u32x4*)(scr + nr * 72 + 8 * c);
        *(u32x4*)(WT + (size_t)(drow0 + nr) * ldk + k0 + 8 * c) = o; }
    LDS_WAIT(); asm volatile("" ::: "memory");
}
__device__ __forceinline__ int cin_row(int n0) { if (n0 < 1024) return n0; if (n0 < 2048) { const int j = n0 - 1024; return 1024 + (j >> 7) * 256 + (j & 127); } const int j = n0 - 2048; return 1024 + (j >> 7) * 256 + 128 + (j & 127); }

__device__ __forceinline__ void rms_row(const float* xrow, const float* gain, int lane, f32x4 (&v)[4]) {
    const f32x4* xr = (const f32x4*)xrow + lane; const f32x4* gr = (const f32x4*)gain + lane; float s = 0.f;
#pragma unroll
    for (int j = 0; j < 4; ++j) { v[j] = xr[64 * j]; s += (v[j].x * v[j].x + v[j].y * v[j].y) + (v[j].z * v[j].z + v[j].w * v[j].w); }
    const float rstd = 1.0f / sqrtf(wave_sum(s) * (1.f / D) + EPS);
#pragma unroll
    for (int j = 0; j < 4; ++j) v[j] = v[j] * rstd * gr[64 * j];
}
__device__ __forceinline__ void rms_row2(const float* x0, const float* x1, const float* gain, int lane, f32x4 (&v0)[4], f32x4 (&v1)[4]) {
    const f32x4* p0 = (const f32x4*)x0 + lane; const f32x4* p1 = (const f32x4*)x1 + lane; const f32x4* gr = (const f32x4*)gain + lane; float s0 = 0.f, s1 = 0.f;
#pragma unroll
    for (int j = 0; j < 4; ++j) { v0[j] = p0[64 * j]; v1[j] = p1[64 * j]; }
#pragma unroll
    for (int j = 0; j < 4; ++j) { s0 += (v0[j].x * v0[j].x + v0[j].y * v0[j].y) + (v0[j].z * v0[j].z + v0[j].w * v0[j].w); s1 += (v1[j].x * v1[j].x + v1[j].y * v1[j].y) + (v1[j].z * v1[j].z + v1[j].w * v1[j].w); }
#pragma unroll
    for (int o = 1; o < 64; o <<= 1) { s0 += __shfl_xor(s0, o); s1 += __shfl_xor(s1, o); }
    const float r0 = 1.0f / sqrtf(s0 * (1.f / D) + EPS), r1 = 1.0f / sqrtf(s1 * (1.f / D) + EPS);
#pragma unroll
    for (int j = 0; j < 4; ++j) { const f32x4 g = gr[64 * j]; v0[j] = v0[j] * r0 * g; v1[j] = v1[j] * r1 * g; }
}
__device__ __forceinline__ void store_row_bf16(bf16* orow, int lane, const f32x4 (&v)[4]) {
    u32x2* o8 = (u32x2*)orow + lane;
#pragma unroll
    for (int j = 0; j < 4; ++j) { u32x2 w; w.x = pk2(v[j].x, v[j].y); w.y = pk2(v[j].z, v[j].w); o8[64 * j] = w; }
}

#define XB_TMO      128
#define XB_XCNT(j)  (256  + 64 * (j))
#define XB_XSUB(j)  (1280 + 64 * (j))
#define XB_XGEN(j)  (2304 + 64 * (j))
#define XB_TOP      3328
#define XB_TOPGEN   3392
#define XCD_BAR_WORDS 3456
#define XB_SPIN_CAP (1u << 18)

__device__ __forceinline__ unsigned xb_ld(unsigned* p)              { return __hip_atomic_load(p, __ATOMIC_RELAXED, __HIP_MEMORY_SCOPE_AGENT); }
__device__ __forceinline__ unsigned xb_add(unsigned* p, unsigned v) { return __hip_atomic_fetch_add(p, v, __ATOMIC_RELAXED, __HIP_MEMORY_SCOPE_AGENT); }
__device__ __forceinline__ unsigned xb_xcc_id() { return (unsigned)__builtin_amdgcn_s_getreg((3 << 11) | 20) & 0xFu; }
#define XB_SPIN(cond, bar) do { unsigned _sp = 0; while (cond) { __builtin_amdgcn_s_sleep(1); \
    if ((++_sp & 255u) == 0u) { if (xb_ld(&(bar)[XB_TMO])) break; if (_sp > XB_SPIN_CAP) { atomicAdd(&(bar)[XB_TMO], 1u); break; } } } } while (0)

struct XcdBarrier {
    unsigned* bar; unsigned x;
    volatile LAS unsigned* st;
};

__device__ __forceinline__ XcdBarrier xcd_barrier_post(unsigned* bar, volatile LAS unsigned* st) {
    XcdBarrier b; b.bar = bar; b.x = xb_xcc_id(); b.st = st;
    if (threadIdx.x == 0) (void)xb_add(&bar[XB_XCNT(b.x)], 1u);
    return b;
}
__device__ __forceinline__ void xcd_barrier_complete(unsigned* bar, unsigned x, unsigned& nloc, unsigned& nx) {
    const unsigned G = gridDim.x * gridDim.y * gridDim.z;
    unsigned sum, cnt, mine, sp = 0u;
    for (;;) {
        sum = 0u; cnt = 0u; mine = 0u;
#pragma unroll
        for (unsigned j = 0; j < 16; ++j) { const unsigned c = xb_ld(&bar[XB_XCNT(j)]); sum += c; cnt += (c > 0u) ? 1u : 0u; mine = (j == x) ? c : mine; }
        if (sum == G) break;
        __builtin_amdgcn_s_sleep(1);
        if ((++sp & 255u) == 0u) { if (xb_ld(&bar[XB_TMO])) break; if (sp > XB_SPIN_CAP) { atomicAdd(&bar[XB_TMO], 1u); break; } }
    }
    nloc = mine > 0u ? mine : 1u; nx = cnt > 0u ? cnt : 1u;
}

__device__ __forceinline__ void xcd_barrier(const XcdBarrier& b) {
    asm volatile("s_waitcnt vmcnt(0)" ::: "memory");
    __syncthreads();
    if (threadIdx.x == 0) {
        unsigned* bar = b.bar;
        __builtin_amdgcn_s_waitcnt(0);
        unsigned nloc = b.st[0], nx = b.st[1];
        if (nloc == 0u) { xcd_barrier_complete(bar, b.x, nloc, nx); b.st[0] = nloc; b.st[1] = nx; }
        const unsigned old = xb_add(&bar[XB_XSUB(b.x)], 1u);
        const unsigned gen = old / nloc;
        if (old + 1u == (gen + 1u) * nloc) {
            __builtin_amdgcn_fence(__ATOMIC_RELEASE, "agent");
            asm volatile("s_waitcnt vmcnt(0)" ::: "memory");
            const unsigned og = xb_add(&bar[XB_TOP], 1u);
            const unsigned tg = og / nx;
            if (og + 1u == (tg + 1u) * nx) xb_add(&bar[XB_TOPGEN], 1u);
            else XB_SPIN(xb_ld(&bar[XB_TOPGEN]) == tg, bar);
            __builtin_amdgcn_fence(__ATOMIC_ACQUIRE, "agent");
            xb_add(&bar[XB_XGEN(b.x)], 1u);
            asm volatile("s_waitcnt vmcnt(0)" ::: "memory");
        } else {
            XB_SPIN(xb_ld(&bar[XB_XGEN(b.x)]) == gen, bar);
            __builtin_amdgcn_fence(__ATOMIC_ACQUIRE, "agent");
            asm volatile("s_waitcnt vmcnt(0)" ::: "memory");
        }
    }
    __syncthreads();
}

struct KArgs { const float* in[34]; float* out; unsigned char* ws; int ph_lo, ph_hi, coop, pad; int rep[8]; };

__global__ void __launch_bounds__(512, 2) fwd_kernel(KArgs a) {
    extern __shared__ __attribute__((aligned(16))) unsigned char lds_raw[];
    LAS unsigned char* lds = (LAS unsigned char*)lds_raw;
    cg::grid_group grid = cg::this_grid();
    const int tid0 = threadIdx.x, wave = __builtin_amdgcn_readfirstlane(tid0 >> 6);
    const int G = gridDim.x, bid = blockIdx.x, gw = bid * 8 + wave, NGW = G * 8;
    unsigned char* ws = a.ws; float* out = a.out;
    float* H = (float*)(ws + WS_H); bf16* XN = (bf16*)(ws + WS_XN);
    const float* rope = (const float*)(ws + WS_ROPE);
    const int lo = a.ph_lo, hi = a.ph_hi; const bool coop = a.coop != 0;
    volatile LAS unsigned* MISC = (volatile LAS unsigned*)(lds + LDS_MISC);
    if (tid0 == 0) { MISC[0] = 0u; MISC[1] = 0u; }
    __syncthreads();
    XcdBarrier xbar = xcd_barrier_post((unsigned*)(ws + WS_BAR), MISC);
    int pc = 0;
#define PH_BEGIN(cat) if (pc >= lo && pc < hi) { for (int rep_ = 0; rep_ < a.rep[cat]; ++rep_) { int tid = tid0; asm volatile("" : "+v"(tid)); const int lane = tid & 63; (void)lane;
#define PH_END   __syncthreads(); } if (coop && pc + 1 < hi) { if (a.coop == 2) grid.sync();     \
        xcd_barrier(xbar); if (a.rep[5] > 1) xcd_barrier(xbar); } } ++pc;

    PH_BEGIN(0)
    {
        LAS bf16* scr = (LAS bf16*)(lds + wave * 9216);
        for (int it = gw; ; it += NGW) {
            int r = it; bool did = false; const float* jW = nullptr; bf16* jWT = nullptr; int jK = 0, jN = 0, jld = 0, jrow = 0, jk0 = 0, jn0 = 0;
#define TRJOB(Wp, K_, N_, KP_, NP_, WTp, LDK_, ROWEXPR) if (!did) { const int nnb = (NP_) / 64, cnt = ((KP_) / 64) * nnb; \
                if (r < cnt) { const int kb = r / nnb, nb = r - kb * nnb, n0 = nb * 64; jW = (Wp); jK = (K_); jN = (N_); jWT = (WTp); jld = (LDK_); jrow = (ROWEXPR) + n0; jk0 = kb * 64; jn0 = n0; did = true; } else r -= cnt; }
            TRJOB(a.in[11], D, NRI, D, NRI, (bf16*)(ws + WS_RI0), D, 0)
            TRJOB(a.in[11] + (size_t)D * NRI, D, NRI, D, NRI, (bf16*)(ws + WS_RI1), D, 0)
            TRJOB(a.in[12], HV, D, HV, D, (bf16*)(ws + WS_RO0), HV, 0)
            TRJOB(a.in[12] + (size_t)HV * D, HV, D, HV, D, (bf16*)(ws + WS_RO1), HV, 0)
            TRJOB(a.in[14], D, D, D, D, (bf16*)(ws + WS_RW1), D, 0)
            TRJOB(a.in[14] + (size_t)D * D, D, D, D, D, (bf16*)(ws + WS_RW1), D, 1024)
            TRJOB(a.in[14] + (size_t)2 * D * D, D, D, D, D, (bf16*)(ws + WS_RW1), D, 2048)
            TRJOB(a.in[16], D, 64, D, 256, (bf16*)(ws + WS_RW1), D, 3072)
            TRJOB(a.in[19], D, 64, D, 256, (bf16*)(ws + WS_RW1), D, 3328)
            TRJOB(a.in[21], D, 160, D, 256, (bf16*)(ws + WS_RW1), D, 3584)
            TRJOB(a.in[17], 64, D, 256, D, (bf16*)(ws + WS_RW2), 256, 0)
            TRJOB(a.in[20], 64, D, 256, D, (bf16*)(ws + WS_RW2), 256, 1024)
            TRJOB(a.in[22], 160, D, 256, D, (bf16*)(ws + WS_RW2), 256, 2048)
            TRJOB(a.in[28], D, D, D, D, (bf16*)(ws + WS_RWO), D, 0)
            TRJOB(a.in[29], D, 3072, D, 3072, (bf16*)(ws + WS_CIN), D, cin_row(n0) - n0)
            TRJOB(a.in[31], D, D, D, D, (bf16*)(ws + WS_COUT), D, 0)
#pragma unroll 1
            for (int l = 0; l < 4; ++l) {
                TRJOB(a.in[32] + (size_t)l * D * FF, D, FF, D, FF, (bf16*)(ws + WS_M1 + (size_t)l * al((size_t)FF * D * 2)), D, 0)
                TRJOB(a.in[33] + (size_t)l * D * FF, FF, D, FF, D, (bf16*)(ws + WS_M2 + (size_t)l * al((size_t)FF * D * 2)), FF, 0)
            }
#undef TRJOB
            if (!did) break;
            tr_item(jW, jK, jN, jWT, jld, jrow, jk0, jn0, scr, lane);
        }
        for (int e = bid * 512 + tid; e < 2065 * 128; e += G * 512) {
            const int p = e >> 7, i = e & 127;
            const float x = (float)i / 127.0f;
            const float inv = 1.0f / (float)exp((double)x * 9.210340371976184);
            const float ang = (float)(p == TP ? 16384 : p) * inv;
            double rev = (double)ang * 0.15915494309189535; rev -= rint(rev);
            const float fr = (float)rev;
            ((f32x2*)(ws + WS_ROPE))[e] = (f32x2){__builtin_amdgcn_cosf(fr), __builtin_amdgcn_sinf(fr)};
        }
        for (int m = gw; m < M; m += NGW) {
            const float* src;
            if (m < MP) { const int b = m / TP, t = m - b * TP; src = t < 16 ? a.in[7] + (size_t)t * D : a.in[0] + ((size_t)b * 2048 + (t - 16)) * D; }
            else src = a.in[1] + (size_t)(m - MP) * D;
            const f32x4* xr = (const f32x4*)src + lane; f32x4* hr = (f32x4*)(H + (size_t)m * D) + lane;
#pragma unroll
            for (int j = 0; j < 4; ++j) hr[64 * j] = xr[64 * j];
            f32x4 v[4]; rms_row(src, a.in[8], lane, v); store_row_bf16(XN + (size_t)m * D, lane, v);
        }
    }
    PH_END

#pragma unroll 1
    for (int layer = 0; layer < 4; ++layer) {
        const int kind = layer % 3;
        const bf16* outA; const bf16* outB; int outK;
        if (kind == 0) {
            const int jr = layer / 3;
            bf16 *Qb = (bf16*)(ws + RB_Q), *Kb = (bf16*)(ws + RB_K), *KTD = (bf16*)(ws + RB_KTD), *VT = (bf16*)(ws + RB_VT), *SG = (bf16*)(ws + RB_SG), *OB = (bf16*)(ws + RB_OB), *Y = (bf16*)(ws + RB_Y);
            float* VS = (float*)(ws + RB_VS);
            outA = Y; outB = (const bf16*)(ws + (jr ? WS_RO1 : WS_RO0)); outK = HV;
            PH_BEGIN(4)
            {
                pg8::Gemm g{XN, (const bf16*)(ws + (jr ? WS_RI1 : WS_RI0)), M, NRI, D}; pg8::StaticOrder S; S.init(M, NRI, G, bid);
                EpiRetIn E{Qb, Kb, KTD, VT, SG, VS, rope};
                pg8::gemm_phase<EpiRetIn, pg8::StaticOrder, true, true>(lds, g, S, E);
            }
            PH_END
            PH_BEGIN(1)
            {
                const float* S0in = a.in[jr ? 6 : 2];
                float* Sp_out = out + (jr ? O_R3P : O_R0P); float* Ss_out = out + (jr ? O_R3S : O_R0S);
                const int l32 = lane & 31, hi = lane >> 5, w = wave;
                LAS bf16* P = (LAS bf16*)lds;
                LAS bf16* ST = (LAS bf16*)(lds + 34816);
                for (int item = bid; item < 256; item += G) {
                    const int itm = (G == 256) ? (((((item & 7) << 2) + (item >> 6)) << 3) | ((item >> 3) & 7)) : item;
                    const int b = itm >> 5, h = (itm >> 3) & 3, es = itm & 7;
                    const float lg2 = __log2f(1.f - __builtin_amdgcn_exp2f(-(float)(5 + h)));
                    const unsigned char* qbytes = (const unsigned char*)(Qb + (size_t)(b * TP) * D + h * 256);
                    const unsigned char* kbytes = (const unsigned char*)(Kb + (size_t)(b * TP) * D + h * 256);
                    const bf16* ktd = KTD + (size_t)((b * 4 + h) * 256) * TP;
                    const bf16* vt = VT + (size_t)((b * 4 + h) * 512 + es * 64) * TP;
                    LAS unsigned char* QH = lds;
                    LAS unsigned char* KH = lds + 34816;
                    LAS unsigned char* STb = lds + 69632;
                    LAS unsigned char* VTs = lds + 103424;
                    f32x16 S2[2];
#pragma unroll
                    for (int i = 0; i < 16; ++i) { S2[0][i] = 0.f; S2[1][i] = 0.f; }
                    for (int i = tid; i < 33792 / 16; i += 512) *(LAS u32x4*)(STb + i * 16) = (u32x4){0u, 0u, 0u, 0u};
                    const u32x4 z4 = {0u, 0u, 0u, 0u};
                    u32x4 rq[4], rk[4], rv[2];
#define RET_T0(cc) ((cc) == 0 ? 0 : 16 + 128 * ((cc) - 1))
#define RET_L(cc)  ((cc) == 0 ? 16 : 128)
#define LOADQK(cc, dh) do { const int t0c_ = RET_T0(cc), Lc_ = RET_L(cc); _Pragma("unroll") for (int i_ = 0; i_ < 4; ++i_) { const int id_ = tidc + 512 * i_, row_ = id_ >> 4, c16_ = id_ & 15; const bool ok_ = row_ < Lc_; \
        const size_t off_ = (size_t)(t0c_ + (ok_ ? row_ : 0)) * 2048 + (dh) * 256 + c16_ * 16; rq[i_] = *(const u32x4*)(qbytes + off_); rk[i_] = *(const u32x4*)(kbytes + off_); if (!ok_) { rq[i_] = z4; rk[i_] = z4; } } } while (0)
#define STOREQK() do { _Pragma("unroll") for (int i_ = 0; i_ < 4; ++i_) { const int id_ = tidc + 512 * i_, row_ = id_ >> 4, c16_ = id_ & 15; *(LAS u32x4*)(QH + row_ * 272 + c16_ * 16) = rq[i_]; *(LAS u32x4*)(KH + row_ * 272 + c16_ * 16) = rk[i_]; } } while (0)
#define LOADV(cc) do { const int t0c_ = RET_T0(cc), Lc_ = RET_L(cc); _Pragma("unroll") for (int i_ = 0; i_ < 2; ++i_) { const int id_ = tidc + 512 * i_, row_ = id_ >> 4, c16_ = id_ & 15; const bool ok_ = c16_ * 8 < Lc_; \
        rv[i_] = *(const u32x4*)(vt + (size_t)row_ * TP + t0c_ + (ok_ ? c16_ * 8 : 0)); if (!ok_) rv[i_] = z4; } } while (0)
#define STOREV() do { _Pragma("unroll") for (int i_ = 0; i_ < 2; ++i_) { const int id_ = tidc + 512 * i_, row_ = id_ >> 4, c16_ = id_ & 15; *(LAS u32x4*)(VTs + row_ * 272 + c16_ * 16) = rv[i_]; } } while (0)
                    { const int tidc = tid; LOADQK(0, 0); LOADV(0); }
                    const int lt = w >> 1, ei = w & 1;
                    LAS float* SQ = (LAS float*)(lds + 120832);
                    const bool il = (item == bid);
                    const int nel = il ? 64 * ((bid < NS * 4 ? 1 : 0) + (bid + G < NS * 4 ? 1 : 0)) : 0;
                    int sn = 0; f32x4 sv = {0.f, 0.f, 0.f, 0.f}, o4 = {0.f, 0.f, 0.f, 0.f};
                    if (il) {
                        for (int it = 0; it * 64 < nel; ++it) { const int si = bid + it * G, ss_ = si >> 2, hh_ = si & 3;
                            SQ[it * 1024 + tid] = bf2f(((tid >> 8) ? Kb : Qb)[(size_t)(MP + ss_) * D + hh_ * 256 + (tid & 255)]);
                            SQ[it * 1024 + 512 + tid] = VS[(size_t)ss_ * HV + hh_ * 512 + tid]; }
                    }
#define RET_PROC(J, VAL) { const int j_ = (J), it_ = j_ >> 6, d_ = dg_ * 64 + (j_ & 63), si_ = bid + it_ * G; \
        LAS float* q_ = SQ + it_ * 1024; const float kd_ = q_[256 + d_], qd_ = q_[d_]; const f32x4 v_ = *(const LAS f32x4*)(q_ + 512 + e4_); \
        const float gam_ = 1.f - __builtin_amdgcn_exp2f(-(float)(5 + (si_ & 3))); \
        const f32x4 n_ = (VAL) * gam_ + v_ * kd_; __builtin_nontemporal_store(n_, (f32x4*)(Ss_out + ((size_t)si_ * 256 + d_) * 512 + e4_)); \
        o4 = o4 + n_ * qd_; \
        if ((j_ & 63) == 63) { const float r0_ = sum4(o4[0]), r1_ = sum4(o4[1]), r2_ = sum4(o4[2]), r3_ = sum4(o4[3]); \
            if (dg_ == 0) { u32x2 w_; w_.x = cvt_pk_bf16(r0_, r1_); w_.y = cvt_pk_bf16(r2_, r3_); *(u32x2*)(OB + (size_t)(MP + (si_ >> 2)) * HV + (si_ & 3) * 512 + e4_) = w_; } \
            o4 = (f32x4){0.f, 0.f, 0.f, 0.f}; } }
#define RET_SRC(J) ((const f32x4*)(S0in + ((size_t)(bid + ((J) >> 6) * G) * 256 + dg_ * 64 + ((J) & 63)) * 512 + e4_))
#define RET_SLOT() do { if (sn <= nel) { int tq_ = tid; asm volatile("" : "+v"(tq_)); const int dg_ = tq_ & 3, e4_ = (tq_ >> 2) * 4; \
        if (sn >= 1) RET_PROC(sn - 1, sv) \
        if (sn < nel) sv = __builtin_nontemporal_load(RET_SRC(sn)); \
        ++sn; } } while (0)
                    __syncthreads();
#pragma unroll 1
                    for (int c = 0; c < 17; ++c) {
                        const int t0 = RET_T0(c), L = RET_L(c);
                        int tl_ = tid; asm volatile("" : "+v"(tl_));
                        const int tidc = tl_, l32 = tidc & 31, hi = (tidc >> 5) & 1, lrow = 32 * lt + l32, erow = 32 * ei + l32;
                        const bool act = 32 * lt < L;
                        f32x16 accP[2], aX;
#pragma unroll
                        for (int i = 0; i < 16; ++i) { accP[0][i] = 0.f; accP[1][i] = 0.f; aX[i] = 0.f; }
#pragma unroll
                        for (int dh = 0; dh < 2; ++dh) {
                            STOREQK(); if (dh == 0) STOREV();
                            if (dh == 0) LOADQK(c, 1); else if (c < 16) { LOADQK(c + 1, 0); LOADV(c + 1); }
                            __syncthreads();
                            RET_SLOT();
                            if (act) {
                                const LAS unsigned char* qrow = QH + lrow * 272 + 16 * hi;
#pragma unroll
                                for (int j = 0; j < 2; ++j) { const int mt = 2 * (w & 1) + j;
                                    if (mt <= lt && 32 * mt < L) { const LAS unsigned char* krow = KH + (32 * mt + l32) * 272 + 16 * hi;
#pragma unroll
                                        for (int s = 0; s < 8; ++s) { const bf16x8 kf = *(const LAS bf16x8*)(krow + 32 * s), qf = *(const LAS bf16x8*)(qrow + 32 * s); accP[j] = MFMA32(kf, qf, accP[j]); } } }
                                const LAS unsigned char* srow = STb + erow * 528 + 256 * dh + 16 * hi;
#pragma unroll
                                for (int s = 0; s < 8; ++s) { const bf16x8 sf = *(const LAS bf16x8*)(srow + 32 * s), qf = *(const LAS bf16x8*)(qrow + 32 * s); aX = MFMA32(sf, qf, aX); }
                            }
                            __syncthreads();
                            RET_SLOT();
                        }
                        bf16x8 kc[8];
                        { const bf16* kp = ktd + (size_t)(32 * w + l32) * TP + t0 + 8 * hi; const int nkc = L >> 4;
#pragma unroll
                          for (int s = 0; s < 8; ++s) kc[s] = *(const bf16x8*)(kp + (s < nkc ? 16 * s : 0)); }
                        if (act) {
#pragma unroll
                            for (int j = 0; j < 2; ++j) { const int mt = 2 * (w & 1) + j;
                                if (mt <= lt && 32 * mt < L) {
#pragma unroll
                                    for (int gq = 0; gq < 4; ++gq) { float o[4];
#pragma unroll
                                        for (int i = 0; i < 4; ++i) { const int mm = 32 * mt + 8 * gq + 4 * hi + i; const int df = lrow - mm;
                                            o[i] = df >= 0 ? accP[j][gq * 4 + i] * __builtin_amdgcn_exp2f((float)df * lg2) : 0.f; }
                                        u32x2 wv; wv.x = cvt_pk_bf16(o[0], o[1]); wv.y = cvt_pk_bf16(o[2], o[3]);
                                        *(LAS u32x2*)(KH + lrow * 272 + (32 * mt + 8 * gq + 4 * hi) * 2) = wv; } } }
                        }
                        __syncthreads();
                        RET_SLOT();
                        if (act) {
                            f32x16 aI;
#pragma unroll
                            for (int i = 0; i < 16; ++i) aI[i] = 0.f;
                            const int nk = (32 * (lt + 1) < L ? 32 * (lt + 1) : L) >> 4;
#pragma unroll 2
                            for (int s = 0; s < nk; ++s) { const bf16x8 fa = *(const LAS bf16x8*)(VTs + erow * 272 + (16 * s + 8 * hi) * 2), fb = *(const LAS bf16x8*)(KH + lrow * 272 + (16 * s + 8 * hi) * 2); aI = MFMA32(fa, fb, aI); }
                            const float qd = __builtin_amdgcn_exp2f((float)(lrow + 1) * lg2);
                            if (lrow < L) {
                                bf16* op = OB + (size_t)(b * TP + t0 + lrow) * HV + h * 512 + es * 64 + 32 * ei + 4 * hi;
#pragma unroll
                                for (int gq = 0; gq < 4; ++gq) {
                                    u32x2 wv; wv.x = cvt_pk_bf16(aI[gq * 4 + 0] + qd * aX[gq * 4 + 0], aI[gq * 4 + 1] + qd * aX[gq * 4 + 1]);
                                    wv.y = cvt_pk_bf16(aI[gq * 4 + 2] + qd * aX[gq * 4 + 2], aI[gq * 4 + 3] + qd * aX[gq * 4 + 3]);
                                    *(u32x2*)(op + 8 * gq) = wv; }
                            }
                        }
                        {
                            const float gl = __builtin_amdgcn_exp2f((float)L * lg2);
                            S2[0] = S2[0] * gl; S2[1] = S2[1] * gl;
                            const int nkc = L >> 4;
#pragma unroll
                            for (int s = 0; s < 8; ++s) if (s < nkc) {
                                const bf16x8 fb0 = *(const LAS bf16x8*)(VTs + l32 * 272 + (16 * s + 8 * hi) * 2), fb1 = *(const LAS bf16x8*)(VTs + (32 + l32) * 272 + (16 * s + 8 * hi) * 2);
                                S2[0] = MFMA32(kc[s], fb0, S2[0]); S2[1] = MFMA32(kc[s], fb1, S2[1]); }
                        }
                        __syncthreads();
                        RET_SLOT();
                        if (c < 16) {
#pragma unroll
                            for (int e2 = 0; e2 < 2; ++e2)
#pragma unroll
                                for (int gq = 0; gq < 4; ++gq) {
                                    u32x2 wv; wv.x = cvt_pk_bf16(S2[e2][gq * 4 + 0], S2[e2][gq * 4 + 1]); wv.y = cvt_pk_bf16(S2[e2][gq * 4 + 2], S2[e2][gq * 4 + 3]);
                                    *(LAS u32x2*)(STb + (32 * e2 + l32) * 528 + (32 * w + 8 * gq + 4 * hi) * 2) = wv; }
                        }
                    }
#undef LOADQK
#undef STOREQK
#undef LOADV
#undef STOREV
                    if (sn <= nel && nel > 0) { int tq_ = tid; asm volatile("" : "+v"(tq_)); const int dg_ = tq_ & 3, e4_ = (tq_ >> 2) * 4;
                        if (sn >= 1) RET_PROC(sn - 1, sv)
#pragma unroll 1
                        for (int j0 = sn; j0 < nel; j0 += 8) { f32x4 bt[8];
#pragma unroll
                            for (int u_ = 0; u_ < 8; ++u_) { const int jj = j0 + u_ < nel ? j0 + u_ : nel - 1; bt[u_] = __builtin_nontemporal_load(RET_SRC(jj)); }
#pragma unroll
                            for (int u_ = 0; u_ < 8; ++u_) if (j0 + u_ < nel) RET_PROC(j0 + u_, bt[u_])
                        }
                        sn = nel + 1;
                    }
#undef RET_PROC
#undef RET_SRC
#undef RET_SLOT
                    {
                        float* sp = Sp_out + (size_t)((b * 4 + h) * 256) * 512 + es * 64 + l32;
#pragma unroll
                        for (int e2 = 0; e2 < 2; ++e2)
#pragma unroll
                            for (int r = 0; r < 16; ++r) sp[(size_t)(32 * w + crow(r, hi)) * 512 + 32 * e2] = S2[e2][r];
                    }
                    __syncthreads();
                }
                {
                    LAS float* qk = (LAS float*)(lds + 69632);
                    LAS float* ored = (LAS float*)(lds + 69632 + 2048);
                    for (int item = bid + (bid < 256 ? 2 * G : 0); item < NS * 4; item += G) {
                        const int s = item >> 2, h = item & 3;
                        const float gamma = 1.f - __builtin_amdgcn_exp2f(-(float)(5 + h));
                        __syncthreads();
                        { const int which = tid >> 8, dd = tid & 255; qk[tid] = bf2f((which ? Kb : Qb)[(size_t)(MP + s) * D + h * 256 + dd]); }
                        __syncthreads();
                        const int e4 = (tid & 127) * 4, dg = tid >> 7;
                        const f32x4 v4 = *(const f32x4*)(VS + (size_t)s * HV + h * 512 + e4);
                        const float* sin_ = S0in + (size_t)(s * 4 + h) * 256 * 512 + e4; float* sout = Ss_out + (size_t)(s * 4 + h) * 256 * 512 + e4;
                        f32x4 o4 = {0.f, 0.f, 0.f, 0.f};
#pragma unroll 16
                        for (int i = 0; i < 64; ++i) { const int d = dg * 64 + i;
                            const f32x4 sv = __builtin_nontemporal_load((const f32x4*)(sin_ + (size_t)d * 512));
                            const f32x4 sn = sv * gamma + v4 * qk[256 + d];
                            __builtin_nontemporal_store(sn, (f32x4*)(sout + (size_t)d * 512));
                            o4 = o4 + sn * qk[d]; }
                        *(LAS f32x4*)(ored + dg * 512 + e4) = o4;
                        __syncthreads();
                        if (tid < 128) { const f32x4 r = *(LAS f32x4*)(ored + e4) + *(LAS f32x4*)(ored + 512 + e4) + *(LAS f32x4*)(ored + 1024 + e4) + *(LAS f32x4*)(ored + 1536 + e4);
                            u32x2 wv; wv.x = cvt_pk_bf16(r[0], r[1]); wv.y = cvt_pk_bf16(r[2], r[3]);
                            *(u32x2*)(OB + (size_t)(MP + s) * HV + h * 512 + e4) = wv; }
                    }
                }
            }
            PH_END
            PH_BEGIN(3)
            {
                for (int m = gw; m < M; m += 2 * NGW) {
                    const int m1 = (m + NGW < M) ? m + NGW : m;
                    u32x4 ov[2][4]; float ss[2] = {0.f, 0.f};
#pragma unroll
                    for (int q = 0; q < 2; ++q) { const u32x4* op = (const u32x4*)(OB + (size_t)(q ? m1 : m) * HV) + lane * 4;
#pragma unroll
                        for (int j = 0; j < 4; ++j) ov[q][j] = op[j]; }
#pragma unroll
                    for (int q = 0; q < 2; ++q) {
#pragma unroll
                        for (int j = 0; j < 4; ++j)
#pragma unroll
                            for (int i = 0; i < 4; ++i) { const float x0 = __uint_as_float(ov[q][j][i] << 16), x1 = __uint_as_float(ov[q][j][i] & 0xffff0000u); ss[q] += x0 * x0 + x1 * x1; }
                        ss[q] = sum16(ss[q]); }
#pragma unroll
                    for (int q = 0; q < 2; ++q) { if (q == 1 && m1 == m) break;
                        const int mr = q ? m1 : m; const float rs = 1.0f / sqrtf(ss[q] * (1.f / 512.f) + EPS);
                        const u32x4* gp = (const u32x4*)(SG + (size_t)mr * HV) + lane * 4; u32x4* yp = (u32x4*)(Y + (size_t)mr * HV) + lane * 4;
#pragma unroll
                        for (int j = 0; j < 4; ++j) { const u32x4 gv = gp[j]; u32x4 wv;
#pragma unroll
                            for (int i = 0; i < 4; ++i) { const float x0 = __uint_as_float(ov[q][j][i] << 16), x1 = __uint_as_float(ov[q][j][i] & 0xffff0000u);
                                const float g0 = __uint_as_float(gv[i] << 16), g1 = __uint_as_float(gv[i] & 0xffff0000u);
                                wv[i] = cvt_pk_bf16(x0 * rs * g0, x1 * rs * g1); }
                            yp[j] = wv; } }
                }
            }
            PH_END
        } else if (kind == 1) {
            bf16* XM = (bf16*)(ws + WB_XM); float* RKV = (float*)(ws + WB_RKV); bf16* L1 = (bf16*)(ws + WB_L1); float* DAG = (float*)(ws + WB_DAG);
            float* YR = (float*)(ws + WB_YR); bf16* Y = (bf16*)(ws + WB_Y);
            outA = Y; outB = (const bf16*)(ws + WS_RWO); outK = D;
            PH_BEGIN(4)
            {
                pg8::Gemm g{XM, (const bf16*)(ws + WS_RW1), 6 * M, 3840, D}; StackOrder S; S.base.init(M, 3840, G, bid); S.mode = 1;
                EpiRw1 E{RKV, L1};
                pg8::gemm_phase<EpiRw1, StackOrder, true, true>(lds, g, S, E);
            }
            PH_END
            PH_BEGIN(4)
            {
                int K2 = 256; asm volatile("" : "+s"(K2));
                pg8::Gemm g{L1, (const bf16*)(ws + WS_RW2), 3 * M, 3072, K2}; StackOrder S; S.base.init(M, 3072, G, bid); S.mode = 2;
                EpiRw2 E{DAG, a.in[15], a.in[18]};
                pg8::gemm_phase<EpiRw2, StackOrder, true, true>(lds, g, S, E);
            }
            PH_END
            PH_BEGIN(2)
            {
                const float *Rr = RKV, *Kr = RKV + (size_t)M * D, *Vr = RKV + (size_t)2 * M * D, *DEC = DAG, *AAp = DAG + (size_t)M * D;
                const float *k_k = a.in[23], *k_a = a.in[24]; float* RKb = (float*)(ws + WB_L1);
                LAS float* ob = (LAS float*)lds;
                const int pair = (tid >> 4) & 15, p = tid & 15; const bool cw = tid < 256;
                const int st_ld = tid >> 5, kq = tid & 31;
                for (int item = bid; item < 2 * NB * 32; item += G) {
                    const int il_ = item & 255, itm = (G == 256) ? ((item & 256) | ((((il_ & 7) << 4) + (il_ >> 4)) << 1) | ((il_ >> 3) & 1)) : item;
                    const int seq = itm >> 5, h = (itm >> 1) & 15, half = itm & 1;
                    const bool indep = seq >= NB; const int s0 = (seq - NB) * 16;
                    const int T = indep ? 16 : TP; const int rowbase = indep ? MP + s0 : seq * TP;
                    const int vrow = half * 32 + 2 * pair, ch = h * 64;
                    f32x4 Sa = (f32x4){0.f, 0.f, 0.f, 0.f}, Sb = Sa;
                    const float* sin_ = a.in[4] + (size_t)(s0 * 16 + h) * 4096 + vrow * 64 + 4 * p; float* sout_ = out + O_WKS + (size_t)(s0 * 16 + h) * 4096 + vrow * 64 + 4 * p;
                    const f32x2 rk2 = *(const f32x2*)(a.in[25] + ch + 2 * kq);
                    const f32x2 kk2 = *(const f32x2*)(k_k + ch + 2 * kq), ka2 = *(const f32x2*)(k_a + ch + 2 * kq);
                    f32x2 lr, lk, lv, ld, la;
                    { const int t = st_ld; const bool ok = t < T; const size_t off = (size_t)(rowbase + (ok ? t : 0)) * D + ch + 2 * kq;
                      lr = *(const f32x2*)(Rr + off); lk = *(const f32x2*)(Kr + off); lv = *(const f32x2*)(Vr + off); ld = *(const f32x2*)(DEC + off); la = *(const f32x2*)(AAp + off); }
                    const int nch = (T + 15) >> 4;
                    __syncthreads();
#pragma unroll 1
                    for (int cidx = 0; cidx < nch; ++cidx) {
                        LAS float* B = ob + (cidx & 1) * 6144;
                        {
                            f32x2 kkv = lk * kk2; float ssq = kkv.x * kkv.x + kkv.y * kkv.y;
                            ssq = sum16(ssq); { const int si = __builtin_bit_cast(int, ssq); ssq += __builtin_bit_cast(float, __builtin_amdgcn_ds_swizzle(si, 0x401F)); }
                            const float nrm = fmaxf(sqrtf(ssq), 1e-12f); kkv = kkv * (1.f / nrm);
                            const f32x2 km = lk * (1.f + (la - 1.f) * ka2), kav = kkv * la;
                            { float rkp = lr.x * km.x * rk2.x + lr.y * km.y * rk2.y; rkp = sum16(rkp); { const int si = __builtin_bit_cast(int, rkp); rkp += __builtin_bit_cast(float, __builtin_amdgcn_ds_swizzle(si, 0x401F)); }
                              const int tt = cidx * 16 + st_ld; if (kq == 0 && half == 0 && tt < T) RKb[(size_t)(rowbase + tt) * 16 + h] = rkp; }
                            const int o = st_ld * 64 + 2 * kq;
                            *(LAS f32x2*)(B + o) = ld; *(LAS f32x2*)(B + 1024 + o) = kkv; *(LAS f32x2*)(B + 2048 + o) = kav; *(LAS f32x2*)(B + 3072 + o) = km; *(LAS f32x2*)(B + 4096 + o) = lr; *(LAS f32x2*)(B + 5120 + o) = lv;
                        }
                        if (cidx + 1 < nch) { const int t = (cidx + 1) * 16 + st_ld; const bool ok = t < T; const size_t off = (size_t)(rowbase + (ok ? t : 0)) * D + ch + 2 * kq;
                            lr = *(const f32x2*)(Rr + off); lk = *(const f32x2*)(Kr + off); lv = *(const f32x2*)(Vr + off); ld = *(const f32x2*)(DEC + off); la = *(const f32x2*)(AAp + off); }
                        __syncthreads();
                        const int t0 = cidx * 16;
                        f32x2 ykeep = {0.f, 0.f}; f32x4 nSa = Sa, nSb = Sb;
#define SCAN_STEP(st, IND) { if (IND) { Sa = nSa; Sb = nSb; const int sn_ = (st) < 15 ? (st) + 1 : 15; nSa = *(const f32x4*)(sin_ + (size_t)sn_ * 65536); nSb = *(const f32x4*)(sin_ + (size_t)sn_ * 65536 + 64); }     \
                            const LAS float* bs = B + (st) * 64 + 4 * p; \
                            const f32x4 w4 = *(const LAS f32x4*)bs, kk4 = *(const LAS f32x4*)(bs + 1024), ka4 = *(const LAS f32x4*)(bs + 2048), km4 = *(const LAS f32x4*)(bs + 3072), r4 = *(const LAS f32x4*)(bs + 4096); \
                            const f32x2 vv = *(const LAS f32x2*)(B + 5120 + (st) * 64 + vrow); \
                            float sa0 = (Sa.x * kk4.x + Sa.y * kk4.y) + (Sa.z * kk4.z + Sa.w * kk4.w), sa1 = (Sb.x * kk4.x + Sb.y * kk4.y) + (Sb.z * kk4.z + Sb.w * kk4.w); \
                            sa0 = -sum16(sa0); sa1 = -sum16(sa1); \
                            Sa = Sa * w4 + ka4 * sa0 + km4 * vv.x; Sb = Sb * w4 + ka4 * sa1 + km4 * vv.y; \
                            float y0 = (Sa.x * r4.x + Sa.y * r4.y) + (Sa.z * r4.z + Sa.w * r4.w), y1 = (Sb.x * r4.x + Sb.y * r4.y) + (Sb.z * r4.z + Sb.w * r4.w); \
                            y0 = sum16(y0); y1 = sum16(y1); \
                            if (p == (st)) { ykeep.x = y0; ykeep.y = y1; } \
                            if (IND) { *(f32x4*)(sout_ + (size_t)(st) * 65536) = Sa; *(f32x4*)(sout_ + (size_t)(st) * 65536 + 64) = Sb; } }
                        if (cw) {
                            if (!indep) {
#pragma unroll
                                for (int st = 0; st < 16; ++st) SCAN_STEP(st, false)
                            } else {
                                nSa = *(const f32x4*)sin_; nSb = *(const f32x4*)(sin_ + 64);
#pragma unroll 1
                                for (int st = 0; st < 16; ++st) SCAN_STEP(st, true)
                            }
                            *(f32x2*)(YR + (size_t)(rowbase + t0 + p) * D + ch + vrow) = ykeep;
                        }
#undef SCAN_STEP
                    }
                    if (!indep && cw) { float* so = out + O_WKP + (size_t)(seq * 16 + h) * 4096 + vrow * 64 + 4 * p; *(f32x4*)so = Sa; *(f32x4*)(so + 64) = Sb; }
                    __syncthreads();
                }
            }
            PH_END
            PH_BEGIN(3)
            {
                const float *Vr = RKV + (size_t)2 * M * D; const bf16* GB = (const bf16*)(DAG + (size_t)2 * M * D); const float* RKb = (const float*)(ws + WB_L1);
                const float *ln_g = a.in[26], *ln_b = a.in[27];
                for (int m = gw; m < M; m += NGW) {
                    const size_t off = (size_t)m * D + lane * 16; const int c0 = lane * 16;
                    f32x4 y[4]; float s1 = 0.f;
                    const float rk = RKb[(size_t)m * 16 + (lane >> 2)];
                    const u32x4 g0 = *(const u32x4*)(GB + off), g1 = *(const u32x4*)(GB + off + 8);
#pragma unroll
                    for (int j = 0; j < 4; ++j) { y[j] = *(const f32x4*)(YR + off + 4 * j); s1 += (y[j].x + y[j].y) + (y[j].z + y[j].w); }
                    s1 = sum4(s1);
                    const float mu = s1 * (1.f / 64.f); float s2 = 0.f;
#pragma unroll
                    for (int j = 0; j < 4; ++j) { const f32x4 d = y[j] - mu; s2 += (d.x * d.x + d.y * d.y) + (d.z * d.z + d.w * d.w); }
                    s2 = sum4(s2);
                    const float rstd = 1.0f / sqrtf(s2 * (1.f / 64.f) + 64e-5f);
                    u32x4 w0, w1;
#pragma unroll
                    for (int j = 0; j < 4; ++j) { const f32x4 lg = *(const f32x4*)(ln_g + c0 + 4 * j), lb = *(const f32x4*)(ln_b + c0 + 4 * j), v = *(const f32x4*)(Vr + off + 4 * j);
                        const unsigned ga = j == 0 ? g0.x : (j == 1 ? g0.z : (j == 2 ? g1.x : g1.z)), gb = j == 0 ? g0.y : (j == 1 ? g0.w : (j == 2 ? g1.y : g1.w));
                        const f32x4 g = {__uint_as_float(ga << 16), __uint_as_float(ga & 0xffff0000u), __uint_as_float(gb << 16), __uint_as_float(gb & 0xffff0000u)};
                        const f32x4 o = ((y[j] - mu) * rstd * lg + lb + v * rk) * g;
                        const unsigned a0 = cvt_pk_bf16(o[0], o[1]), a1 = cvt_pk_bf16(o[2], o[3]);
                        if (j == 0) { w0.x = a0; w0.y = a1; } else if (j == 1) { w0.z = a0; w0.w = a1; } else if (j == 2) { w1.x = a0; w1.y = a1; } else { w1.z = a0; w1.w = a1; } }
                    u32x4* yp = (u32x4*)(Y + off); yp[0] = w0; yp[1] = w1;
                }
            }
            PH_END
        } else {
            bf16* BC = (bf16*)(ws + CB_BC); float* U = (float*)(ws + CB_U); bf16* A2 = (bf16*)(ws + CB_A2);
            outA = A2; outB = (const bf16*)(ws + WS_COUT); outK = D;
            PH_BEGIN(4)
            {
                pg8::Gemm g{XN, (const bf16*)(ws + WS_CIN), M, 3072, D}; pg8::StaticOrder S; S.init(M, 3072, G, bid);
                EpiConvIn E{BC, U};
                pg8::gemm_phase<EpiConvIn, pg8::StaticOrder, true, true>(lds, g, S, E);
            }
            PH_END
            PH_BEGIN(3)
            {
                const float* cw = a.in[30]; const float* cst = a.in[5];
                for (size_t e = (size_t)bid * 512 + tid; e < (size_t)M * 256; e += (size_t)G * 512) {
                    const int m = (int)(e >> 8), c = (int)(e & 255) * 4;
                    const f32x4 w0 = *(const f32x4*)(cw + c), w1 = *(const f32x4*)(cw + D + c), w2 = *(const f32x4*)(cw + 2 * D + c);
                    const f32x4 u2 = *(const f32x4*)(U + (size_t)m * D + c); f32x4 u1, u0;
                    if (m < MP) { const int b = m / TP, t = m - b * TP;
                        u1 = t >= 1 ? *(const f32x4*)(U + (size_t)(m - 1) * D + c) : (f32x4){0.f, 0.f, 0.f, 0.f};
                        u0 = t >= 2 ? *(const f32x4*)(U + (size_t)(m - 2) * D + c) : (f32x4){0.f, 0.f, 0.f, 0.f};
                        if (t >= TP - 2) *(f32x4*)(out + O_CVP + ((size_t)b * 2 + (t - (TP - 2))) * D + c) = u2;
                    } else { const int s = m - MP;
                        u0 = *(const f32x4*)(cst + ((size_t)s * 2) * D + c); u1 = *(const f32x4*)(cst + ((size_t)s * 2 + 1) * D + c);
                        *(f32x4*)(out + O_CVS + ((size_t)s * 2) * D + c) = u1; *(f32x4*)(out + O_CVS + ((size_t)s * 2 + 1) * D + c) = u2; }
                    const f32x4 yv = w0 * u0 + w1 * u1 + w2 * u2;
                    const u32x2 bb = *(const u32x2*)(BC + (size_t)m * D + c);
                    const float b0 = __uint_as_float(bb.x << 16), b1 = __uint_as_float(bb.x & 0xffff0000u), b2 = __uint_as_float(bb.y << 16), b3 = __uint_as_float(bb.y & 0xffff0000u);
                    u32x2 wv; wv.x = cvt_pk_bf16(b0 * yv[0], b1 * yv[1]); wv.y = cvt_pk_bf16(b2 * yv[2], b3 * yv[3]);
                    *(u32x2*)(A2 + (size_t)m * D + c) = wv;
                }
            }
            PH_END
        }
        PH_BEGIN(7)
        {
            pg8::Gemm g{outA, outB, M, D, outK}; TailOrder S; S.init(D, outK, G, bid);
            EpiResid E{H, (rep_ & 1) ? -1.f : 1.f};
            pg8::gemm_phase<EpiResid, TailOrder, true, true>(lds, g, S, E);
        }
        PH_END
        PH_BEGIN(3)
        {
            const float* gain = a.in[9] + (size_t)layer * D;
            for (int m = gw; m < M; m += 2 * NGW) { const int m1 = m + NGW; const bool has1 = m1 < M; f32x4 v0[4], v1[4]; rms_row2(H + (size_t)m * D, H + (size_t)(has1 ? m1 : m) * D, gain, lane, v0, v1); store_row_bf16(XN + (size_t)m * D, lane, v0); if (has1) store_row_bf16(XN + (size_t)m1 * D, lane, v1); }
        }
        PH_END
        bf16* ACT = (bf16*)(ws + MB_ACT);
        PH_BEGIN(4)
        {
            pg8::Gemm g{XN, (const bf16*)(ws + WS_M1 + (size_t)layer * al((size_t)FF * D * 2)), M, FF, D}; pg8::StaticOrder S; S.init(M, FF, G, bid);
            EpiRelu2 E{ACT};
            pg8::gemm_phase<EpiRelu2, pg8::StaticOrder, true, true>(lds, g, S, E);
        }
        PH_END
        PH_BEGIN(7)
        {
            pg8::Gemm g{ACT, (const bf16*)(ws + WS_M2 + (size_t)layer * al((size_t)FF * D * 2)), M, D, FF}; TailOrder S; S.init(D, FF, G, bid);
            EpiResid E{H, (rep_ & 1) ? -1.f : 1.f};
            pg8::gemm_phase<EpiResid, TailOrder, true, true>(lds, g, S, E);
        }
        PH_END
        PH_BEGIN(3)
        {
            if (layer == 3) {
                for (int m = gw; m < M; m += NGW) {
                    float* dst;
                    if (m < MP) { const int b = m / TP, t = m - b * TP; if (t < 16) continue; dst = out + O_YP + ((size_t)b * 2048 + (t - 16)) * D; }
                    else dst = out + O_YS + (size_t)(m - MP) * D;
                    f32x4 v[4]; rms_row(H + (size_t)m * D, a.in[10], lane, v);
                    f32x4* o = (f32x4*)dst + lane;
#pragma unroll
                    for (int j = 0; j < 4; ++j) o[64 * j] = v[j];
                }
            } else if ((layer + 1) % 3 == 1) {
                const float* gain = a.in[8] + (size_t)(layer + 1) * D; const float* mix = a.in[13];
                bf16* XM = (bf16*)(ws + WB_XM);
                f32x4 mrow[6][4];
#pragma unroll
                for (int q = 0; q < 6; ++q)
#pragma unroll
                    for (int j = 0; j < 4; ++j) mrow[q][j] = ((const f32x4*)(mix + (size_t)q * D) + lane)[64 * j];
                for (int m = gw; m < M; m += NGW) {
                    f32x4 xn[4], xp[4];
                    rms_row(H + (size_t)m * D, gain, lane, xn);
                    int b = 0, t = 0;
                    if (m < MP) { b = m / TP; t = m - b * TP;
                        if (t > 0) rms_row(H + (size_t)(m - 1) * D, gain, lane, xp);
                        else {
#pragma unroll
                            for (int j = 0; j < 4; ++j) xp[j] = (f32x4){0.f, 0.f, 0.f, 0.f}; }
                        if (t == TP - 1) { f32x4* o = (f32x4*)(out + O_SHP + (size_t)b * D) + lane;
#pragma unroll
                            for (int j = 0; j < 4; ++j) o[64 * j] = xn[j]; }
                    } else { const int s = m - MP; const f32x4* sp = (const f32x4*)(a.in[3] + (size_t)s * D) + lane; f32x4* o = (f32x4*)(out + O_SHS + (size_t)s * D) + lane;
#pragma unroll
                        for (int j = 0; j < 4; ++j) { xp[j] = sp[64 * j]; o[64 * j] = xn[j]; } }
#pragma unroll
                    for (int j = 0; j < 4; ++j) xp[j] = xp[j] - xn[j];
#pragma unroll
                    for (int q = 0; q < 6; ++q) { f32x4 v[4];
#pragma unroll
                        for (int j = 0; j < 4; ++j) v[j] = xn[j] + xp[j] * mrow[q][j];
                        store_row_bf16(XM + ((size_t)q * M + m) * D, lane, v); }
                }
            } else {
                const float* gain = a.in[8] + (size_t)(layer + 1) * D;
                for (int m = gw; m < M; m += 2 * NGW) { const int m1 = m + NGW; const bool has1 = m1 < M; f32x4 v0[4], v1[4]; rms_row2(H + (size_t)m * D, H + (size_t)(has1 ? m1 : m) * D, gain, lane, v0, v1); store_row_bf16(XN + (size_t)m * D, lane, v0); if (has1) store_row_bf16(XN + (size_t)m1 * D, lane, v1); }
            }
        }
        PH_END
    }
#undef PH_BEGIN
#undef PH_END
}

constexpr int N_PHASES = 33;

#ifndef REP0
#define REP0 1
#define REP1 1
#define REP2 1
#define REP3 1
#define REP4 1
#endif
#ifndef REP5
#define REP5 1
#endif
#ifndef REP7
#define REP7 1
#endif
#ifndef MK_MULTI
#define MK_MULTI 0
#endif

extern "C" void kernel_launch(void* const* d_in, const int* in_sizes, int n_in, void* d_out, int out_size, void* d_ws, size_t ws_size, hipStream_t stream) {
    static int grid = 0;
    if (grid == 0) {
        if (n_in != 34 || (size_t)out_size != O_END || ws_size < WS_TOTAL) { fprintf(stderr, "kernel_launch: unexpected shapes: n_in %d out %d ws %zu (need %zu)\n", n_in, out_size, ws_size, (size_t)WS_TOTAL); grid = -1; return; }
        int dev = 0, cus = 0, per_cu = 0;
        hipGetDevice(&dev); hipDeviceGetAttribute(&cus, hipDeviceAttributeMultiprocessorCount, dev);
        if (hipFuncSetAttribute((const void*)fwd_kernel, hipFuncAttributeMaxDynamicSharedMemorySize, LDS_BYTES) != hipSuccess) { fprintf(stderr, "kernel_launch: hipFuncSetAttribute failed\n"); grid = -1; return; }
        if (hipOccupancyMaxActiveBlocksPerMultiprocessor(&per_cu, (const void*)fwd_kernel, 512, LDS_BYTES) != hipSuccess || per_cu < 1) { fprintf(stderr, "kernel_launch: occupancy query says %d\n", per_cu); (void)hipGetLastError(); grid = -1; return; }
        grid = cus * 1;
    }
    if (grid < 0) return;
    if (hipMemsetAsync((char*)d_ws + WS_BAR, 0, 16384, stream) != hipSuccess) { fprintf(stderr, "kernel_launch: memset failed\n"); return; }
    KArgs a{};
    for (int i = 0; i < 34; ++i) a.in[i] = (const float*)d_in[i];
    a.out = (float*)d_out; a.ws = (unsigned char*)d_ws;
    { const int reps[8] = {REP0, REP1, REP2, REP3, REP4, REP5, 1, REP7}; for (int i = 0; i < 8; ++i) a.rep[i] = reps[i]; }
#if MK_MULTI
    for (int p = 0; p < N_PHASES; ++p) { a.ph_lo = p; a.ph_hi = p + 1; a.coop = 0; hipLaunchKernelGGL(fwd_kernel, dim3(grid), dim3(512), LDS_BYTES, stream, a); }
#else
    a.ph_lo = 0; a.ph_hi = N_PHASES; a.coop = 1;
    void* args[] = {&a};
    hipError_t e = hipLaunchCooperativeKernel((const void*)fwd_kernel, dim3(grid), dim3(512), args, LDS_BYTES, stream);
    if (e != hipSuccess) fprintf(stderr, "cooperative launch failed: %s (grid %d)\n", hipGetErrorString(e), grid);
#endif
}
```
